# Optimizing an MI355X kernel written in HIP

```python
import math
import jax, jax.numpy as jnp
from jax import lax
import numpy as np

D_MODEL = 1024
BATCH = 2
SEQ = 8192
DEPTH = 1
DEC_BATCH = 32
DEC_SEQ = 1
PAST_LEN = 16384
PAGE_SIZE = 128

HEAD_DIM = 64
HEADS_PER_GROUP = 4
ATTN_GROUPS = ((128, 1), (512, 4), (2048, 16))
N_ATTN_GROUPS = len(ATTN_GROUPS)
ATTN_WIDTH = N_ATTN_GROUPS * HEADS_PER_GROUP * HEAD_DIM
ATTN_OUT_WIDTH = HEADS_PER_GROUP * HEAD_DIM
SSM_CH_PER_GROUP = 16
SSM_STATE = 64
SSM_WIDTH = D_MODEL // 2
SSM_GROUPS = SSM_WIDTH // SSM_CH_PER_GROUP
D_FF = 2816
DT_MIN = 0.01
DT_MAX = 0.1
RMS_EPS = 1e-6
Q_BLOCK = 128
COL_Q = SSM_WIDTH
COL_K = COL_Q + ATTN_WIDTH
COL_V = COL_K + ATTN_WIDTH
COL_GATE_SSM = COL_V + ATTN_WIDTH
COL_GATE_ATTN = COL_GATE_SSM + D_MODEL
IN_WIDTH = COL_GATE_ATTN + D_MODEL

kernel_name = "gated_s5_dilated_attn_macaron_step"


def rms_norm(x, g):
    xf = x.astype(jnp.float32)
    y = xf * lax.rsqrt(jnp.mean(xf * xf, axis=-1, keepdims=True) + RMS_EPS)
    return (y * g.astype(jnp.float32)).astype(x.dtype)


def head_rms_norm(t, g):
    tf = t.astype(jnp.float32)
    y = tf * lax.rsqrt(jnp.mean(tf * tf, axis=-1, keepdims=True) + RMS_EPS)
    return (y * g.astype(jnp.float32)[:, None, :]).astype(t.dtype)


def swiglu(x, w_gate, w_up, w_down):
    return (jax.nn.silu(x @ w_gate) * (x @ w_up)) @ w_down


def ssm_discretize(a_re, a_im, log_dt, b_re, b_im):
    f32 = jnp.float32
    a_re = a_re.astype(f32)
    a_im = a_im.astype(f32)
    dt = jnp.exp(log_dt.astype(f32))[:, None]
    mag = jnp.exp(a_re * dt)
    ab_re = mag * jnp.cos(a_im * dt)
    ab_im = mag * jnp.sin(a_im * dt)
    inv = 1.0 / (a_re * a_re + a_im * a_im)
    f_re = ((ab_re - 1.0) * a_re + ab_im * a_im) * inv
    f_im = (ab_im * a_re - (ab_re - 1.0) * a_im) * inv
    b_re = b_re.astype(f32)
    b_im = b_im.astype(f32)
    bb_re = f_re[..., None] * b_re - f_im[..., None] * b_im
    bb_im = f_re[..., None] * b_im + f_im[..., None] * b_re
    return ab_re, ab_im, bb_re, bb_im


def complex_affine_combine(e1, e2):
    a1r, a1i, b1r, b1i = e1
    a2r, a2i, b2r, b2i = e2
    return (a2r * a1r - a2i * a1i,
            a2r * a1i + a2i * a1r,
            a2r * b1r - a2i * b1i + b2r,
            a2r * b1i + a2i * b1r + b2i)


def s5_branch(u, h0_re, h0_im, a_re, a_im, log_dt, b_re, b_im, c_re, c_im, d_skip, w_glu, b_glu):
    f32 = jnp.float32
    nb, seq_len, _ = u.shape
    uf = u.astype(f32)
    ab_re, ab_im, bb_re, bb_im = ssm_discretize(a_re, a_im, log_dt, b_re, b_im)
    ug = uf.reshape(nb, seq_len, SSM_GROUPS, SSM_CH_PER_GROUP)
    x_re = jnp.einsum("blgc,gpc->blgp", ug, bb_re)
    x_im = jnp.einsum("blgc,gpc->blgp", ug, bb_im)
    h0_re = h0_re.astype(f32)
    h0_im = h0_im.astype(f32)
    x_re = x_re.at[:, 0].add(ab_re * h0_re - ab_im * h0_im)
    x_im = x_im.at[:, 0].add(ab_re * h0_im + ab_im * h0_re)
    a_re_t = jnp.broadcast_to(ab_re, x_re.shape)
    a_im_t = jnp.broadcast_to(ab_im, x_im.shape)
    _, _, s_re, s_im = lax.associative_scan(
        complex_affine_combine, (a_re_t, a_im_t, x_re, x_im), axis=1)
    y = (jnp.einsum("blgp,gcp->blgc", s_re, c_re.astype(f32))
         - jnp.einsum("blgp,gcp->blgc", s_im, c_im.astype(f32)))
    y = y.reshape(nb, seq_len, SSM_WIDTH) + d_skip.astype(f32) * uf
    y = jax.nn.gelu(y)
    y = y * jax.nn.sigmoid(y @ w_glu.astype(f32) + b_glu.astype(f32))
    return y.astype(u.dtype), s_re[:, -1], s_im[:, -1]


def dilated_group_attention(q, k_ext, v_ext, pos0, window, dilation):
    nb, lq, nh, hd = q.shape
    qb = Q_BLOCK if lq % Q_BLOCK == 0 else lq
    n_blk = lq // qb
    n_keys = window // dilation + 1
    rel = jnp.arange(qb)[:, None] + window - dilation * jnp.arange(n_keys)[None, :]
    scale = HEAD_DIM ** -0.5
    qf = q.astype(jnp.float32)

    def one_block(blk):
        start = blk * qb
        qs = lax.dynamic_slice_in_dim(qf, start, qb, axis=1)
        ks = lax.dynamic_slice_in_dim(k_ext, start, qb + window, axis=1)
        vs = lax.dynamic_slice_in_dim(v_ext, start, qb + window, axis=1)
        kg = ks[:, rel].astype(jnp.float32)
        vg = vs[:, rel].astype(jnp.float32)
        s = jnp.einsum("bqhd,bqjhd->bqhj", qs, kg) * scale
        valid = (pos0 - window + start + rel) >= 0
        s = jnp.where(valid[None, :, None, :], s, -jnp.inf)
        m = jnp.max(s, axis=-1)
        p = jnp.exp(s - m[..., None])
        den = jnp.sum(p, axis=-1)
        o = jnp.einsum("bqhj,bqjhd->bqhd", p, vg) / den[..., None]
        return o, m, den

    o, m, den = lax.map(one_block, jnp.arange(n_blk))
    o = jnp.moveaxis(o, 0, 1).reshape(nb, lq, nh, hd)
    m = jnp.moveaxis(m, 0, 1).reshape(nb, lq, nh)
    den = jnp.moveaxis(den, 0, 1).reshape(nb, lq, nh)
    return o, m, den


def dilated_attention_branch(q, k, v, kv_prev, pos0):
    nb, lq = q.shape[0], q.shape[1]
    outs, maxes, dens, new_bufs = [], [], [], []
    for g, (window, dilation) in enumerate(ATTN_GROUPS):
        prev = kv_prev[g].astype(k.dtype)
        n_prev = prev.shape[1]
        pad = jnp.zeros((nb, window - n_prev, HEADS_PER_GROUP, HEAD_DIM), k.dtype)
        kg = k[:, :, g]
        vg = v[:, :, g]
        k_ext = jnp.concatenate([pad, prev[:, :, 0], kg], axis=1)
        v_ext = jnp.concatenate([pad, prev[:, :, 1], vg], axis=1)
        o, m, den = dilated_group_attention(q[:, :, g], k_ext, v_ext, pos0, window, dilation)
        outs.append(o)
        maxes.append(m)
        dens.append(den)
        kv_all = jnp.concatenate([prev, jnp.stack([kg, vg], axis=2)], axis=1)
        keep = min(window, pos0 + lq)
        new_bufs.append(kv_all[:, kv_all.shape[1] - keep:])
    m_all = jnp.stack(maxes)
    den_all = jnp.stack(dens)
    o_all = jnp.stack(outs)
    m_top = jnp.max(m_all, axis=0)
    wts = den_all * jnp.exp(m_all - m_top[None])
    out = jnp.sum(wts[..., None] * o_all, axis=0) / jnp.sum(wts, axis=0)[..., None]
    return out.reshape(nb, lq, ATTN_OUT_WIDTH).astype(q.dtype), tuple(new_bufs)


def trunk_layer(x, pos0, h0_re, h0_im, kv_prev, w):
    nb, seq_len, _ = x.shape
    x = x + 0.5 * swiglu(rms_norm(x, w["g_ffn1"]), w["w1_gate"], w["w1_up"], w["w1_down"])
    h = rms_norm(x, w["g_mix"])
    proj = h @ w["w_in"]
    heads = (nb, seq_len, N_ATTN_GROUPS, HEADS_PER_GROUP, HEAD_DIM)
    u = proj[..., :COL_Q]
    q = head_rms_norm(proj[..., COL_Q:COL_K].reshape(heads), w["g_q"])
    k = head_rms_norm(proj[..., COL_K:COL_V].reshape(heads), w["g_k"])
    v = proj[..., COL_V:COL_GATE_SSM].reshape(heads)
    gate_ssm = jax.nn.sigmoid(proj[..., COL_GATE_SSM:COL_GATE_ATTN])
    gate_attn = jax.nn.sigmoid(proj[..., COL_GATE_ATTN:])
    y_ssm, hT_re, hT_im = s5_branch(u, h0_re, h0_im, w["ssm_a_re"], w["ssm_a_im"], w["ssm_log_dt"],
                                    w["ssm_b_re"], w["ssm_b_im"], w["ssm_c_re"], w["ssm_c_im"],
                                    w["ssm_d"], w["w_glu"], w["b_glu"])
    y_attn, kv_new = dilated_attention_branch(q, k, v, kv_prev, pos0)
    mixed = gate_ssm * (y_ssm @ w["w_ssm_proj"]) + gate_attn * (y_attn @ w["w_attn_proj"])
    x = x + mixed @ w["w_o"]
    x = x + 0.5 * swiglu(rms_norm(x, w["g_ffn2"]), w["w2_gate"], w["w2_up"], w["w2_down"])
    return x, hT_re, hT_im, kv_new


def setup_inputs(seed: int = 0) -> dict:
    key = jax.random.key(seed)
    keys = iter(jax.random.split(key, 40))
    f32 = jnp.float32

    def nrm(shape, scale=1.0):
        return jax.random.normal(next(keys), shape, f32) * scale

    def gain(shape):
        return 1.0 + nrm(shape, 0.02)

    L = DEPTH
    inp = {}
    inp["x_prompt"] = nrm((BATCH, SEQ, D_MODEL))
    inp["x_sample"] = nrm((DEC_BATCH, DEC_SEQ, D_MODEL))
    for window, _ in ATTN_GROUPS:
        inp["cache_kv_w%d" % window] = nrm(
            (L, DEC_BATCH, min(window, PAST_LEN), 2, HEADS_PER_GROUP, HEAD_DIM))
    inp["state_ssm_re"] = nrm((L, DEC_BATCH, SSM_GROUPS, SSM_STATE), 0.1)
    inp["state_ssm_im"] = nrm((L, DEC_BATCH, SSM_GROUPS, SSM_STATE), 0.1)
    inp["g_ffn1"] = gain((L, D_MODEL))
    inp["w1_gate"] = nrm((L, D_MODEL, D_FF), D_MODEL ** -0.5)
    inp["w1_up"] = nrm((L, D_MODEL, D_FF), D_MODEL ** -0.5)
    inp["w1_down"] = nrm((L, D_FF, D_MODEL), D_FF ** -0.5)
    inp["g_mix"] = gain((L, D_MODEL))
    inp["w_in"] = nrm((L, D_MODEL, IN_WIDTH), D_MODEL ** -0.5)
    inp["g_q"] = gain((L, N_ATTN_GROUPS, HEAD_DIM))
    inp["g_k"] = gain((L, N_ATTN_GROUPS, HEAD_DIM))
    inp["ssm_a_re"] = -0.5 + nrm((L, SSM_GROUPS, SSM_STATE), 0.01)
    inp["ssm_a_im"] = (jnp.pi * jnp.arange(SSM_STATE, dtype=f32)
                       + nrm((L, SSM_GROUPS, SSM_STATE), 0.01))
    inp["ssm_log_dt"] = jax.random.uniform(next(keys), (L, SSM_GROUPS), f32,
                                           math.log(DT_MIN), math.log(DT_MAX))
    inp["ssm_b_re"] = nrm((L, SSM_GROUPS, SSM_STATE, SSM_CH_PER_GROUP), (2 * SSM_CH_PER_GROUP) ** -0.5)
    inp["ssm_b_im"] = nrm((L, SSM_GROUPS, SSM_STATE, SSM_CH_PER_GROUP), (2 * SSM_CH_PER_GROUP) ** -0.5)
    inp["ssm_c_re"] = nrm((L, SSM_GROUPS, SSM_CH_PER_GROUP, SSM_STATE), SSM_STATE ** -0.5)
    inp["ssm_c_im"] = nrm((L, SSM_GROUPS, SSM_CH_PER_GROUP, SSM_STATE), SSM_STATE ** -0.5)
    inp["ssm_d"] = nrm((L, SSM_WIDTH))
    inp["w_glu"] = nrm((L, SSM_WIDTH, SSM_WIDTH), SSM_WIDTH ** -0.5)
    inp["b_glu"] = nrm((L, SSM_WIDTH), 0.02)
    inp["w_ssm_proj"] = nrm((L, SSM_WIDTH, D_MODEL), SSM_WIDTH ** -0.5)
    inp["w_attn_proj"] = nrm((L, ATTN_OUT_WIDTH, D_MODEL), ATTN_OUT_WIDTH ** -0.5)
    inp["w_o"] = nrm((L, D_MODEL, D_MODEL), D_MODEL ** -0.5)
    inp["g_ffn2"] = gain((L, D_MODEL))
    inp["w2_gate"] = nrm((L, D_MODEL, D_FF), D_MODEL ** -0.5)
    inp["w2_up"] = nrm((L, D_MODEL, D_FF), D_MODEL ** -0.5)
    inp["w2_down"] = nrm((L, D_FF, D_MODEL), D_FF ** -0.5)
    return inp


def reference(x_prompt, x_sample, cache_kv_w128, cache_kv_w512, cache_kv_w2048,
              state_ssm_re, state_ssm_im,
              g_ffn1, w1_gate, w1_up, w1_down, g_mix, w_in, g_q, g_k,
              ssm_a_re, ssm_a_im, ssm_log_dt, ssm_b_re, ssm_b_im, ssm_c_re, ssm_c_im,
              ssm_d, w_glu, b_glu, w_ssm_proj, w_attn_proj, w_o,
              g_ffn2, w2_gate, w2_up, w2_down):
    caches = (cache_kv_w128, cache_kv_w512, cache_kv_w2048)
    nb_p = x_prompt.shape[0]
    y_p = x_prompt
    y_s = x_sample
    p_kv = ([], [], [])
    s_kv = ([], [], [])
    p_re, p_im, s_re, s_im = [], [], [], []
    for layer in range(DEPTH):
        w = {
            "g_ffn1": g_ffn1[layer], "w1_gate": w1_gate[layer], "w1_up": w1_up[layer],
            "w1_down": w1_down[layer], "g_mix": g_mix[layer], "w_in": w_in[layer],
            "g_q": g_q[layer], "g_k": g_k[layer],
            "ssm_a_re": ssm_a_re[layer], "ssm_a_im": ssm_a_im[layer],
            "ssm_log_dt": ssm_log_dt[layer], "ssm_b_re": ssm_b_re[layer],
            "ssm_b_im": ssm_b_im[layer], "ssm_c_re": ssm_c_re[layer], "ssm_c_im": ssm_c_im[layer],
            "ssm_d": ssm_d[layer], "w_glu": w_glu[layer], "b_glu": b_glu[layer],
            "w_ssm_proj": w_ssm_proj[layer], "w_attn_proj": w_attn_proj[layer], "w_o": w_o[layer],
            "g_ffn2": g_ffn2[layer], "w2_gate": w2_gate[layer], "w2_up": w2_up[layer],
            "w2_down": w2_down[layer],
        }
        empty_kv = tuple(jnp.zeros((nb_p, 0, 2, HEADS_PER_GROUP, HEAD_DIM), x_prompt.dtype)
                         for _ in ATTN_GROUPS)
        h0 = jnp.zeros((nb_p, SSM_GROUPS, SSM_STATE), jnp.float32)
        y_p, hp_re, hp_im, kvp = trunk_layer(y_p, 0, h0, h0, empty_kv, w)
        y_s, hs_re, hs_im, kvs = trunk_layer(y_s, PAST_LEN, state_ssm_re[layer], state_ssm_im[layer],
                                             tuple(c[layer] for c in caches), w)
        for g in range(N_ATTN_GROUPS):
            p_kv[g].append(kvp[g])
            s_kv[g].append(kvs[g])
        p_re.append(hp_re)
        p_im.append(hp_im)
        s_re.append(hs_re)
        s_im.append(hs_im)
    sdt = state_ssm_re.dtype
    return (y_p, y_s,
            jnp.stack(p_kv[0]), jnp.stack(p_kv[1]), jnp.stack(p_kv[2]),
            jnp.stack(p_re).astype(sdt), jnp.stack(p_im).astype(sdt),
            jnp.stack(s_kv[0]), jnp.stack(s_kv[1]), jnp.stack(s_kv[2]),
            jnp.stack(s_re).astype(sdt), jnp.stack(s_im).astype(sdt))
```

```cpp
#include <hip/hip_runtime.h>
#include <hip/hip_cooperative_groups.h>
#include <cstdio>
#include <cstdint>
namespace cg = cooperative_groups;
namespace pg8 {
#define PG8_LAS __attribute__((address_space(3)))
typedef unsigned short bf16_t;
typedef short bf16x8 __attribute__((ext_vector_type(8)));
typedef float f32x4 __attribute__((ext_vector_type(4)));
typedef unsigned u32x4 __attribute__((ext_vector_type(4)));
constexpr int BM = 256, BK = 64, HALF = 128, HTB = HALF * BK * 2  , STAGE_BYTES = 8 * HTB, NXCD = 8, WGM = 8;

__host__ __device__ __forceinline__ int lds_byte(int r, int c) { const int st = (r >> 4) * 2 + (c >> 5), rr = r & 15, cc = c & 31, ob = rr * 64 + cc * 2; return st * 1024 + (ob ^ (((ob >> 9) & 1) << 5)); }
__host__ __device__ __forceinline__ void stage_rc(int b, int& R, int& C) { const int st = b / 1024, sb = b % 1024, swz = sb ^ (((sb >> 9) & 1) << 5); R = (st >> 1) * 16 + swz / 64; C = (st & 1) * 32 + (swz % 64) / 2; }
__host__ __device__ __forceinline__ int perm32(int rho) { const int n = rho >> 4, i = rho & 15; return 8 * (i >> 2) + 4 * n + (i & 3); }

struct Unit { int pm, pn; };
struct Gemm { const bf16_t* A; const bf16_t* Bt; int M, N, K; };

struct StaticOrder {
    int nM, nN, nwg, G, c;
    __host__ __device__ void init(int M, int N, int G_, int c_) { nM = M / BM; nN = N / BM; nwg = nM * nN; G = G_; c = c_; }
    __host__ __device__ bool next(int i, Unit& u) const {
        const long L = (long)i * G + c; if (L >= nwg) return false;
        int wgid = (int)L; { const int q = nwg / NXCD, r = nwg % NXCD, xcd = wgid % NXCD, off = wgid / NXCD; wgid = (xcd < r ? xcd * (q + 1) : r * (q + 1) + (xcd - r) * q) + off; }
        const int nig = WGM * nN, gid = wgid / nig, fm = gid * WGM, gsz = (nM - fm) < WGM ? (nM - fm) : WGM;
        u.pm = fm + ((wgid % nig) % gsz); u.pn = (wgid % nig) / gsz; return true;
    }
    __device__ __forceinline__ void a_ready(const Unit&) const {}
    __device__ __forceinline__ void done(const Unit&) const {}
};
template <class Epi, class Sched, bool ALIGN_EPI = false, bool SP2 = false, int LDA_T = 0>
__device__ __forceinline__ void gemm_phase(PG8_LAS unsigned char* lds, const Gemm g, const Sched& S, const Epi& E) {
    int tid_ = threadIdx.x; asm volatile("" : "+v"(tid_));
    const int tid = tid_, wid = __builtin_amdgcn_readfirstlane(tid >> 6), lane = tid & 63, wr = wid >> 2, wc = wid & 3, fr = lane & 15, fq = lane >> 4;
    constexpr bool ABLK = (LDA_T == -1);
    const int K = g.K, nt = K / BK, LDA = ABLK ? BK : (LDA_T ? LDA_T : g.K);
    unsigned voffA[2], voffB[2];
#pragma unroll
    for (int i = 0; i < 2; ++i) { int R, C; stage_rc(tid * 16 + i * 8192, R, C); const int Rb = Epi::PERM ? ((R & ~31) + perm32(R & 31)) : R;
        voffA[i] = (unsigned)(R * LDA + C) * 2u; voffB[i] = (unsigned)(Rb * K + C) * 2u; }
    const size_t kstepB = (size_t)(BK * 2), kstepA = ABLK ? (size_t)(BM * BK * 2) : kstepB;
    const size_t hstepB = (size_t)HALF * K * 2, hstepA = (size_t)HALF * LDA * 2;
    const size_t tstepB = 2 * hstepB, tstepA = ABLK ? (size_t)nt * kstepA : 2 * hstepA;
    const unsigned ldsw = (unsigned)wid * 1024u;
    const int aoff = lds_byte(wr * 64 + fr, fq * 8), boff = lds_byte(wc * 32 + fr, fq * 8);
#define PG8_SA(b, h) (((b) * 2 + (h)) * HTB)
#define PG8_SB(b, h) ((4 + (b) * 2 + (h)) * HTB)
#define PG8_STAGE(bufoff, gbase, voff) do { _Pragma("unroll") for (int _i = 0; _i < 2; ++_i) \
        __builtin_amdgcn_global_load_lds((const unsigned*)((const char*)(gbase) + (voff)[_i]), (PG8_LAS unsigned*)(lds + (bufoff) + ldsw + _i * 8192), 16, 0, 0); } while (0)
#define PG8_LDA(dst, b, h) do { _Pragma("unroll") for (int m = 0; m < 4; ++m) _Pragma("unroll") for (int k = 0; k < 2; ++k) dst[m][k] = *(const PG8_LAS bf16x8*)(lds + PG8_SA(b, h) + aoff + m * 2048 + k * 1024); } while (0)
#define PG8_LDB(dst, b, h) do { _Pragma("unroll") for (int n = 0; n < 2; ++n) _Pragma("unroll") for (int k = 0; k < 2; ++k) dst[n][k] = *(const PG8_LAS bf16x8*)(lds + PG8_SB(b, h) + boff + n * 2048 + k * 1024); } while (0)
#define PG8_MMA(ai, bj, At, Bt) do { __builtin_amdgcn_s_setprio(1); _Pragma("unroll") for (int m = 0; m < 4; ++m) _Pragma("unroll") for (int n = 0; n < 2; ++n) _Pragma("unroll") for (int k = 0; k < 2; ++k) \
        acc[ai][bj][m][n] = __builtin_amdgcn_mfma_f32_16x16x32_bf16(Bt[n][k], At[m][k], acc[ai][bj][m][n], 0, 0, 0); __builtin_amdgcn_s_setprio(0); } while (0)
#define PG8_WAIT_V(n) asm volatile("s_waitcnt vmcnt(" #n ")" ::: "memory")
#define PG8_WAIT_L(n) asm volatile("s_waitcnt lgkmcnt(" #n ")" ::: "memory")
#define PG8_BAR __builtin_amdgcn_s_barrier()
#define PG8_SCHED __builtin_amdgcn_sched_barrier(0)
    Unit cur, nxt; int ui = 0;
    if (!S.next(0, cur)) return;
    f32x4 acc[2][2][4][2];
#pragma unroll
    for (int a = 0; a < 2; ++a)
#pragma unroll
        for (int b = 0; b < 2; ++b)
#pragma unroll
            for (int m = 0; m < 4; ++m)
#pragma unroll
                for (int n = 0; n < 2; ++n) acc[a][b][m][n] = (f32x4){0.f, 0.f, 0.f, 0.f};
    bf16x8 At[4][2], B0[2][2], B1[2][2];
    const char* cA = (const char*)g.A + (size_t)cur.pm * tstepA; const char* cB = (const char*)g.Bt + (size_t)cur.pn * tstepB;
    S.a_ready(cur);
    if constexpr (SP2) {
        PG8_STAGE(PG8_SB(0, 0), cB, voffB); PG8_STAGE(PG8_SB(0, 1), cB + hstepB, voffB); PG8_STAGE(PG8_SA(0, 0), cA, voffA); PG8_STAGE(PG8_SA(0, 1), cA + hstepA, voffA);
        if (wr == 1) PG8_BAR;
        PG8_WAIT_V(2); PG8_BAR;
        PG8_STAGE(PG8_SB(1, 0), cB + kstepB, voffB); PG8_STAGE(PG8_SA(1, 0), cA + kstepA, voffA); PG8_STAGE(PG8_SB(1, 1), cB + hstepB + kstepB, voffB);
        PG8_WAIT_V(6); PG8_BAR;
    } else {
        PG8_STAGE(PG8_SB(0, 0), cB, voffB); PG8_STAGE(PG8_SA(0, 0), cA, voffA); PG8_STAGE(PG8_SB(0, 1), cB + hstepB, voffB); PG8_STAGE(PG8_SA(0, 1), cA + hstepA, voffA);
        if (wr == 1) PG8_BAR;
        PG8_WAIT_V(4); PG8_BAR;
        PG8_STAGE(PG8_SB(1, 0), cB + kstepB, voffB); PG8_STAGE(PG8_SA(1, 0), cA + kstepA, voffA); PG8_STAGE(PG8_SB(1, 1), cB + hstepB + kstepB, voffB);
        PG8_WAIT_V(6); PG8_BAR;
    }
    for (;;) {
        const bool has_next = S.next(ui + 1, nxt);
        const char* nA = has_next ? (const char*)g.A + (size_t)nxt.pm * tstepA : cA; const char* nB = has_next ? (const char*)g.Bt + (size_t)nxt.pn * tstepB : cB;
        for (int t = 0; t < nt; t += 2) {
            const bool last = (t == nt - 2);
            const char* a1 = cA + (size_t)(t + 1) * kstepA;
            const char* a2 = last ? nA : cA + (size_t)(t + 2) * kstepA; const char* b2 = last ? nB : cB + (size_t)(t + 2) * kstepB;
            const char* a3 = a2 + kstepA; const char* b3 = b2 + kstepB;
            if (last && has_next) S.a_ready(nxt);
            if constexpr (SP2) {
            PG8_LDB(B0, 0, 0); PG8_LDB(B1, 0, 1); PG8_SCHED; PG8_LDA(At, 0, 0); PG8_STAGE(PG8_SA(1, 1), a1 + hstepA, voffA);
            PG8_WAIT_V(8); PG8_WAIT_L(0); PG8_BAR; PG8_MMA(0, 0, At, B0); PG8_MMA(0, 1, At, B1); PG8_BAR; PG8_SCHED;
            PG8_LDA(At, 0, 1); PG8_STAGE(PG8_SB(0, 0), b2, voffB); PG8_STAGE(PG8_SB(0, 1), b2 + hstepB, voffB); PG8_STAGE(PG8_SA(0, 0), a2, voffA);
            PG8_WAIT_V(8); PG8_WAIT_L(0); PG8_BAR; PG8_MMA(1, 0, At, B0); PG8_MMA(1, 1, At, B1); PG8_BAR; PG8_SCHED;
            PG8_LDB(B0, 1, 0); PG8_LDB(B1, 1, 1); PG8_SCHED; PG8_LDA(At, 1, 0); PG8_STAGE(PG8_SA(0, 1), a2 + hstepA, voffA);
            PG8_WAIT_V(8); PG8_WAIT_L(0); PG8_BAR; PG8_MMA(0, 0, At, B0); PG8_MMA(0, 1, At, B1); PG8_BAR; PG8_SCHED;
            PG8_LDA(At, 1, 1); PG8_STAGE(PG8_SB(1, 0), b3, voffB); PG8_STAGE(PG8_SB(1, 1), b3 + hstepB, voffB); PG8_STAGE(PG8_SA(1, 0), a3, voffA);
            PG8_WAIT_V(8); PG8_WAIT_L(0); PG8_BAR; PG8_MMA(1, 0, At, B0); PG8_MMA(1, 1, At, B1); PG8_BAR; PG8_SCHED;
            } else {
            PG8_LDB(B0, 0, 0); PG8_SCHED; PG8_LDA(At, 0, 0); PG8_STAGE(PG8_SA(1, 1), a1 + hstepA, voffA);
            PG8_WAIT_L(8); PG8_BAR; PG8_WAIT_L(0); PG8_MMA(0, 0, At, B0); PG8_BAR; PG8_SCHED;
            PG8_LDB(B1, 0, 1); PG8_STAGE(PG8_SB(0, 0), b2, voffB);
            PG8_BAR; PG8_WAIT_L(0); PG8_MMA(0, 1, At, B1); PG8_BAR;
            PG8_LDA(At, 0, 1); PG8_STAGE(PG8_SA(0, 0), a2, voffA);
            PG8_BAR; PG8_WAIT_L(0); PG8_MMA(1, 0, At, B0); PG8_BAR; PG8_SCHED;
            PG8_STAGE(PG8_SB(0, 1), b2 + hstepB, voffB);
            PG8_WAIT_V(6); PG8_BAR; PG8_MMA(1, 1, At, B1); PG8_BAR;
            PG8_LDB(B0, 1, 0); PG8_SCHED; PG8_LDA(At, 1, 0); PG8_STAGE(PG8_SA(0, 1), a2 + hstepA, voffA);
            PG8_WAIT_L(8); PG8_BAR; PG8_WAIT_L(0); PG8_MMA(0, 0, At, B0); PG8_BAR; PG8_SCHED;
            PG8_LDB(B1, 1, 1); PG8_STAGE(PG8_SB(1, 0), b3, voffB);
            PG8_BAR; PG8_WAIT_L(0); PG8_MMA(0, 1, At, B1); PG8_BAR;
            PG8_LDA(At, 1, 1); PG8_STAGE(PG8_SA(1, 0), a3, voffA);
            PG8_BAR; PG8_WAIT_L(0); PG8_MMA(1, 0, At, B0); PG8_BAR; PG8_SCHED;
            PG8_STAGE(PG8_SB(1, 1), b3 + hstepB, voffB);
            PG8_WAIT_V(6); PG8_BAR; PG8_MMA(1, 1, At, B1); PG8_BAR;
            }
        }
        if constexpr (ALIGN_EPI) { if (wr == 0) PG8_BAR; }
        if constexpr (!Epi::AFTER_DRAIN) { E(acc, cur, wr, wc, fr, fq); S.done(cur); }
        if (!has_next) break;
#pragma unroll
        for (int a = 0; a < 2; ++a)
#pragma unroll
            for (int b = 0; b < 2; ++b)
#pragma unroll
                for (int m = 0; m < 4; ++m)
#pragma unroll
                    for (int n = 0; n < 2; ++n) acc[a][b][m][n] = (f32x4){0.f, 0.f, 0.f, 0.f};
        cur = nxt; cA = nA; cB = nB; ++ui;
        if constexpr (ALIGN_EPI) { if (wr == 1) PG8_BAR; }
    }
    PG8_WAIT_V(0);
    if constexpr (!ALIGN_EPI) { if (wr == 0) PG8_BAR; }
    PG8_BAR;
    if constexpr (Epi::AFTER_DRAIN) { E.fused(acc, cur, wr, wc, fr, fq, lds, wid, lane); S.done(cur); }
#undef PG8_SA
#undef PG8_SB
#undef PG8_STAGE
#undef PG8_LDA
#undef PG8_LDB
#undef PG8_MMA
#undef PG8_WAIT_V
#undef PG8_WAIT_L
#undef PG8_BAR
#undef PG8_SCHED
}
}

#define LAS __attribute__((address_space(3)))
#define DI __device__ __forceinline__
typedef unsigned short bf16_t;
typedef short bf16x8 __attribute__((ext_vector_type(8)));
typedef float f32x4 __attribute__((ext_vector_type(4)));
typedef float f32x2 __attribute__((ext_vector_type(2)));
typedef float f32x16 __attribute__((ext_vector_type(16)));
typedef unsigned u32x4 __attribute__((ext_vector_type(4)));
typedef unsigned u32x2 __attribute__((ext_vector_type(2)));
typedef __bf16 bf16x2n __attribute__((ext_vector_type(2)));

constexpr int DM = 1024, FF = 2816, NPR = 16384, NSM = 32, MT = NPR + NSM, SEQ = 8192, INW = 4864;
constexpr float EPS = 1e-6f;
constexpr float QSCALE = 0.125f * 1.4426950408889634f;
constexpr int NCH = 128, TCH = 64;

constexpr size_t MiB = 1u << 20;
constexpr size_t WS_W1GU = 1 * MiB, WS_W1D = 12 * MiB, WS_WIN = 18 * MiB, WS_WGLU = 28 * MiB, WS_WMIX = 29 * MiB, WS_WO = 32 * MiB, WS_W2GU = 34 * MiB, WS_W2D = 45 * MiB;
constexpr size_t WS_SEND = 51 * MiB, WS_SIN = 55 * MiB, WS_ML = 59 * MiB, WS_SQ1 = 61 * MiB, WS_SQ2 = 63 * MiB, WS_SRAW = 65 * MiB;
constexpr size_t WS_XN = 70 * MiB, WS_X1B = 103 * MiB, WS_X1 = 136 * MiB, WS_ACT = 201 * MiB, WS_G = 290 * MiB, WS_OG = 355 * MiB, WS_YG = 380 * MiB, WS_YY = 397 * MiB, WS_END = 422 * MiB;
constexpr size_t SR_RAW1 = 0, SR_RAWD = SR_RAW1 + 32 * 5632, SR_RAW3 = SR_RAWD + 32 * 1024, SR_RAWGLU = SR_RAW3 + 32 * 4864, SR_RAWMIX = SR_RAWGLU + 32 * 512, SR_RAWO = SR_RAWMIX + 32 * 2048,
                 SR_RAW10 = SR_RAWO + 32 * 1024, SR_END = SR_RAW10 + 32 * 5632;
static_assert(SR_END * 4 <= 5 * MiB, "sample raw region");
constexpr size_t O_YP = 0, O_YS = 16777216, O_KVP0 = 16809984, O_KVP1 = 16941056, O_KVP2 = 17465344, O_SREP = 19562496, O_SIMP = 19566592,
                 O_KVS0 = 19570688, O_KVS1 = 21667840, O_KVS2 = 30056448, O_SRES = 63610880, O_SIMS = 63676416;

constexpr int LDS_BYTES = 147456;

DI int otid() { int t = threadIdx.x; asm volatile("" : "+v"(t)); return t; }
DI unsigned pk2(float a, float b) { f32x2 v = {a, b}; bf16x2n r = __builtin_convertvector(v, bf16x2n); return __builtin_bit_cast(unsigned, r); }
DI bf16_t f2bf(float a) { return (bf16_t)(pk2(a, a) & 0xffffu); }
DI float bflo(unsigned w) { return __uint_as_float(w << 16); }
DI float bfhi(unsigned w) { return __uint_as_float(w & 0xffff0000u); }
DI float bf2f(bf16_t b) { return __uint_as_float(((unsigned)b) << 16); }
DI float sigm(float x) { return __builtin_amdgcn_rcpf(1.f + __expf(-x)); }
DI float silu(float x) { return x * sigm(x); }
DI float gelu_tanh(float x) { const float z = 0.7978845608028654f * (x + 0.044715f * x * x * x); const float t = 1.f - 2.f * __builtin_amdgcn_rcpf(1.f + __expf(2.f * z)); return 0.5f * x * (1.f + t); }
DI u32x4 pack8(f32x4 a, f32x4 b) { u32x4 w; w.x = pk2(a[0], a[1]); w.y = pk2(a[2], a[3]); w.z = pk2(b[0], b[1]); w.w = pk2(b[2], b[3]); return w; }
DI void unpack8(u32x4 w, f32x4& a, f32x4& b) { a = (f32x4){bflo(w.x), bfhi(w.x), bflo(w.y), bfhi(w.y)}; b = (f32x4){bflo(w.z), bfhi(w.z), bflo(w.w), bfhi(w.w)}; }
DI float wave_sum(float v) {
#pragma unroll
    for (int o = 1; o < 64; o <<= 1) v += __shfl_xor(v, o);
    return v;
}
DI float wave_max(float v) {
#pragma unroll
    for (int o = 1; o < 64; o <<= 1) v = fmaxf(v, __shfl_xor(v, o));
    return v;
}
DI float rstd16(const float* sq, int row) { return rsqrtf(sq[row] * (1.f / 1024.f) + EPS); }
DI int l2p(int c) { return (c & ~255) | (((c >> 5) & 1) << 7) | (((c >> 6) & 3) << 5) | (c & 31); }
#define LDS_WAIT() asm volatile("s_waitcnt lgkmcnt(0)" ::: "memory")
#define SCHED_FENCE() __builtin_amdgcn_sched_barrier(0)


typedef __attribute__((address_space(1))) unsigned gu32;
#define XB_TMO      128
#define XB_XCNT(j)  (256  + 64 * (j))
#define XB_XSUB(j)  (1280 + 64 * (j))
#define XB_XGEN(j)  (2304 + 64 * (j))
#define XB_TOP      3328
#define XB_TOPGEN   3392
#define XCD_BAR_WORDS 3456
#define XB_SPIN_CAP (1u << 18)

__device__ __forceinline__ unsigned xb_ld(unsigned* p)              { return __hip_atomic_load(p, __ATOMIC_RELAXED, __HIP_MEMORY_SCOPE_AGENT); }
__device__ __forceinline__ unsigned xb_add(unsigned* p, unsigned v) { return __hip_atomic_fetch_add(p, v, __ATOMIC_RELAXED, __HIP_MEMORY_SCOPE_AGENT); }
__device__ __forceinline__ unsigned xb_xcc_id() { return (unsigned)__builtin_amdgcn_s_getreg((3 << 11) | 20) & 0xFu; }
#define XB_SPIN(cond, bar) do { unsigned _sp = 0; while (cond) { __builtin_amdgcn_s_sleep(1); \
    if ((++_sp & 255u) == 0u) { if (xb_ld(&(bar)[XB_TMO])) break; if (_sp > XB_SPIN_CAP) { atomicAdd(&(bar)[XB_TMO], 1u); break; } } } } while (0)

struct XcdBarrier {
    unsigned* bar; unsigned x;
    volatile LAS unsigned* st;
};

__device__ __forceinline__ XcdBarrier xcd_barrier_post(unsigned* bar, volatile LAS unsigned* st) {
    XcdBarrier b; b.bar = bar; b.x = xb_xcc_id(); b.st = st;
    if (threadIdx.x == 0) (void)xb_add(&bar[XB_XCNT(b.x)], 1u);
    return b;
}
__device__ __forceinline__ void xcd_barrier_complete(unsigned* bar, unsigned x, unsigned& nloc, unsigned& nx) {
    const unsigned G = gridDim.x * gridDim.y * gridDim.z;
    unsigned sum, cnt, mine, sp = 0u;
    for (;;) {
        sum = 0u; cnt = 0u; mine = 0u;
#pragma unroll
        for (unsigned j = 0; j < 16; ++j) { const unsigned c = xb_ld(&bar[XB_XCNT(j)]); sum += c; cnt += (c > 0u) ? 1u : 0u; mine = (j == x) ? c : mine; }
        if (sum == G) break;
        __builtin_amdgcn_s_sleep(1);
        if ((++sp & 255u) == 0u) { if (xb_ld(&bar[XB_TMO])) break; if (sp > XB_SPIN_CAP) { atomicAdd(&bar[XB_TMO], 1u); break; } }
    }
    nloc = mine > 0u ? mine : 1u; nx = cnt > 0u ? cnt : 1u;
}

__device__ __forceinline__ void xcd_barrier(const XcdBarrier& b) {
    asm volatile("s_waitcnt vmcnt(0)" ::: "memory");
    __syncthreads();
    if (threadIdx.x == 0) {
        unsigned* bar = b.bar; unsigned bx = b.x; asm volatile("" : "+s"(bx));
        __builtin_amdgcn_s_waitcnt(0);
        unsigned nloc = b.st[0], nx = b.st[1];
        if (nloc == 0u) { xcd_barrier_complete(bar, bx, nloc, nx); b.st[0] = nloc; b.st[1] = nx; }
        const unsigned old = xb_add(&bar[XB_XSUB(bx)], 1u);
        const unsigned gen = old / nloc;
        if (old + 1u == (gen + 1u) * nloc) {
            __builtin_amdgcn_fence(__ATOMIC_RELEASE, "agent");
            asm volatile("s_waitcnt vmcnt(0)" ::: "memory");
            const unsigned og = xb_add(&bar[XB_TOP], 1u);
            const unsigned tg = og / nx;
            if (og + 1u == (tg + 1u) * nx) xb_add(&bar[XB_TOPGEN], 1u);
            else XB_SPIN(xb_ld(&bar[XB_TOPGEN]) == tg, bar);
            __builtin_amdgcn_fence(__ATOMIC_ACQUIRE, "agent");
            xb_add(&bar[XB_XGEN(bx)], 1u);
            asm volatile("s_waitcnt vmcnt(0)" ::: "memory");
        } else {
            XB_SPIN(xb_ld(&bar[XB_XGEN(bx)]) == gen, bar);
            __builtin_amdgcn_fence(__ATOMIC_ACQUIRE, "agent");
            asm volatile("s_waitcnt vmcnt(0)" ::: "memory");
        }
    }
    __syncthreads();
}

using pg8::Unit;
template <bool RS> struct EpiAct {
    static constexpr bool PERM = true, AFTER_DRAIN = false;
    bf16_t* O; const float* sq;
    DI void operator()(const f32x4 (&acc)[2][2][4][2], const Unit& u, int wr, int wc, int fr, int fq) const {
        const int row0 = u.pm * 256 + wr * 64 + fr, col = u.pn * 128 + wc * 32 + 8 * fq;
        float rs[2][4];
#pragma unroll
        for (int ai = 0; ai < 2; ++ai)
#pragma unroll
            for (int m = 0; m < 4; ++m) rs[ai][m] = RS ? sq[row0 + ai * 128 + m * 16] : 1.f;
        SCHED_FENCE();
#pragma unroll
        for (int ai = 0; ai < 2; ++ai)
#pragma unroll
            for (int m = 0; m < 4; ++m) {
                const int row = row0 + ai * 128 + m * 16; float r1 = 1.f; if (RS) r1 = rsqrtf(rs[ai][m] * (1.f / 1024.f) + EPS);
                f32x4 o[2];
#pragma unroll
                for (int n = 0; n < 2; ++n)
#pragma unroll
                    for (int e = 0; e < 4; ++e) o[n][e] = silu(acc[ai][0][m][n][e] * r1) * (acc[ai][1][m][n][e] * r1);
                *(u32x4*)(O + (((size_t)(row >> 8) * (FF / 64) + (col >> 6)) * 256 + (row & 255)) * 64 + (col & 63)) = pack8(o[0], o[1]);
            }
    }
};
template <bool BF> struct EpiRes {
    static constexpr bool PERM = true, AFTER_DRAIN = false;
    const void* base; float* out; bf16_t* ob; float* sq; float scale;
    DI void operator()(const f32x4 (&acc)[2][2][4][2], const Unit& u, int wr, int wc, int fr, int fq) const {
        const int row0 = u.pm * 256 + wr * 64 + fr;
        constexpr int MB = BF ? 4 : 2;
#pragma unroll
        for (int ai = 0; ai < 2; ++ai)
#pragma unroll
        for (int m0 = 0; m0 < 4; m0 += MB) {
            f32x4 b0[MB][2], b1[MB][2]; u32x4 bw[MB][2];
            SCHED_FENCE();
#pragma unroll
            for (int mm = 0; mm < MB; ++mm)
#pragma unroll
                for (int bj = 0; bj < 2; ++bj) { const size_t off = (size_t)(row0 + ai * 128 + (m0 + mm) * 16) * DM + u.pn * 256 + bj * 128 + wc * 32 + 8 * fq;
                    if (BF) bw[mm][bj] = *(const u32x4*)((const bf16_t*)base + off);
                    else { b0[mm][bj] = *(const f32x4*)((const float*)base + off); b1[mm][bj] = *(const f32x4*)((const float*)base + off + 4); } }
            SCHED_FENCE();
#pragma unroll
            for (int mm = 0; mm < MB; ++mm) {
                const int m = m0 + mm; const int row = row0 + ai * 128 + m * 16; float ss = 0.f;
#pragma unroll
                for (int bj = 0; bj < 2; ++bj) {
                    const size_t off = (size_t)row * DM + u.pn * 256 + bj * 128 + wc * 32 + 8 * fq;
                    f32x4 c0, c1; if (BF) unpack8(bw[mm][bj], c0, c1); else { c0 = b0[mm][bj]; c1 = b1[mm][bj]; }
                    const f32x4 v0 = c0 + acc[ai][bj][m][0] * scale, v1 = c1 + acc[ai][bj][m][1] * scale;
                    if (out) { *(f32x4*)(out + off) = v0; *(f32x4*)(out + off + 4) = v1; }
                    if (ob) *(u32x4*)(ob + off) = pack8(v0, v1);
                    ss += (v0[0] * v0[0] + v0[1] * v0[1]) + (v0[2] * v0[2] + v0[3] * v0[3]) + (v1[0] * v1[0] + v1[1] * v1[1]) + (v1[2] * v1[2] + v1[3] * v1[3]);
                }
                if (sq) { ss += __shfl_xor(ss, 16); ss += __shfl_xor(ss, 32); if (fq == 0) atomicAdd(sq + row, ss); }
            }
        }
    }
};
struct EpiWin {
    static constexpr bool PERM = true, AFTER_DRAIN = false;
    const float* sq; bf16_t* UQKV; bf16_t* G; const float* gqk; float* out;
    DI void operator()(const f32x4 (&acc)[2][2][4][2], const Unit& u, int wr, int wc, int fr, int fq) const {
        const int row0 = u.pm * 256 + wr * 64 + fr, pn = u.pn;
        const int kind = (pn - 2) / 3, g = (pn - 2) % 3;
        float rsq[2][4]; f32x4 gn[2][2];
#pragma unroll
        for (int ai = 0; ai < 2; ++ai)
#pragma unroll
            for (int m = 0; m < 4; ++m) rsq[ai][m] = sq[row0 + ai * 128 + m * 16];
        if (pn >= 2 && pn < 8) { const float* gp = gqk + kind * 192 + g * 64 + 8 * fq;
#pragma unroll
            for (int bj = 0; bj < 2; ++bj) { gn[bj][0] = *(const f32x4*)(gp + bj * 32); gn[bj][1] = *(const f32x4*)(gp + bj * 32 + 4); } }
        else { const f32x4 one = {1.f, 1.f, 1.f, 1.f}; gn[0][0] = one; gn[0][1] = one; gn[1][0] = one; gn[1][1] = one; }
        SCHED_FENCE();
#pragma unroll
        for (int ai = 0; ai < 2; ++ai)
#pragma unroll
            for (int m = 0; m < 4; ++m) {
                const int row = row0 + ai * 128 + m * 16; const float rs = rsqrtf(rsq[ai][m] * (1.f / 1024.f) + EPS);
                f32x4 v[2][2];
#pragma unroll
                for (int bj = 0; bj < 2; ++bj)
#pragma unroll
                    for (int n = 0; n < 2; ++n) v[bj][n] = acc[ai][bj][m][n] * rs;
                if (pn < 2) {
#pragma unroll
                    for (int bj = 0; bj < 2; ++bj) *(u32x4*)(UQKV + (size_t)row * 512 + pn * 256 + wc * 64 + bj * 32 + 8 * fq) = pack8(v[bj][0], v[bj][1]);
                } else if (pn < 11) {
                    float rn = 1.f;
                    if (kind < 2) {
                        float ss = 0.f;
#pragma unroll
                        for (int bj = 0; bj < 2; ++bj)
#pragma unroll
                            for (int n = 0; n < 2; ++n) ss += (v[bj][n][0] * v[bj][n][0] + v[bj][n][1] * v[bj][n][1]) + (v[bj][n][2] * v[bj][n][2] + v[bj][n][3] * v[bj][n][3]);
                        ss += __shfl_xor(ss, 16); ss += __shfl_xor(ss, 32);
                        rn = rsqrtf(ss * (1.f / 64.f) + EPS) * (kind == 0 ? QSCALE : 1.f);
                    }
                    const int t = row & (SEQ - 1), b = row >> 13; const int w = g == 0 ? 128 : (g == 1 ? 512 : 2048);
                    const size_t kvo = g == 0 ? O_KVP0 : (g == 1 ? O_KVP1 : O_KVP2);
                    bf16_t* dstb = UQKV + (size_t)MT * 512 + (size_t)kind * ((size_t)MT * 768) + (size_t)row * 768 + g * 256 + wc * 64 + 8 * fq;
#pragma unroll
                    for (int bj = 0; bj < 2; ++bj) {
                        const f32x4 a0 = v[bj][0] * rn * gn[bj][0], a1 = v[bj][1] * rn * gn[bj][1];
                        *(u32x4*)(dstb + bj * 32) = pack8(a0, a1);
                        if (kind >= 1 && t >= SEQ - w) { float* o = out + kvo + ((size_t)(b * w + (t - (SEQ - w))) * 2 + (kind - 1)) * 256 + wc * 64 + bj * 32 + 8 * fq; *(f32x4*)o = a0; *(f32x4*)(o + 4) = a1; }
                    }
                } else {
#pragma unroll
                    for (int bj = 0; bj < 2; ++bj) {
                        f32x4 a0, a1;
#pragma unroll
                        for (int e = 0; e < 4; ++e) { a0[e] = sigm(v[bj][0][e]); a1[e] = sigm(v[bj][1][e]); }
                        *(u32x4*)(G + (size_t)row * 2048 + (pn - 11) * 256 + wc * 64 + bj * 32 + 8 * fq) = pack8(a0, a1);
                    }
                }
            }
    }
};
struct EpiGlu {
    static constexpr bool PERM = true, AFTER_DRAIN = false;
    const bf16_t* YG; const float* bias; bf16_t* YY;
    DI void operator()(const f32x4 (&acc)[2][2][4][2], const Unit& u, int wr, int wc, int fr, int fq) const {
        const int row0 = u.pm * 256 + wr * 64 + fr;
        f32x4 bb[2][2];
#pragma unroll
        for (int bj = 0; bj < 2; ++bj) { const int col = u.pn * 256 + bj * 128 + wc * 32 + 8 * fq; bb[bj][0] = *(const f32x4*)(bias + col); bb[bj][1] = *(const f32x4*)(bias + col + 4); }
#pragma unroll
        for (int ai = 0; ai < 2; ++ai) {
            u32x4 yw[2][4][2];
            SCHED_FENCE();
#pragma unroll
            for (int bj = 0; bj < 2; ++bj)
#pragma unroll
                for (int m = 0; m < 4; ++m) yw[ai][m][bj] = *(const u32x4*)(YG + (size_t)(row0 + ai * 128 + m * 16) * 512 + u.pn * 256 + bj * 128 + wc * 32 + 8 * fq);
            SCHED_FENCE();
#pragma unroll
            for (int m = 0; m < 4; ++m) {
                const int row = row0 + ai * 128 + m * 16;
#pragma unroll
                for (int bj = 0; bj < 2; ++bj) {
                    const int col = u.pn * 256 + bj * 128 + wc * 32 + 8 * fq;
                    f32x4 y0, y1; unpack8(yw[ai][m][bj], y0, y1);
                    f32x4 o0, o1;
#pragma unroll
                    for (int e = 0; e < 4; ++e) { o0[e] = y0[e] * sigm(acc[ai][bj][m][0][e] + bb[bj][0][e]); o1[e] = y1[e] * sigm(acc[ai][bj][m][1][e] + bb[bj][1][e]); }
                    *(u32x4*)(YY + (size_t)row * 768 + col) = pack8(o0, o1);
                }
            }
        }
    }
};
struct EpiGateScale {
    static constexpr bool PERM = true, AFTER_DRAIN = false;
    const bf16_t* G; bf16_t* T;
    DI void operator()(const f32x4 (&acc)[2][2][4][2], const Unit& u, int wr, int wc, int fr, int fq) const {
        const int row0 = u.pm * 256 + wr * 64 + fr;
#pragma unroll
        for (int ai = 0; ai < 2; ++ai) {
            u32x4 gw[2][4][2];
            SCHED_FENCE();
#pragma unroll
            for (int m = 0; m < 4; ++m)
#pragma unroll
                for (int bj = 0; bj < 2; ++bj) gw[ai][m][bj] = *(const u32x4*)(G + (size_t)(row0 + ai * 128 + m * 16) * 2048 + 1024 + u.pn * 256 + bj * 128 + wc * 32 + 8 * fq);
            SCHED_FENCE();
#pragma unroll
            for (int m = 0; m < 4; ++m) {
                const int row = row0 + ai * 128 + m * 16;
#pragma unroll
                for (int bj = 0; bj < 2; ++bj) { const int col = u.pn * 256 + bj * 128 + wc * 32 + 8 * fq;
                    f32x4 a0, a1; unpack8(gw[ai][m][bj], a0, a1);
                    *(u32x4*)(T + (size_t)row * DM + col) = pack8(a0 * acc[ai][bj][m][0], a1 * acc[ai][bj][m][1]); }
            }
        }
    }
};
struct EpiMix2 {
    static constexpr bool PERM = true, AFTER_DRAIN = false;
    const bf16_t* G; const bf16_t* T; bf16_t* O;
    DI void operator()(const f32x4 (&acc)[2][2][4][2], const Unit& u, int wr, int wc, int fr, int fq) const {
        const int row0 = u.pm * 256 + wr * 64 + fr;
#pragma unroll
        for (int ai = 0; ai < 2; ++ai)
#pragma unroll
        for (int mh = 0; mh < 4; mh += 2) {
            u32x4 gw[4][2], tw[4][2];
            SCHED_FENCE();
#pragma unroll
            for (int m = mh; m < mh + 2; ++m)
#pragma unroll
                for (int bj = 0; bj < 2; ++bj) { const int row = row0 + ai * 128 + m * 16, col = u.pn * 256 + bj * 128 + wc * 32 + 8 * fq;
                    gw[m][bj] = *(const u32x4*)(G + (size_t)row * 2048 + col); tw[m][bj] = *(const u32x4*)(T + (size_t)row * DM + col); }
            SCHED_FENCE();
#pragma unroll
            for (int m = mh; m < mh + 2; ++m) {
                const int row = row0 + ai * 128 + m * 16;
#pragma unroll
                for (int bj = 0; bj < 2; ++bj) { const int col = u.pn * 256 + bj * 128 + wc * 32 + 8 * fq;
                    f32x4 s0, s1, t0, t1; unpack8(gw[m][bj], s0, s1); unpack8(tw[m][bj], t0, t1);
                    *(u32x4*)(O + (size_t)row * DM + col) = pack8(s0 * acc[ai][bj][m][0] + t0, s1 * acc[ai][bj][m][1] + t1); }
            }
        }
    }
};

#define MFMA32(a, b, c) __builtin_amdgcn_mfma_f32_32x32x16_bf16((a), (b), (c), 0, 0, 0)
#define MFMA16(a, b, c) __builtin_amdgcn_mfma_f32_16x16x32_bf16((a), (b), (c), 0, 0, 0)
DI bf16x8 frag_from_f32(f32x4 a, f32x4 b) { return __builtin_bit_cast(bf16x8, pack8(a, b)); }

struct ProvBf16 { const bf16_t* A; int ld; static constexpr bool SQ = false; static constexpr int BATCH = 4;
    struct Raw { bf16x8 v; };
    DI Raw load(int r, int k) const { Raw w; w.v = *(const bf16x8*)(A + (size_t)r * ld + k); return w; }
    DI bf16x8 cvt(const Raw& w, float&) const { return w.v; } };
struct ProvAct { const float* raw; static constexpr bool SQ = false; static constexpr int BATCH = 4;
    struct Raw { f32x4 g0, g1, u0, u1; };
    DI Raw load(int r, int k) const { const float* p = raw + (size_t)r * 5632 + 256 * (k >> 7) + (k & 127); Raw w; w.g0 = *(const f32x4*)p; w.g1 = *(const f32x4*)(p + 4); w.u0 = *(const f32x4*)(p + 128); w.u1 = *(const f32x4*)(p + 132); return w; }
    DI bf16x8 cvt(const Raw& w, float&) const { f32x4 a, b;
#pragma unroll
        for (int e = 0; e < 4; ++e) { a[e] = silu(w.g0[e]) * w.u0[e]; b[e] = silu(w.g1[e]) * w.u1[e]; }
        return frag_from_f32(a, b); } };
template <bool HASO> struct ProvX { const float* xs; const float* rawd; const float* rawo; static constexpr bool SQ = true; static constexpr int BATCH = 2;
    struct Raw { f32x4 x0, x1, d0, d1, o0, o1; };
    DI Raw load(int r, int k) const { const size_t o = (size_t)r * DM + k; Raw w; w.x0 = *(const f32x4*)(xs + o); w.x1 = *(const f32x4*)(xs + o + 4); w.d0 = *(const f32x4*)(rawd + o); w.d1 = *(const f32x4*)(rawd + o + 4);
        if (HASO) { w.o0 = *(const f32x4*)(rawo + o); w.o1 = *(const f32x4*)(rawo + o + 4); } return w; }
    DI bf16x8 cvt(const Raw& w, float& ss) const { f32x4 a = w.x0 + w.d0 * 0.5f, b = w.x1 + w.d1 * 0.5f; if (HASO) { a += w.o0; b += w.o1; }
        ss += (a[0] * a[0] + a[1] * a[1]) + (a[2] * a[2] + a[3] * a[3]) + (b[0] * b[0] + b[1] * b[1]) + (b[2] * b[2] + b[3] * b[3]);
        return frag_from_f32(a, b); } };
struct ProvYY { const bf16_t* YG; const float* rawglu; const float* bias; const bf16_t* YY; static constexpr bool SQ = false; static constexpr int BATCH = 3;
    struct Raw { u32x4 y; f32x4 z0, z1, b0, b1; };
    DI Raw load(int r, int k) const { Raw w; const f32x4 z = {0.f, 0.f, 0.f, 0.f}; w.z0 = z; w.z1 = z; w.b0 = z; w.b1 = z;
        if (k >= 512) { w.y = *(const u32x4*)(YY + (size_t)(NPR + r) * 768 + k); }
        else { w.y = *(const u32x4*)(YG + (size_t)(NPR + r) * 512 + k); w.z0 = *(const f32x4*)(rawglu + r * 512 + k); w.z1 = *(const f32x4*)(rawglu + r * 512 + k + 4); w.b0 = *(const f32x4*)(bias + k); w.b1 = *(const f32x4*)(bias + k + 4); }
        return w; }
    DI bf16x8 cvt(const Raw& w, float&, int k) const { return __builtin_bit_cast(bf16x8, w.y); }
    DI bf16x8 cvt(const Raw& w, float&) const { return __builtin_bit_cast(bf16x8, w.y); }
    DI bf16x8 cvtk(const Raw& w, int k) const {
        if (k >= 512) return __builtin_bit_cast(bf16x8, w.y);
        f32x4 y0, y1; unpack8(w.y, y0, y1); f32x4 a, b;
#pragma unroll
        for (int e = 0; e < 4; ++e) { a[e] = y0[e] * sigm(w.z0[e] + w.b0[e]); b[e] = y1[e] * sigm(w.z1[e] + w.b1[e]); }
        return frag_from_f32(a, b); } };
struct ProvMixed { const float* raw3; const float* rawms; const float* rawma; static constexpr bool SQ = false; static constexpr int BATCH = 2;
    struct Raw { f32x4 s0, s1, a0, a1, m0, m1, n0, n1; };
    DI Raw load(int r, int k) const { const float* gs = raw3 + (size_t)r * INW + l2p(2816 + k); const float* ga = raw3 + (size_t)r * INW + l2p(3840 + k);
        Raw w; w.s0 = *(const f32x4*)gs; w.s1 = *(const f32x4*)(gs + 4); w.a0 = *(const f32x4*)ga; w.a1 = *(const f32x4*)(ga + 4);
        w.m0 = *(const f32x4*)(rawms + r * DM + k); w.m1 = *(const f32x4*)(rawms + r * DM + k + 4); w.n0 = *(const f32x4*)(rawma + r * DM + k); w.n1 = *(const f32x4*)(rawma + r * DM + k + 4); return w; }
    DI bf16x8 cvt(const Raw& w, float&) const { f32x4 a, b;
#pragma unroll
        for (int e = 0; e < 4; ++e) { a[e] = sigm(w.s0[e]) * w.m0[e] + sigm(w.a0[e]) * w.n0[e]; b[e] = sigm(w.s1[e]) * w.m1[e] + sigm(w.a1[e]) * w.n1[e]; }
        return frag_from_f32(a, b); } };
template <class P> struct ProvTraits { static constexpr bool NEEDK = false; };
template <> struct ProvTraits<ProvYY> { static constexpr bool NEEDK = true; };
struct SEpiRaw { float* dst; int ld; DI void operator()(int row, int col, float v, float) const { dst[(size_t)row * ld + col] = v; } };
struct SEpiRawScaled { float* dst; int ld; DI void operator()(int row, int col, float v, float rs) const { dst[(size_t)row * ld + col] = v * rs; } };
struct SEpiFinal { const float* xs; const float* rawd; const float* rawo; float* out; DI void operator()(int row, int col, float v, float) const { const size_t o = (size_t)row * DM + col; out[o] = xs[o] + 0.5f * rawd[o] + rawo[o] + 0.5f * v; } };

template <int N, int K, class Prov, class SEpi>
DI void skinny_phase(LAS unsigned char* lds, const bf16_t* Bt, const Prov& P, const SEpi& E) {
    const int tid = otid(), wave = tid >> 6, lane = tid & 63, r = lane & 31, hh = lane >> 5, G = gridDim.x;
    LAS float* red = (LAS float*)lds;
    LAS float* sqp = (LAS float*)(lds + 32768);
    LAS float* rsd = (LAS float*)(lds + 32768 + 2048);
    constexpr int ntiles = N / 32, kper = K / 8, NIT = kper / 32, BATCH = Prov::BATCH;
    for (int tile = G - 1 - (int)blockIdx.x; tile < ntiles; tile += G) {
        const int n0 = tile * 32;
        f32x16 acc = {};
        float ss = 0.f;
        const bf16_t* bp = Bt + (size_t)(n0 + r) * K + wave * kper + 16 * hh;
        const int kbase = wave * kper + 16 * hh;
#pragma unroll
        for (int i0 = 0; i0 < NIT; i0 += BATCH) {
            typename Prov::Raw ra[BATCH][2]; bf16x8 rb[BATCH][2];
            SCHED_FENCE();
#pragma unroll
            for (int u = 0; u < BATCH; ++u) if (i0 + u < NIT) { const int k = kbase + 32 * (i0 + u);
                ra[u][0] = P.load(r, k); ra[u][1] = P.load(r, k + 8); rb[u][0] = *(const bf16x8*)(bp + 32 * (i0 + u)); rb[u][1] = *(const bf16x8*)(bp + 32 * (i0 + u) + 8); }
            SCHED_FENCE();
#pragma unroll
            for (int u = 0; u < BATCH; ++u) if (i0 + u < NIT) { const int k = kbase + 32 * (i0 + u);
                bf16x8 a0, a1;
                if constexpr (ProvTraits<Prov>::NEEDK) { a0 = P.cvtk(ra[u][0], k); a1 = P.cvtk(ra[u][1], k + 8); } else { a0 = P.cvt(ra[u][0], ss); a1 = P.cvt(ra[u][1], ss); }
                acc = MFMA32(a0, rb[u][0], acc); acc = MFMA32(a1, rb[u][1], acc); }
        }
#pragma unroll
        for (int i = 0; i < 16; ++i) red[wave * 1024 + ((i & 3) + 8 * (i >> 2) + 4 * hh) * 32 + r] = acc[i];
        if (Prov::SQ) sqp[(wave * 2 + hh) * 32 + r] = ss;
        __syncthreads();
        if (Prov::SQ) { if (tid < 32) { float sm = 0.f; for (int j = 0; j < 16; ++j) sm += sqp[j * 32 + tid]; rsd[tid] = rsqrtf(sm * (1.f / 1024.f) + EPS); } __syncthreads(); }
#pragma unroll
        for (int h2 = 0; h2 < 2; ++h2) { const int e = tid + 512 * h2; float sm = 0.f;
#pragma unroll
            for (int w = 0; w < 8; ++w) sm += red[w * 1024 + e];
            E(e >> 5, n0 + (e & 31), sm, Prov::SQ ? rsd[e >> 5] : 1.f); }
        __syncthreads();
    }
}

DI int maprow(int mode, int c0) {
    if (mode == 0) return c0;
    if (mode == 1) return 256 * (c0 >> 7) + (c0 & 127);
    if (mode == 2) return 256 * (c0 >> 7) + 128 + (c0 & 127);
    return (c0 & ~255) | (((c0 >> 5) & 1) << 7) | (((c0 >> 6) & 3) << 5);
}
DI void tr_item(const float* W, int N, const float* g, bf16_t* dst, int ldd, int kofs, int mode, int item, LAS float* scr, int lane) {
    const int nblk = N / 32, kb = item / nblk, nb = item % nblk, k0 = 64 * kb, c0 = 32 * nb, p0 = maprow(mode, c0);
    const int kr = lane >> 3, c4 = lane & 7;
    f32x4 v[8];
#pragma unroll
    for (int i = 0; i < 8; ++i) v[i] = *(const f32x4*)(W + (size_t)(k0 + 8 * i + kr) * N + c0 + 4 * c4);
    if (g) {
#pragma unroll
        for (int i = 0; i < 8; ++i) v[i] = v[i] * g[k0 + 8 * i + kr];
    }
#pragma unroll
    for (int i = 0; i < 8; ++i) { LAS float* sp = scr + (8 * i + kr) * 33 + 4 * c4; sp[0] = v[i][0]; sp[1] = v[i][1]; sp[2] = v[i][2]; sp[3] = v[i][3]; }
    LDS_WAIT();
    const int c = lane & 7;
#pragma unroll
    for (int j = 0; j < 4; ++j) { const int n = (lane >> 3) + 8 * j; const LAS float* sq = scr + (8 * c) * 33 + n;
        u32x4 o; o.x = pk2(sq[0 * 33], sq[1 * 33]); o.y = pk2(sq[2 * 33], sq[3 * 33]); o.z = pk2(sq[4 * 33], sq[5 * 33]); o.w = pk2(sq[6 * 33], sq[7 * 33]);
        *(u32x4*)(dst + (size_t)(p0 + n) * ldd + kofs + k0 + 8 * c) = o; }
    LDS_WAIT();
}
DI void norm_rows2_bf16(const float* x0, const float* x1, const float* g, bf16_t* o0, bf16_t* o1, int lane) {
    const f32x4* xr0 = (const f32x4*)x0 + lane; const f32x4* xr1 = (const f32x4*)x1 + lane; const f32x4* gr = (const f32x4*)g + lane;
    f32x4 v[2][4]; float s0 = 0.f, s1 = 0.f;
#pragma unroll
    for (int j = 0; j < 4; ++j) { v[0][j] = xr0[64 * j]; v[1][j] = xr1[64 * j]; }
    SCHED_FENCE();
#pragma unroll
    for (int j = 0; j < 4; ++j) { s0 += (v[0][j][0] * v[0][j][0] + v[0][j][1] * v[0][j][1]) + (v[0][j][2] * v[0][j][2] + v[0][j][3] * v[0][j][3]); s1 += (v[1][j][0] * v[1][j][0] + v[1][j][1] * v[1][j][1]) + (v[1][j][2] * v[1][j][2] + v[1][j][3] * v[1][j][3]); }
    const float r0 = rsqrtf(wave_sum(s0) * (1.f / 1024.f) + EPS), r1 = rsqrtf(wave_sum(s1) * (1.f / 1024.f) + EPS);
    u32x2* p0 = (u32x2*)o0 + lane; u32x2* p1 = (u32x2*)o1 + lane;
#pragma unroll
    for (int j = 0; j < 4; ++j) { const f32x4 gg = gr[64 * j]; const f32x4 w0 = v[0][j] * r0 * gg, w1 = v[1][j] * r1 * gg; u32x2 a, b; a.x = pk2(w0[0], w0[1]); a.y = pk2(w0[2], w0[3]); b.x = pk2(w1[0], w1[1]); b.y = pk2(w1[2], w1[3]); p0[64 * j] = a; p1[64 * j] = b; }
}

constexpr int KVR0 = 32 * 127, KVR1 = KVR0 + 32 * 511, KVR_ALL = KVR1 + 32 * 2047;
constexpr int KVQ = 3;
constexpr int KV_TAIL_P10 = 17184, KV_TAIL_P3 = 8592, KV_TAIL_ROWS = KV_TAIL_P10 + KV_TAIL_P3;
struct KvCopy { f32x4 t[KVQ][2]; f32x4* dp[KVQ]; };
DI void kv_issue(KvCopy& k, const float* c0, const float* c1, const float* c2, float* out, int slot, int lane) {
#pragma unroll
    for (int q = 0; q < KVQ; ++q) {
        const int R0 = KV_TAIL_ROWS + KVQ * slot + q; const int R = R0 < KVR_ALL ? R0 : KVR_ALL - 1;
        const int g = R < KVR0 ? 0 : (R < KVR1 ? 1 : 2); const int Rl = R - (g == 0 ? 0 : (g == 1 ? KVR0 : KVR1));
        const int w = g == 0 ? 128 : (g == 1 ? 512 : 2048), wm1 = w - 1; const int b = g == 0 ? Rl / 127 : (g == 1 ? Rl / 511 : Rl / 2047), r = Rl - b * wm1;
        const f32x4* sp = (const f32x4*)(g == 0 ? c0 : (g == 1 ? c1 : c2)) + ((size_t)b * w + r + 1) * 128 + lane;
        f32x4* d = (f32x4*)(out + (g == 0 ? O_KVS0 : (g == 1 ? O_KVS1 : O_KVS2))) + ((size_t)b * w + r) * 128 + lane;
        k.dp[q] = R0 < KVR_ALL ? d : nullptr;
        k.t[q][0] = __builtin_nontemporal_load(sp); k.t[q][1] = __builtin_nontemporal_load(sp + 64);
    }
}
DI void kv_commit(const KvCopy& k) {
#pragma unroll
    for (int q = 0; q < KVQ; ++q) if (k.dp[q]) { __builtin_nontemporal_store(k.t[q][0], k.dp[q]); __builtin_nontemporal_store(k.t[q][1], k.dp[q] + 64); }
}

struct SsmPar { float abr, abi, fr, fi; };
DI SsmPar ssm_par(const float* a_re, const float* a_im, const float* log_dt, int g, int p) {
    const float ar = a_re[g * 64 + p], ai = a_im[g * 64 + p], dt = expf(log_dt[g]);
    const float mag = expf(ar * dt); SsmPar o; o.abr = mag * cosf(ai * dt); o.abi = mag * sinf(ai * dt);
    const float inv = 1.0f / (ar * ar + ai * ai);
    o.fr = ((o.abr - 1.0f) * ar + o.abi * ai) * inv; o.fi = (o.abi * ar - (o.abr - 1.0f) * ai) * inv; return o;
}
struct SsmIn { const float *a_re, *a_im, *log_dt, *b_re, *b_im, *c_re, *c_im, *dsk; };

constexpr size_t WS_SSMT = 576 * 1024, SSMT_TC = 32 * 8 * 64 * 16, SSMT_TA = SSMT_TC + 32 * 4 * 64 * 16;
DI void ssm_build_tables(const SsmIn& W, unsigned char* tb, int g, int lane) {
    const int l15 = lane & 15, quad = lane >> 4;
    { const SsmPar sp = ssm_par(W.a_re, W.a_im, W.log_dt, g, lane); f32x2 ab = {sp.abr, sp.abi}; ((f32x2*)(tb + SSMT_TA))[g * 64 + lane] = ab; }
#pragma unroll
    for (int q = 0; q < 4; ++q) {
        const int p = 16 * q + l15; const SsmPar sp = ssm_par(W.a_re, W.a_im, W.log_dt, g, p);
        f32x4 re0 = {0, 0, 0, 0}, re1 = re0, im0 = re0, im1 = re0;
        if (quad < 2) { const float* br = W.b_re + ((size_t)(g * 64 + p)) * 16 + 8 * quad; const float* bi = W.b_im + ((size_t)(g * 64 + p)) * 16 + 8 * quad;
            const f32x4 r0 = *(const f32x4*)br, r1 = *(const f32x4*)(br + 4), i0 = *(const f32x4*)bi, i1 = *(const f32x4*)(bi + 4);
            re0 = r0 * sp.fr - i0 * sp.fi; re1 = r1 * sp.fr - i1 * sp.fi; im0 = i0 * sp.fr + r0 * sp.fi; im1 = i1 * sp.fr + r1 * sp.fi; }
        ((bf16x8*)tb)[(g * 8 + q) * 64 + lane] = frag_from_f32(re0, re1); ((bf16x8*)tb)[(g * 8 + q + 4) * 64 + lane] = frag_from_f32(im0, im1);
    }
#pragma unroll
    for (int s2 = 0; s2 < 4; ++s2) { const int p0 = 32 * (s2 & 1) + 8 * quad; const float* cp = (s2 < 2 ? W.c_re : W.c_im) + ((size_t)(g * 16 + l15)) * 64 + p0;
        f32x4 c0 = *(const f32x4*)cp, c1 = *(const f32x4*)(cp + 4); if (s2 >= 2) { c0 = -c0; c1 = -c1; } ((bf16x8*)(tb + SSMT_TC))[(g * 4 + s2) * 64 + lane] = frag_from_f32(c0, c1); }
}
struct KvSrc { const float *c0, *c1, *c2; float* out; int slotbase; };

DI void kvshift_rows(const float* c0, const float* c1, const float* c2, float* out, int r_lo, int r_hi, int wk, int nwk, int wave, int lane) {
    const int stride = nwk * 8;
    for (int R0 = r_lo + wk * 8 + wave; R0 < r_hi; R0 += 8 * stride) {
        f32x4 t[8][2]; f32x4* dp[8];
#pragma unroll
        for (int q = 0; q < 8; ++q) {
            int R = R0 + q * stride; R = R < r_hi ? R : r_hi - 1;
            const int g = R < KVR0 ? 0 : (R < KVR1 ? 1 : 2); const int Rl = R - (g == 0 ? 0 : (g == 1 ? KVR0 : KVR1));
            const int w = g == 0 ? 128 : (g == 1 ? 512 : 2048), wm1 = w - 1; const int b = g == 0 ? Rl / 127 : (g == 1 ? Rl / 511 : Rl / 2047), r = Rl - b * wm1;
            const f32x4* sp = (const f32x4*)(g == 0 ? c0 : (g == 1 ? c1 : c2)) + ((size_t)b * w + r + 1) * 128 + lane;
            dp[q] = (f32x4*)(out + (g == 0 ? O_KVS0 : (g == 1 ? O_KVS1 : O_KVS2))) + ((size_t)b * w + r) * 128 + lane;
            t[q][0] = __builtin_nontemporal_load(sp); t[q][1] = __builtin_nontemporal_load(sp + 64);
        }
        SCHED_FENCE();
#pragma unroll
        for (int q = 0; q < 8; ++q) if (R0 + q * stride < r_hi) { __builtin_nontemporal_store(t[q][0], dp[q]); __builtin_nontemporal_store(t[q][1], dp[q] + 64); }
    }
}
DI void kvshift_tail(const float* c0, const float* c1, const float* c2, float* out, int nwg, int r_lo, int r_hi, int wave, int lane) {
    const int G = gridDim.x; const int first = nwg % G; const int wk = (int)blockIdx.x - first;
    if (wk >= 0) kvshift_rows(c0, c1, c2, out, r_lo, r_hi, wk, G - first, wave, lane);
}
template <bool PASS2>
DI void ssm_pass(LAS unsigned char* lds, const SsmIn& W, const unsigned char* TBL, const bf16_t* U, float* SEND, const float* SIN, bf16_t* YG, const KvSrc& KS) {
    const int tid = otid(), wave = tid >> 6, lane = tid & 63, l15 = lane & 15, quad = lane >> 4;
    LAS float* Xs = (LAS float*)(lds + wave * 13312);
    LAS bf16_t* Ss = (LAS bf16_t*)(lds + wave * 13312 + 8448);
    LAS bf16_t* Us = (LAS bf16_t*)(lds + wave * 13312 + 12800);
    const int NGW = gridDim.x * 8, gw = blockIdx.x * 8 + wave;
    int gcur = -1; bf16x8 bfr[8]; bf16x8 cfr[4]; float abr = 0.f, abi = 0.f, dk = 0.f;
    for (int it = gw; it < 2 * NCH * 32; it += NGW) {
        const int g = it & 31, bc = it >> 5, b = bc >> 7, ch = bc & 127;
        KvCopy kc; kv_issue(kc, KS.c0, KS.c1, KS.c2, KS.out, KS.slotbase + it, lane);
        const int rowc = b * SEQ + ch * TCH;
        bf16x8 uf[4];
#pragma unroll
        for (int sub = 0; sub < 4; ++sub) { uf[sub] = (bf16x8){0, 0, 0, 0, 0, 0, 0, 0}; if (quad < 2) uf[sub] = *(const bf16x8*)(U + (size_t)(rowc + 16 * sub + l15) * 512 + 16 * g + 8 * quad); }
        float sr = 0.f, si = 0.f;
        const size_t sbase = ((size_t)(b * NCH + ch) * 32 + g) * 128;
        if (PASS2) { sr = SIN[sbase + lane]; si = SIN[sbase + 64 + lane]; }
        __builtin_amdgcn_sched_barrier(0);
        if (g != gcur) {
            gcur = g;
            { const f32x2 ab = ((const f32x2*)(TBL + SSMT_TA))[g * 64 + lane]; abr = ab[0]; abi = ab[1]; }
#pragma unroll
            for (int q = 0; q < 8; ++q) bfr[q] = ((const bf16x8*)TBL)[(g * 8 + q) * 64 + lane];
            if (PASS2) {
#pragma unroll
                for (int s2 = 0; s2 < 4; ++s2) cfr[s2] = ((const bf16x8*)(TBL + SSMT_TC))[(g * 4 + s2) * 64 + lane];
                dk = W.dsk[g * 16 + l15];
            }
        }
#pragma unroll
        for (int sub = 0; sub < 4; ++sub) {
            const int row0 = rowc + 16 * sub;
            if (PASS2) { if (quad < 2) *(LAS bf16x8*)(Us + l15 * 16 + 8 * quad) = uf[sub]; }
#pragma unroll
            for (int nt = 0; nt < 8; ++nt) { f32x4 x = {0.f, 0.f, 0.f, 0.f}; x = MFMA16(uf[sub], bfr[nt], x);
#pragma unroll
                for (int j = 0; j < 4; ++j) Xs[(4 * quad + j) * 132 + 16 * nt + l15] = x[j]; }
            LDS_WAIT();
#pragma unroll
            for (int tok = 0; tok < 16; ++tok) {
                const float xr = Xs[tok * 132 + lane], xi = Xs[tok * 132 + 64 + lane];
                const float nr = abr * sr - abi * si + xr, ni = abr * si + abi * sr + xi; sr = nr; si = ni;
                if (PASS2) { Ss[tok * 136 + lane] = f2bf(sr); Ss[tok * 136 + 64 + lane] = f2bf(si); }
            }
            LDS_WAIT();
            if (PASS2) {
                f32x4 y = {0.f, 0.f, 0.f, 0.f};
#pragma unroll
                for (int s2 = 0; s2 < 4; ++s2) { const bf16x8 af = *(const LAS bf16x8*)(Ss + l15 * 136 + 32 * s2 + 8 * quad); y = MFMA16(af, cfr[s2], y); }
#pragma unroll
                for (int j = 0; j < 4; ++j) { const float uv = bf2f(Us[(4 * quad + j) * 16 + l15]); YG[(size_t)(row0 + 4 * quad + j) * 512 + 16 * g + l15] = f2bf(gelu_tanh(y[j] + dk * uv)); }
                LDS_WAIT();
            }
        }
        if (!PASS2) { SEND[sbase + lane] = sr; SEND[sbase + 64 + lane] = si; }
        kv_commit(kc);
    }
}

DI void ssm_carry(const SsmIn& W, const float* SEND, float* SIN, float* out_re, float* out_im) {
    for (int gt = blockIdx.x * 512 + otid(); gt < 2 * 32 * 64; gt += gridDim.x * 512) {
        const int b = gt >> 11, g = (gt >> 6) & 31, p = gt & 63;
        const SsmPar sp = ssm_par(W.a_re, W.a_im, W.log_dt, g, p);
        float tr = sp.abr, ti = sp.abi;
#pragma unroll
        for (int i = 0; i < 6; ++i) { const float nr = tr * tr - ti * ti, ni = 2.f * tr * ti; tr = nr; ti = ni; }
        float sr = 0.f, si = 0.f;
        for (int c0 = 0; c0 < NCH; c0 += 32) {
            float er[32], ei[32];
#pragma unroll
            for (int j = 0; j < 32; ++j) { const size_t o = ((size_t)(b * NCH + c0 + j) * 32 + g) * 128; er[j] = SEND[o + p]; ei[j] = SEND[o + 64 + p]; }
            SCHED_FENCE();
#pragma unroll
            for (int j = 0; j < 32; ++j) { const size_t o = ((size_t)(b * NCH + c0 + j) * 32 + g) * 128; SIN[o + p] = sr; SIN[o + 64 + p] = si;
                const float nr = tr * sr - ti * si + er[j], ni = tr * si + ti * sr + ei[j]; sr = nr; si = ni; }
        }
        out_re[gt] = sr; out_im[gt] = si;
    }
}

DI void attn_unit(int b, int g, int h, int dl, int rho, int m0, const bf16_t* Q, const bf16_t* K, const bf16_t* V, bf16_t* OG, float* ML, LAS bf16_t* Vs, int lane) {
    const int r = lane & 31, hh = lane >> 5; const int rowb = b * SEQ; const int co = g * 256 + h * 64;
    const int rowq = rowb + rho + ((m0 + r) << dl);
    bf16x8 qf[4]; bf16x8 kf[5][4];
    { const bf16x8* qp = (const bf16x8*)(Q + (size_t)rowq * 768 + co + 32 * hh);
#pragma unroll
      for (int s = 0; s < 4; ++s) qf[s] = qp[s]; }
#pragma unroll
    for (int kb = 0; kb < 5; ++kb) {
        int mk = m0 - 128 + 32 * kb + r; mk = mk < 0 ? 0 : mk;
        const bf16x8* kp = (const bf16x8*)(K + (size_t)(rowb + rho + (mk << dl)) * 768 + co + 32 * hh);
#pragma unroll
        for (int s = 0; s < 4; ++s) kf[kb][s] = kp[s];
    }
    const bf16_t* vbase = V + (size_t)(rowb + rho) * 768 + co + 8 * (lane & 7);
    u32x4 vreg[4];
#define ATT_VLOAD(kb_) do { _Pragma("unroll") for (int i_ = 0; i_ < 4; ++i_) { int kidx_ = m0 - 128 + 32 * (kb_) + 8 * i_ + (lane >> 3); kidx_ = kidx_ < 0 ? 0 : kidx_; \
        vreg[i_] = *(const u32x4*)(vbase + (size_t)(kidx_ << dl) * 768); } } while (0)
#define ATT_VSTORE(buf_) do { _Pragma("unroll") for (int i_ = 0; i_ < 4; ++i_) *(LAS u32x4*)(Vs + (buf_) * 2304 + (8 * i_ + (lane >> 3)) * 72 + 8 * (lane & 7)) = vreg[i_]; } while (0)
    SCHED_FENCE();
    f32x16 st[5];
#pragma unroll
    for (int kb = 0; kb < 5; ++kb) {
        f32x16 a = {};
#pragma unroll
        for (int s = 0; s < 4; ++s) a = MFMA32(kf[kb][s], qf[s], a);
        st[kb] = a;
    }
    SCHED_FENCE();
    ATT_VLOAD(0);
    SCHED_FENCE();
    float mx = -INFINITY; const bool early = m0 < 128;
#pragma unroll
    for (int kb = 0; kb < 5; ++kb)
#pragma unroll
        for (int i = 0; i < 16; ++i) {
            const int c = (i & 3) + 8 * (i >> 2) + 4 * hh; const int kidx = m0 - 128 + 32 * kb + c; const int j = r + 128 - 32 * kb - c;
            float v = st[kb][i];
            if (kb == 0) v = (j <= 128) ? v : -INFINITY;
            if (kb == 4) v = (j >= 0) ? v : -INFINITY;
            if (early) v = (kidx >= 0) ? v : -INFINITY;
            st[kb][i] = v; mx = fmaxf(mx, v);
        }
    mx = fmaxf(mx, __shfl_xor(mx, 32));
    float den = 0.f;
#pragma unroll
    for (int kb = 0; kb < 5; ++kb)
#pragma unroll
        for (int i = 0; i < 16; ++i) { const float p = __builtin_amdgcn_exp2f(st[kb][i] - mx); st[kb][i] = p; den += p; }
    den += __shfl_xor(den, 32);
    SCHED_FENCE();
    ATT_VSTORE(0);
    ATT_VLOAD(1);
    SCHED_FENCE();
    f32x16 ot[2] = {{}, {}};
#pragma unroll
    for (int kb = 0; kb < 5; ++kb) {
        LDS_WAIT();
#pragma unroll
        for (int c = 0; c < 2; ++c) {
            f32x4 p0, p1;
#pragma unroll
            for (int e = 0; e < 4; ++e) { p0[e] = st[kb][8 * c + e]; p1[e] = st[kb][8 * c + 4 + e]; }
            const bf16x8 pf = frag_from_f32(p0, p1);
#pragma unroll
            for (int db = 0; db < 2; ++db) {
                bf16x8 vf;
#pragma unroll
                for (int jj = 0; jj < 8; ++jj) vf[jj] = (short)Vs[(kb & 1) * 2304 + (16 * c + 8 * (jj >> 2) + 4 * hh + (jj & 3)) * 72 + 32 * db + r];
                ot[db] = MFMA32(vf, pf, ot[db]);
            }
        }
        SCHED_FENCE();
        if (kb < 4) { ATT_VSTORE((kb + 1) & 1); if (kb < 3) ATT_VLOAD(kb + 2); }
        SCHED_FENCE();
    }
    LDS_WAIT();
#undef ATT_VLOAD
#undef ATT_VSTORE
    const float inv = 1.0f / den;
    bf16_t* op = OG + ((size_t)g * MT + rowq) * 256 + h * 64;
#pragma unroll
    for (int db = 0; db < 2; ++db)
#pragma unroll
        for (int ig = 0; ig < 4; ++ig) { u32x2 w; w.x = pk2(ot[db][4 * ig] * inv, ot[db][4 * ig + 1] * inv); w.y = pk2(ot[db][4 * ig + 2] * inv, ot[db][4 * ig + 3] * inv);
            *(u32x2*)(op + 32 * db + 8 * ig + 4 * hh) = w; }
    if (hh == 0) { f32x2 ml = {mx, den}; *(f32x2*)(ML + (((size_t)g * MT + rowq) * 4 + h) * 2) = ml; }
}
DI void attn_prompt_phase(LAS unsigned char* lds, const bf16_t* Q, const bf16_t* K, const bf16_t* V, bf16_t* OG, float* ML, const KvSrc& KS) {
    const int tid = otid(); const int wave = tid >> 6, lane = tid & 63; const int NGW = gridDim.x * 8, gw = blockIdx.x * 8 + wave;
    for (int it = gw; it < 2 * 3 * 4 * 256; it += NGW) {
        const int tile = it & 255, h = (it >> 8) & 3, gb = it >> 10, g = gb % 3, b = gb / 3;
        const int dl = 2 * g;
        const int tpc = 256 >> dl;
        KvCopy kc; kv_issue(kc, KS.c0, KS.c1, KS.c2, KS.out, KS.slotbase + it, lane);
        SCHED_FENCE();
        attn_unit(b, g, h, dl, tile / tpc, 32 * (tile % tpc), Q, K, V, OG, ML, (LAS bf16_t*)(lds + wave * 9216), lane);
        SCHED_FENCE();
        kv_commit(kc);
    }
}
DI void attn_combine(const bf16_t* OG, const float* ML, bf16_t* YY) {
    for (int it = blockIdx.x * 512 + otid(); it < MT * 32; it += gridDim.x * 512) {
        const int row = it >> 5, h = (it >> 3) & 3, dc = it & 7;
        float m[3], dn[3];
#pragma unroll
        for (int g = 0; g < 3; ++g) { const f32x2 v = *(const f32x2*)(ML + (((size_t)g * MT + row) * 4 + h) * 2); m[g] = v[0]; dn[g] = v[1]; }
        const float mt = fmaxf(m[0], fmaxf(m[1], m[2]));
        f32x4 a0 = {0, 0, 0, 0}, a1 = a0; float wsum = 0.f;
#pragma unroll
        for (int g = 0; g < 3; ++g) { const float w = dn[g] * __builtin_amdgcn_exp2f(m[g] - mt); wsum += w; f32x4 o0, o1; unpack8(*(const u32x4*)(OG + ((size_t)g * MT + row) * 256 + h * 64 + 8 * dc), o0, o1); a0 += o0 * w; a1 += o1 * w; }
        const float inv = 1.0f / wsum;
        *(u32x4*)(YY + (size_t)row * 768 + 512 + h * 64 + 8 * dc) = pack8(a0 * inv, a1 * inv);
    }
}

DI void sample_attn_item(int s, int h, int g, const float* raw3, const float* gqk, const float* cp, float* ko, bf16_t* OG, float* ML, LAS float* sl, int lane) {
    const float* r3 = raw3 + (size_t)s * INW;
    const int w = g == 0 ? 128 : (g == 1 ? 512 : 2048), dl = 2 * g;
    const float q = r3[l2p(512 + 256 * g + 64 * h + lane)], k = r3[l2p(1280 + 256 * g + 64 * h + lane)], v = r3[l2p(2048 + 256 * g + 64 * h + lane)];
    const float qs = wave_sum(q * q), ks = wave_sum(k * k);
    const float qv = q * rsqrtf(qs * (1.f / 64.f) + EPS) * gqk[g * 64 + lane] * QSCALE, kn = k * rsqrtf(ks * (1.f / 64.f) + EPS) * gqk[192 + g * 64 + lane];
    sl[lane] = qv; sl[192 + lane] = v;
    ko[((size_t)(s * w + (w - 1)) * 2 + 0) * 256 + h * 64 + lane] = kn; ko[((size_t)(s * w + (w - 1)) * 2 + 1) * 256 + h * 64 + lane] = v;
    const float s0 = wave_sum(qv * kn);
    LDS_WAIT();
    float sc[2];
#pragma unroll
    for (int half = 0; half < 2; ++half) {
        const int j = 1 + lane + 64 * half; const int rr = w - (j << dl);
        const float* kp = cp + ((size_t)(s * w + rr) * 2 + 0) * 256 + h * 64; float a = 0.f;
#pragma unroll
        for (int d4 = 0; d4 < 16; ++d4) { const f32x4 kk = *(const f32x4*)(kp + 4 * d4); const f32x4 qq = *(const LAS f32x4*)(sl + 4 * d4); a += (kk[0] * qq[0] + kk[1] * qq[1]) + (kk[2] * qq[2] + kk[3] * qq[3]); }
        sc[half] = a;
    }
    const float mx = wave_max(fmaxf(s0, fmaxf(sc[0], sc[1])));
    const float e0 = __builtin_amdgcn_exp2f(s0 - mx), p0 = __builtin_amdgcn_exp2f(sc[0] - mx), p1 = __builtin_amdgcn_exp2f(sc[1] - mx);
    const float den = wave_sum(p0 + p1) + e0;
    sl[64 + lane] = p0; sl[128 + lane] = p1;
    LDS_WAIT();
    const int d4 = lane & 15, kq = lane >> 4;
    f32x4 o = {0.f, 0.f, 0.f, 0.f};
#pragma unroll 8
    for (int i = 0; i < 32; ++i) { const int j = 1 + kq + 4 * i; const int rr = w - (j << dl);
        const f32x4 vv = *(const f32x4*)(cp + ((size_t)(s * w + rr) * 2 + 1) * 256 + h * 64 + 4 * d4); o += vv * sl[64 + j - 1]; }
#pragma unroll
    for (int e = 0; e < 4; ++e) { o[e] += __shfl_xor(o[e], 16); o[e] += __shfl_xor(o[e], 32); }
    if (lane < 16) {
        const f32x4 vn = *(const LAS f32x4*)(sl + 192 + 4 * d4); const float inv = 1.0f / den;
        o = (o + vn * e0) * inv;
        u32x2 wv; wv.x = pk2(o[0], o[1]); wv.y = pk2(o[2], o[3]);
        *(u32x2*)(OG + ((size_t)g * MT + NPR + s) * 256 + h * 64 + 4 * d4) = wv;
    }
    if (lane == 0) { f32x2 ml = {mx, den}; *(f32x2*)(ML + (((size_t)g * MT + NPR + s) * 4 + h) * 2) = ml; }
    LDS_WAIT();
}
DI void sample_ssm_item(int s, int g, const SsmIn& W, const float* raw3, const float* st_re, const float* st_im, float* out_re, float* out_im, bf16_t* YG, int lane) {
    const SsmPar sp = ssm_par(W.a_re, W.a_im, W.log_dt, g, lane);
    const float* r3 = raw3 + (size_t)s * INW;
    float xr = 0.f, xi = 0.f;
    const float* br = W.b_re + (size_t)(g * 64 + lane) * 16; const float* bi = W.b_im + (size_t)(g * 64 + lane) * 16;
#pragma unroll
    for (int c = 0; c < 16; ++c) { const float u = r3[l2p(16 * g + c)]; const float bbr = sp.fr * br[c] - sp.fi * bi[c], bbi = sp.fr * bi[c] + sp.fi * br[c]; xr += bbr * u; xi += bbi * u; }
    const size_t so = (size_t)(s * 32 + g) * 64 + lane;
    const float s0r = st_re[so], s0i = st_im[so];
    const float nr = sp.abr * s0r - sp.abi * s0i + xr, ni = sp.abr * s0i + sp.abi * s0r + xi;
    out_re[so] = nr; out_im[so] = ni;
    float ysel = 0.f;
#pragma unroll
    for (int c = 0; c < 16; ++c) { const float y = wave_sum(W.c_re[(size_t)(g * 16 + c) * 64 + lane] * nr - W.c_im[(size_t)(g * 16 + c) * 64 + lane] * ni); if (lane == c) ysel = y; }
    if (lane < 16) { const float u = r3[l2p(16 * g + lane)]; YG[(size_t)(NPR + s) * 512 + 16 * g + lane] = f2bf(gelu_tanh(ysel + W.dsk[16 * g + lane] * u)); }
}

struct Args { const float* in[32]; float* out; unsigned char* ws; };

__global__ void __launch_bounds__(512, 2) mega_fwd(Args a) {
    extern __shared__ __attribute__((aligned(16))) unsigned char lds_raw[];
    LAS unsigned char* lds = (LAS unsigned char*)lds_raw;
    cg::grid_group grid = cg::this_grid();
    const int tid = threadIdx.x, lane = tid & 63, wave = __builtin_amdgcn_readfirstlane(tid >> 6);
    const int G = gridDim.x, blk = blockIdx.x, gw = blk * 8 + wave, NGW = G * 8;
    unsigned char* const ws = a.ws;
    if (tid < 16) ((LAS unsigned*)(lds + 131072))[tid] = 0u;
    __syncthreads();
    unsigned* const barw = (unsigned*)(ws + 512 * 1024);
    const XcdBarrier xb = xcd_barrier_post(barw, (volatile LAS unsigned*)(lds + 131072 + 32));
#define W1GU ((bf16_t*)(ws + WS_W1GU))
#define W1D ((bf16_t*)(ws + WS_W1D))
#define WIN ((bf16_t*)(ws + WS_WIN))
#define WGLU ((bf16_t*)(ws + WS_WGLU))
#define WSP ((bf16_t*)(ws + WS_WMIX))
#define WAP ((bf16_t*)(ws + WS_WMIX + MiB))
#define TBUF ((bf16_t*)(ws + WS_X1 + 33 * MiB))
#define WO ((bf16_t*)(ws + WS_WO))
#define W2GU ((bf16_t*)(ws + WS_W2GU))
#define W2D ((bf16_t*)(ws + WS_W2D))
#define SEND ((float*)(ws + WS_SEND))
#define SIN ((float*)(ws + WS_SIN))
#define ML ((float*)(ws + WS_ML))
#define SQ1 ((float*)(ws + WS_SQ1))
#define SQ2 ((float*)(ws + WS_SQ2))
#define SR ((float*)(ws + WS_SRAW))
#define XN ((bf16_t*)(ws + WS_XN))
#define X1B ((bf16_t*)(ws + WS_X1B))
#define ACT ((bf16_t*)(ws + WS_ACT))
#define GT ((bf16_t*)(ws + WS_G))
#define OG ((bf16_t*)(ws + WS_OG))
#define YG ((bf16_t*)(ws + WS_YG))
#define YY ((bf16_t*)(ws + WS_YY))
#define X1 ((float*)(ws + WS_X1))
#define GQK ((float*)ws)
#define X2B XN
#define MIXED ((bf16_t*)(ws + WS_X1))
#define Ub ACT
#define Qb (ACT + (size_t)MT * 512)
#define Kb (ACT + (size_t)MT * 512 + (size_t)MT * 768)
#define Vb (ACT + (size_t)MT * 512 + (size_t)MT * 1536)
#define raw1 (SR + SR_RAW1)
#define rawd (SR + SR_RAWD)
#define raw3 (SR + SR_RAW3)
#define rawglu (SR + SR_RAWGLU)
#define rawms (SR + SR_RAWMIX)
#define rawma (SR + SR_RAWMIX + 32 * 1024)
#define rawo (SR + SR_RAWO)
#define raw10 (SR + SR_RAW10)
#define xp (a.in[0])
#define xs (a.in[1])
    float* const out = a.out;
#define SSM_IN(SW) SsmIn SW; SW.a_re = a.in[15]; SW.a_im = a.in[16]; SW.log_dt = a.in[17]; SW.b_re = a.in[18]; SW.b_im = a.in[19]; SW.c_re = a.in[20]; SW.c_im = a.in[21]; SW.dsk = a.in[22];

    constexpr int I_GU = 16 * 88, I_DN = 44 * 32, I_IN = 16 * 152, I_GL = 8 * 16, I_SP = 8 * 32, I_AP = 4 * 32, I_WO = 16 * 32;
#ifndef REP_P0
#define REP_P0 1
#endif
    for (int rep0 = 0; rep0 < REP_P0; ++rep0) {
        LAS float* scr = (LAS float*)(lds + wave * 16384);
        constexpr int NIT = 3 * I_GU + I_IN + I_GL + I_SP + I_AP + I_WO + 3 * I_GU;
        static_assert(I_DN == I_GU, "item counts");
        (void)NIT;
#define TR_JOB(CNT, ...) for (int r = gw; r < (CNT); r += NGW) tr_item(__VA_ARGS__, r, scr, lane);
        TR_JOB(I_GU, a.in[8], FF, nullptr, W1GU, 1024, 0, 1)
        TR_JOB(I_GU, a.in[9], FF, nullptr, W1GU, 1024, 0, 2)
        TR_JOB(I_IN, a.in[12], INW, a.in[11], WIN, 1024, 0, 3)
#undef TR_JOB
        for (int i = blk * 512 + tid; i < NPR; i += G * 512) { SQ1[i] = 0.f; SQ2[i] = 0.f; }
        for (int i = blk * 512 + tid; i < 384; i += G * 512) GQK[i] = i < 192 ? a.in[13][i] : a.in[14][i - 192];
        if (gw >= NGW - 32) { SSM_IN(SWT) ssm_build_tables(SWT, ws + WS_SSMT, gw - (NGW - 32), lane); }
        for (int m = gw; m < MT; m += 2 * NGW) { const int m1 = (m + NGW < MT) ? m + NGW : m;
            norm_rows2_bf16(m < NPR ? xp + (size_t)m * DM : xs + (size_t)(m - NPR) * DM, m1 < NPR ? xp + (size_t)m1 * DM : xs + (size_t)(m1 - NPR) * DM, a.in[7], XN + (size_t)m * DM, XN + (size_t)m1 * DM, lane); }
    }
    if (a.ws == nullptr) grid.sync();
    xcd_barrier(xb);
    {
        pg8::Gemm g{XN, W1GU, NPR, 2 * FF, DM}; pg8::StaticOrder S; S.init(NPR, 2 * FF, G, blk);
        EpiAct<false> E{ACT, nullptr};
        pg8::gemm_phase<EpiAct<false>, pg8::StaticOrder, true, true>(lds, g, S, E);
        ProvBf16 P{XN + (size_t)NPR * DM, DM}; SEpiRaw SE{raw1, 5632};
        skinny_phase<2 * FF, DM>(lds, W1GU, P, SE);
        { const int first = (64 * 22) % G; const int wk = blk - first;
          if (wk >= 0) { LAS float* scr = (LAS float*)(lds + wave * 16384); const int gw2 = wk * 8 + wave, NGW2 = (G - first) * 8;
#define TR_JOB2(CNT, ...) for (int r = gw2; r < (CNT); r += NGW2) tr_item(__VA_ARGS__, r, scr, lane);
            TR_JOB2(I_DN, a.in[10], DM, nullptr, W1D, FF, 0, 0)
            TR_JOB2(I_GL, a.in[23], 512, nullptr, WGLU, 512, 0, 0)
            TR_JOB2(I_SP, a.in[25], DM, nullptr, WSP, 512, 0, 0)
            TR_JOB2(I_AP, a.in[26], DM, nullptr, WAP, 256, 0, 0)
            TR_JOB2(I_WO, a.in[27], DM, nullptr, WO, 1024, 0, 0)
            TR_JOB2(I_GU, a.in[29], FF, a.in[28], W2GU, 1024, 0, 1)
            TR_JOB2(I_GU, a.in[30], FF, a.in[28], W2GU, 1024, 0, 2)
            TR_JOB2(I_DN, a.in[31], DM, nullptr, W2D, FF, 0, 0)
#undef TR_JOB2
          } }
    }
    xcd_barrier(xb);
    {
        pg8::Gemm g{ACT, W1D, NPR, DM, FF}; pg8::StaticOrder S; S.init(NPR, DM, G, blk);
        EpiRes<false> E{xp, nullptr, X1B, SQ1, 0.5f};
        pg8::gemm_phase<EpiRes<false>, pg8::StaticOrder, true, true, -1>(lds, g, S, E);
        ProvAct P{raw1}; SEpiRaw SE{rawd, DM};
        skinny_phase<DM, FF>(lds, W1D, P, SE);
    }
    xcd_barrier(xb);
    {
        pg8::Gemm g{X1B, WIN, NPR, INW, DM}; pg8::StaticOrder S; S.init(NPR, INW, G, blk);
        EpiWin E{SQ1, ACT, GT, GQK, out};
        pg8::gemm_phase<EpiWin, pg8::StaticOrder, true, true>(lds, g, S, E);
        ProvX<false> P{xs, rawd, nullptr}; SEpiRawScaled SE{raw3, INW};
        skinny_phase<INW, DM>(lds, WIN, P, SE);
        kvshift_tail(a.in[2], a.in[3], a.in[4], out, 64 * 19, KV_TAIL_P10, KV_TAIL_ROWS, wave, lane);
    }
    xcd_barrier(xb);
#ifndef REP_P456
#define REP_P456 1
#endif
    for (int rep4 = 0; rep4 < REP_P456; ++rep4) {
    {
        SSM_IN(SW)
        { const KvSrc KS{a.in[2], a.in[3], a.in[4], out, 0}; ssm_pass<false>(lds, SW, ws + WS_SSMT, Ub, SEND, nullptr, nullptr, KS); }
        __syncthreads();
        { const KvSrc KS{a.in[2], a.in[3], a.in[4], out, 8192}; attn_prompt_phase(lds, Qb, Kb, Vb, OG, ML, KS); }
        LAS float* sl = (LAS float*)(lds + 110592 + wave * 2560);
        for (int it = gw; it < 384; it += NGW) { const int g = it % 3, sh = it / 3;
            sample_attn_item(sh >> 2, sh & 3, g, raw3, GQK, g == 0 ? a.in[2] : (g == 1 ? a.in[3] : a.in[4]), out + (g == 0 ? O_KVS0 : (g == 1 ? O_KVS1 : O_KVS2)), OG, ML, sl, lane); }
        for (int it = NGW - 1 - gw; it < 1024; it += NGW) sample_ssm_item(it >> 5, it & 31, SW, raw3, a.in[5], a.in[6], out + O_SRES, out + O_SIMS, YG, lane);
    }
    xcd_barrier(xb);
    {
        SSM_IN(SW)
        ssm_carry(SW, SEND, SIN, out + O_SREP, out + O_SIMP);
        attn_combine(OG, ML, YY);
    }
    xcd_barrier(xb);
    { SSM_IN(SW)
      const KvSrc KS{a.in[2], a.in[3], a.in[4], out, 14336}; ssm_pass<true>(lds, SW, ws + WS_SSMT, Ub, nullptr, SIN, YG, KS); }
    xcd_barrier(xb);
    }
    {
        { pg8::Gemm g{YG, WGLU, NPR, 512, 512}; pg8::StaticOrder S; S.init(NPR, 512, G, blk);
          EpiGlu E{YG, a.in[24], YY};
          pg8::gemm_phase<EpiGlu, pg8::StaticOrder, true, true>(lds, g, S, E); }
        { pg8::Gemm g{YY + 512, WAP, NPR, DM, 256}; pg8::StaticOrder S; S.init(NPR, DM, G, blk);
          EpiGateScale E{GT, TBUF};
          pg8::gemm_phase<EpiGateScale, pg8::StaticOrder, true, true, 768>(lds, g, S, E); }
        { ProvBf16 P{YG + (size_t)NPR * 512, 512}; SEpiRaw SE{rawglu, 512};
          skinny_phase<512, 512>(lds, WGLU, P, SE); }
        { ProvBf16 P{YY + (size_t)NPR * 768 + 512, 768}; SEpiRaw SE{rawma, DM};
          skinny_phase<DM, 256>(lds, WAP, P, SE); }
    }
    xcd_barrier(xb);
    {
        pg8::Gemm g{YY, WSP, NPR, DM, 512}; pg8::StaticOrder S; S.init(NPR, DM, G, blk);
        EpiMix2 E{GT, TBUF, MIXED};
        pg8::gemm_phase<EpiMix2, pg8::StaticOrder, true, true, 768>(lds, g, S, E);
        ProvYY P{YG, rawglu, a.in[24], YY}; SEpiRaw SE{rawms, DM};
        skinny_phase<DM, 512>(lds, WSP, P, SE);
    }
    xcd_barrier(xb);
    {
        pg8::Gemm g{MIXED, WO, NPR, DM, DM}; pg8::StaticOrder S; S.init(NPR, DM, G, blk);
        EpiRes<true> E{X1B, nullptr, X2B, SQ2, 1.0f};
        pg8::gemm_phase<EpiRes<true>, pg8::StaticOrder, true, true>(lds, g, S, E);
        ProvMixed P{raw3, rawms, rawma}; SEpiRaw SE{rawo, DM};
        skinny_phase<DM, DM>(lds, WO, P, SE);
    }
    xcd_barrier(xb);
    {
        pg8::Gemm g{X2B, W2GU, NPR, 2 * FF, DM}; pg8::StaticOrder S; S.init(NPR, 2 * FF, G, blk);
        EpiAct<true> E{ACT, SQ2};
        pg8::gemm_phase<EpiAct<true>, pg8::StaticOrder, true, true>(lds, g, S, E);
        ProvX<true> P{xs, rawd, rawo}; SEpiRawScaled SE{raw10, 5632};
        skinny_phase<2 * FF, DM>(lds, W2GU, P, SE);
        kvshift_tail(a.in[2], a.in[3], a.in[4], out, 64 * 22, 0, KV_TAIL_P10, wave, lane);
    }
    xcd_barrier(xb);
    {
        pg8::Gemm g{ACT, W2D, NPR, DM, FF}; pg8::StaticOrder S; S.init(NPR, DM, G, blk);
        EpiRes<true> E{X2B, out + O_YP, nullptr, nullptr, 0.5f};
        pg8::gemm_phase<EpiRes<true>, pg8::StaticOrder, true, true, -1>(lds, g, S, E);
        ProvAct P{raw10}; SEpiFinal SE{xs, rawd, rawo, out + O_YS};
        skinny_phase<DM, FF>(lds, W2D, P, SE);
    }
}

extern "C" void kernel_launch(void* const* d_in, const int* in_sizes, int n_in, void* d_out, int out_size, void* d_ws, size_t ws_size, hipStream_t stream) {
    static int grid = 0;
    if (grid == 0) {
        if (n_in != 32 || ws_size < WS_END) { fprintf(stderr, "kernel_launch: unexpected inputs (n_in %d, ws %zu)\n", n_in, ws_size); grid = -1; return; }
        int dev = 0, cus = 0, per_cu = 0;
        hipGetDevice(&dev); hipDeviceGetAttribute(&cus, hipDeviceAttributeMultiprocessorCount, dev);
        hipFuncSetAttribute((const void*)mega_fwd, hipFuncAttributeMaxDynamicSharedMemorySize, LDS_BYTES);
        hipOccupancyMaxActiveBlocksPerMultiprocessor(&per_cu, (const void*)mega_fwd, 512, LDS_BYTES);
        if (per_cu < 1) { fprintf(stderr, "kernel_launch: occupancy query says %d blocks/CU\n", per_cu); per_cu = 1; }
        if (per_cu > 1) per_cu = 1;
        grid = cus * per_cu;
        (void)hipGetLastError();
    }
    if (grid < 0) return;
    if (hipMemsetAsync((char*)d_ws + 512 * 1024, 0, XCD_BAR_WORDS * 4, stream) != hipSuccess) { fprintf(stderr, "kernel_launch: memset of barrier words failed\n"); return; }
    Args a{};
    for (int i = 0; i < 32; ++i) a.in[i] = (const float*)d_in[i];
    a.out = (float*)d_out; a.ws = (unsigned char*)d_ws;
    void* args[] = {&a};
    hipError_t e = hipLaunchCooperativeKernel((const void*)mega_fwd, dim3(grid), dim3(512), args, LDS_BYTES, stream);
    if (e != hipSuccess) fprintf(stderr, "cooperative launch failed: %s (grid %d)\n", hipGetErrorString(e), grid);
}
```

```cpp
#include <hip/hip_runtime.h>
#include <hip/hip_cooperative_groups.h>
#include <cstdio>
#include <cstdint>
namespace cg = cooperative_groups;
namespace pg8 {
#define PG8_LAS __attribute__((address_space(3)))
typedef unsigned short bf16_t;
typedef short bf16x8 __attribute__((ext_vector_type(8)));
typedef float f32x4 __attribute__((ext_vector_type(4)));
typedef unsigned u32x4 __attribute__((ext_vector_type(4)));
constexpr int BM = 256, BK = 64, HALF = 128, HTB = HALF * BK * 2  , STAGE_BYTES = 8 * HTB, NXCD = 8, WGM = 8;

__host__ __device__ __forceinline__ int lds_byte(int r, int c) { const int st = (r >> 4) * 2 + (c >> 5), rr = r & 15, cc = c & 31, ob = rr * 64 + cc * 2; return st * 1024 + (ob ^ (((ob >> 9) & 1) << 5)); }
__host__ __device__ __forceinline__ void stage_rc(int b, int& R, int& C) { const int st = b / 1024, sb = b % 1024, swz = sb ^ (((sb >> 9) & 1) << 5); R = (st >> 1) * 16 + swz / 64; C = (st & 1) * 32 + (swz % 64) / 2; }
__host__ __device__ __forceinline__ int perm32(int rho) { const int n = rho >> 4, i = rho & 15; return 8 * (i >> 2) + 4 * n + (i & 3); }

struct Unit { int pm, pn; };
struct Gemm { const bf16_t* A; const bf16_t* Bt; int M, N, K; };

struct StaticOrder {
    int nM, nN, nwg, G, c;
    __host__ __device__ void init(int M, int N, int G_, int c_) { nM = M / BM; nN = N / BM; nwg = nM * nN; G = G_; c = c_; }
    __host__ __device__ bool next(int i, Unit& u) const {
        const long L = (long)i * G + c; if (L >= nwg) return false;
        int wgid = (int)L; { const int q = nwg / NXCD, r = nwg % NXCD, xcd = wgid % NXCD, off = wgid / NXCD; wgid = (xcd < r ? xcd * (q + 1) : r * (q + 1) + (xcd - r) * q) + off; }
        const int nig = WGM * nN, gid = wgid / nig, fm = gid * WGM, gsz = (nM - fm) < WGM ? (nM - fm) : WGM;
        u.pm = fm + ((wgid % nig) % gsz); u.pn = (wgid % nig) / gsz; return true;
    }
    __device__ __forceinline__ void a_ready(const Unit&) const {}
    __device__ __forceinline__ void done(const Unit&) const {}
};
template <class Epi, class Sched, bool ALIGN_EPI = false, bool SP2 = false, int LDA_T = 0>
__device__ __forceinline__ void gemm_phase(PG8_LAS unsigned char* lds, const Gemm g, const Sched& S, const Epi& E) {
    int tid_ = threadIdx.x; asm volatile("" : "+v"(tid_));
    const int tid = tid_, wid = __builtin_amdgcn_readfirstlane(tid >> 6), lane = tid & 63, wr = wid >> 2, wc = wid & 3, fr = lane & 15, fq = lane >> 4;
    constexpr bool ABLK = (LDA_T == -1);
    const int K = g.K, nt = K / BK, LDA = ABLK ? BK : (LDA_T ? LDA_T : g.K);
    unsigned voffA[2], voffB[2];
#pragma unroll
    for (int i = 0; i < 2; ++i) { int R, C; stage_rc(tid * 16 + i * 8192, R, C); const int Rb = Epi::PERM ? ((R & ~31) + perm32(R & 31)) : R;
        voffA[i] = (unsigned)(R * LDA + C) * 2u; voffB[i] = (unsigned)(Rb * K + C) * 2u; }
    const size_t kstepB = (size_t)(BK * 2), kstepA = ABLK ? (size_t)(BM * BK * 2) : kstepB;
    const size_t hstepB = (size_t)HALF * K * 2, hstepA = (size_t)HALF * LDA * 2;
    const size_t tstepB = 2 * hstepB, tstepA = ABLK ? (size_t)nt * kstepA : 2 * hstepA;
    const unsigned ldsw = (unsigned)wid * 1024u;
    const int aoff = lds_byte(wr * 64 + fr, fq * 8), boff = lds_byte(wc * 32 + fr, fq * 8);
#define PG8_SA(b, h) (((b) * 2 + (h)) * HTB)
#define PG8_SB(b, h) ((4 + (b) * 2 + (h)) * HTB)
#define PG8_STAGE(bufoff, gbase, voff) do { _Pragma("unroll") for (int _i = 0; _i < 2; ++_i) \
        __builtin_amdgcn_global_load_lds((const unsigned*)((const char*)(gbase) + (voff)[_i]), (PG8_LAS unsigned*)(lds + (bufoff) + ldsw + _i * 8192), 16, 0, 0); } while (0)
#define PG8_LDA(dst, b, h) do { _Pragma("unroll") for (int m = 0; m < 4; ++m) _Pragma("unroll") for (int k = 0; k < 2; ++k) dst[m][k] = *(const PG8_LAS bf16x8*)(lds + PG8_SA(b, h) + aoff + m * 2048 + k * 1024); } while (0)
#define PG8_LDB(dst, b, h) do { _Pragma("unroll") for (int n = 0; n < 2; ++n) _Pragma("unroll") for (int k = 0; k < 2; ++k) dst[n][k] = *(const PG8_LAS bf16x8*)(lds + PG8_SB(b, h) + boff + n * 2048 + k * 1024); } while (0)
#define PG8_MMA(ai, bj, At, Bt) do { __builtin_amdgcn_s_setprio(1); _Pragma("unroll") for (int m = 0; m < 4; ++m) _Pragma("unroll") for (int n = 0; n < 2; ++n) _Pragma("unroll") for (int k = 0; k < 2; ++k) \
        acc[ai][bj][m][n] = __builtin_amdgcn_mfma_f32_16x16x32_bf16(Bt[n][k], At[m][k], acc[ai][bj][m][n], 0, 0, 0); __builtin_amdgcn_s_setprio(0); } while (0)
#define PG8_WAIT_V(n) asm volatile("s_waitcnt vmcnt(" #n ")" ::: "memory")
#define PG8_WAIT_L(n) asm volatile("s_waitcnt lgkmcnt(" #n ")" ::: "memory")
#define PG8_BAR __builtin_amdgcn_s_barrier()
#define PG8_SCHED __builtin_amdgcn_sched_barrier(0)
    Unit cur, nxt; int ui = 0;
    if (!S.next(0, cur)) return;
    f32x4 acc[2][2][4][2];
#pragma unroll
    for (int a = 0; a < 2; ++a)
#pragma unroll
        for (int b = 0; b < 2; ++b)
#pragma unroll
            for (int m = 0; m < 4; ++m)
#pragma unroll
                for (int n = 0; n < 2; ++n) acc[a][b][m][n] = (f32x4){0.f, 0.f, 0.f, 0.f};
    bf16x8 At[4][2], B0[2][2], B1[2][2];
    const char* cA = (const char*)g.A + (size_t)cur.pm * tstepA; const char* cB = (const char*)g.Bt + (size_t)cur.pn * tstepB;
    S.a_ready(cur);
    if constexpr (SP2) {
        PG8_STAGE(PG8_SB(0, 0), cB, voffB); PG8_STAGE(PG8_SB(0, 1), cB + hstepB, voffB); PG8_STAGE(PG8_SA(0, 0), cA, voffA); PG8_STAGE(PG8_SA(0, 1), cA + hstepA, voffA);
        if (wr == 1) PG8_BAR;
        PG8_WAIT_V(2); PG8_BAR;
        PG8_STAGE(PG8_SB(1, 0), cB + kstepB, voffB); PG8_STAGE(PG8_SA(1, 0), cA + kstepA, voffA); PG8_STAGE(PG8_SB(1, 1), cB + hstepB + kstepB, voffB);
        PG8_WAIT_V(6); PG8_BAR;
    } else {
        PG8_STAGE(PG8_SB(0, 0), cB, voffB); PG8_STAGE(PG8_SA(0, 0), cA, voffA); PG8_STAGE(PG8_SB(0, 1), cB + hstepB, voffB); PG8_STAGE(PG8_SA(0, 1), cA + hstepA, voffA);
        if (wr == 1) PG8_BAR;
        PG8_WAIT_V(4); PG8_BAR;
        PG8_STAGE(PG8_SB(1, 0), cB + kstepB, voffB); PG8_STAGE(PG8_SA(1, 0), cA + kstepA, voffA); PG8_STAGE(PG8_SB(1, 1), cB + hstepB + kstepB, voffB);
        PG8_WAIT_V(6); PG8_BAR;
    }
    for (;;) {
        const bool has_next = S.next(ui + 1, nxt);
        const char* nA = has_next ? (const char*)g.A + (size_t)nxt.pm * tstepA : cA; const char* nB = has_next ? (const char*)g.Bt + (size_t)nxt.pn * tstepB : cB;
        for (int t = 0; t < nt; t += 2) {
            const bool last = (t == nt - 2);
            const char* a1 = cA + (size_t)(t + 1) * kstepA;
            const char* a2 = last ? nA : cA + (size_t)(t + 2) * kstepA; const char* b2 = last ? nB : cB + (size_t)(t + 2) * kstepB;
            const char* a3 = a2 + kstepA; const char* b3 = b2 + kstepB;
            if (last && has_next) S.a_ready(nxt);
            if constexpr (SP2) {
            PG8_LDB(B0, 0, 0); PG8_LDB(B1, 0, 1); PG8_SCHED; PG8_LDA(At, 0, 0); PG8_STAGE(PG8_SA(1, 1), a1 + hstepA, voffA);
            PG8_WAIT_V(8); PG8_WAIT_L(0); PG8_BAR; PG8_MMA(0, 0, At, B0); PG8_MMA(0, 1, At, B1); PG8_BAR; PG8_SCHED;
            PG8_LDA(At, 0, 1); PG8_STAGE(PG8_SB(0, 0), b2, voffB); PG8_STAGE(PG8_SB(0, 1), b2 + hstepB, voffB); PG8_STAGE(PG8_SA(0, 0), a2, voffA);
            PG8_WAIT_V(8); PG8_WAIT_L(0); PG8_BAR; PG8_MMA(1, 0, At, B0); PG8_MMA(1, 1, At, B1); PG8_BAR; PG8_SCHED;
            PG8_LDB(B0, 1, 0); PG8_LDB(B1, 1, 1); PG8_SCHED; PG8_LDA(At, 1, 0); PG8_STAGE(PG8_SA(0, 1), a2 + hstepA, voffA);
            PG8_WAIT_V(8); PG8_WAIT_L(0); PG8_BAR; PG8_MMA(0, 0, At, B0); PG8_MMA(0, 1, At, B1); PG8_BAR; PG8_SCHED;
            PG8_LDA(At, 1, 1); PG8_STAGE(PG8_SB(1, 0), b3, voffB); PG8_STAGE(PG8_SB(1, 1), b3 + hstepB, voffB); PG8_STAGE(PG8_SA(1, 0), a3, voffA);
            PG8_WAIT_V(8); PG8_WAIT_L(0); PG8_BAR; PG8_MMA(1, 0, At, B0); PG8_MMA(1, 1, At, B1); PG8_BAR; PG8_SCHED;
            } else {
            PG8_LDB(B0, 0, 0); PG8_SCHED; PG8_LDA(At, 0, 0); PG8_STAGE(PG8_SA(1, 1), a1 + hstepA, voffA);
            PG8_WAIT_L(8); PG8_BAR; PG8_WAIT_L(0); PG8_MMA(0, 0, At, B0); PG8_BAR; PG8_SCHED;
            PG8_LDB(B1, 0, 1); PG8_STAGE(PG8_SB(0, 0), b2, voffB);
            PG8_BAR; PG8_WAIT_L(0); PG8_MMA(0, 1, At, B1); PG8_BAR;
            PG8_LDA(At, 0, 1); PG8_STAGE(PG8_SA(0, 0), a2, voffA);
            PG8_BAR; PG8_WAIT_L(0); PG8_MMA(1, 0, At, B0); PG8_BAR; PG8_SCHED;
            PG8_STAGE(PG8_SB(0, 1), b2 + hstepB, voffB);
            PG8_WAIT_V(6); PG8_BAR; PG8_MMA(1, 1, At, B1); PG8_BAR;
            PG8_LDB(B0, 1, 0); PG8_SCHED; PG8_LDA(At, 1, 0); PG8_STAGE(PG8_SA(0, 1), a2 + hstepA, voffA);
            PG8_WAIT_L(8); PG8_BAR; PG8_WAIT_L(0); PG8_MMA(0, 0, At, B0); PG8_BAR; PG8_SCHED;
            PG8_LDB(B1, 1, 1); PG8_STAGE(PG8_SB(1, 0), b3, voffB);
            PG8_BAR; PG8_WAIT_L(0); PG8_MMA(0, 1, At, B1); PG8_BAR;
            PG8_LDA(At, 1, 1); PG8_STAGE(PG8_SA(1, 0), a3, voffA);
            PG8_BAR; PG8_WAIT_L(0); PG8_MMA(1, 0, At, B0); PG8_BAR; PG8_SCHED;
            PG8_STAGE(PG8_SB(1, 1), b3 + hstepB, voffB);
            PG8_WAIT_V(6); PG8_BAR; PG8_MMA(1, 1, At, B1); PG8_BAR;
            }
        }
        if constexpr (ALIGN_EPI) { if (wr == 0) PG8_BAR; }
        if constexpr (!Epi::AFTER_DRAIN) { E(acc, cur, wr, wc, fr, fq); S.done(cur); }
        if (!has_next) break;
#pragma unroll
        for (int a = 0; a < 2; ++a)
#pragma unroll
            for (int b = 0; b < 2; ++b)
#pragma unroll
                for (int m = 0; m < 4; ++m)
#pragma unroll
                    for (int n = 0; n < 2; ++n) acc[a][b][m][n] = (f32x4){0.f, 0.f, 0.f, 0.f};
        cur = nxt; cA = nA; cB = nB; ++ui;
        if constexpr (ALIGN_EPI) { if (wr == 1) PG8_BAR; }
    }
    PG8_WAIT_V(0);
    if constexpr (!ALIGN_EPI) { if (wr == 0) PG8_BAR; }
    PG8_BAR;
    if constexpr (Epi::AFTER_DRAIN) { E.fused(acc, cur, wr, wc, fr, fq, lds, wid, lane); S.done(cur); }
#undef PG8_SA
#undef PG8_SB
#undef PG8_STAGE
#undef PG8_LDA
#undef PG8_LDB
#undef PG8_MMA
#undef PG8_WAIT_V
#undef PG8_WAIT_L
#undef PG8_BAR
#undef PG8_SCHED
}
}

#define LAS __attribute__((address_space(3)))
#define DI __device__ __forceinline__
typedef unsigned short bf16_t;
typedef short bf16x8 __attribute__((ext_vector_type(8)));
typedef float f32x4 __attribute__((ext_vector_type(4)));
typedef float f32x2 __attribute__((ext_vector_type(2)));
typedef float f32x16 __attribute__((ext_vector_type(16)));
typedef unsigned u32x4 __attribute__((ext_vector_type(4)));
typedef unsigned u32x2 __attribute__((ext_vector_type(2)));
typedef __bf16 bf16x2n __attribute__((ext_vector_type(2)));

constexpr int DM = 1024, FF = 2816, NPR = 16384, NSM = 32, MT = NPR + NSM, SEQ = 8192, INW = 4864;
constexpr float EPS = 1e-6f;
constexpr float QSCALE = 0.125f * 1.4426950408889634f;
constexpr int NCH = 128, TCH = 64;

constexpr size_t MiB = 1u << 20;
constexpr size_t WS_W1GU = 1 * MiB, WS_W1D = 12 * MiB, WS_WIN = 18 * MiB, WS_WGLU = 28 * MiB, WS_WMIX = 29 * MiB, WS_WO = 32 * MiB, WS_W2GU = 34 * MiB, WS_W2D = 45 * MiB;
constexpr size_t WS_SEND = 51 * MiB, WS_SIN = 55 * MiB, WS_ML = 59 * MiB, WS_SQ1 = 61 * MiB, WS_SQ2 = 63 * MiB, WS_SRAW = 65 * MiB;
constexpr size_t WS_XN = 70 * MiB, WS_X1B = 103 * MiB, WS_X1 = 136 * MiB, WS_ACT = 201 * MiB, WS_G = 290 * MiB, WS_OG = 355 * MiB, WS_YG = 380 * MiB, WS_YY = 397 * MiB, WS_END = 422 * MiB;
constexpr size_t SR_RAW1 = 0, SR_RAWD = SR_RAW1 + 32 * 5632, SR_RAW3 = SR_RAWD + 32 * 1024, SR_RAWGLU = SR_RAW3 + 32 * 4864, SR_RAWMIX = SR_RAWGLU + 32 * 512, SR_RAWO = SR_RAWMIX + 32 * 2048,
                 SR_RAW10 = SR_RAWO + 32 * 1024, SR_END = SR_RAW10 + 32 * 5632;
static_assert(SR_END * 4 <= 5 * MiB, "sample raw region");
constexpr size_t O_YP = 0, O_YS = 16777216, O_KVP0 = 16809984, O_KVP1 = 16941056, O_KVP2 = 17465344, O_SREP = 19562496, O_SIMP = 19566592,
                 O_KVS0 = 19570688, O_KVS1 = 21667840, O_KVS2 = 30056448, O_SRES = 63610880, O_SIMS = 63676416;

constexpr int LDS_BYTES = 147456;

DI int otid() { int t = threadIdx.x; asm volatile("" : "+v"(t)); return t; }
DI unsigned pk2(float a, float b) { f32x2 v = {a, b}; bf16x2n r = __builtin_convertvector(v, bf16x2n); return __builtin_bit_cast(unsigned, r); }
DI bf16_t f2bf(float a) { return (bf16_t)(pk2(a, a) & 0xffffu); }
DI float bflo(unsigned w) { return __uint_as_float(w << 16); }
DI float bfhi(unsigned w) { return __uint_as_float(w & 0xffff0000u); }
DI float bf2f(bf16_t b) { return __uint_as_float(((unsigned)b) << 16); }
DI float sigm(float x) { return __builtin_amdgcn_rcpf(1.f + __expf(-x)); }
DI float silu(float x) { return x * sigm(x); }
DI float gelu_tanh(float x) { const float z = 0.7978845608028654f * (x + 0.044715f * x * x * x); const float t = 1.f - 2.f * __builtin_amdgcn_rcpf(1.f + __expf(2.f * z)); return 0.5f * x * (1.f + t); }
DI u32x4 pack8(f32x4 a, f32x4 b) { u32x4 w; w.x = pk2(a[0], a[1]); w.y = pk2(a[2], a[3]); w.z = pk2(b[0], b[1]); w.w = pk2(b[2], b[3]); return w; }
DI void unpack8(u32x4 w, f32x4& a, f32x4& b) { a = (f32x4){bflo(w.x), bfhi(w.x), bflo(w.y), bfhi(w.y)}; b = (f32x4){bflo(w.z), bfhi(w.z), bflo(w.w), bfhi(w.w)}; }
DI float wave_sum(float v) {
#pragma unroll
    for (int o = 1; o < 64; o <<= 1) v += __shfl_xor(v, o);
    return v;
}
DI float wave_max(float v) {
#pragma unroll
    for (int o = 1; o < 64; o <<= 1) v = fmaxf(v, __shfl_xor(v, o));
    return v;
}
DI float rstd16(const float* sq, int row) { return rsqrtf(sq[row] * (1.f / 1024.f) + EPS); }
DI int l2p(int c) { return (c & ~255) | (((c >> 5) & 1) << 7) | (((c >> 6) & 3) << 5) | (c & 31); }
#define LDS_WAIT() asm volatile("s_waitcnt lgkmcnt(0)" ::: "memory")
#define SCHED_FENCE() __builtin_amdgcn_sched_barrier(0)


typedef __attribute__((address_space(1))) unsigned gu32;
#define XB_TMO      128
#define XB_XCNT(j)  (256  + 64 * (j))
#define XB_XSUB(j)  (1280 + 64 * (j))
#define XB_XGEN(j)  (2304 + 64 * (j))
#define XB_TOP      3328
#define XB_TOPGEN   3392
#define XCD_BAR_WORDS 3456
#define XB_SPIN_CAP (1u << 18)

__device__ __forceinline__ unsigned xb_ld(unsigned* p)              { return __hip_atomic_load(p, __ATOMIC_RELAXED, __HIP_MEMORY_SCOPE_AGENT); }
__device__ __forceinline__ unsigned xb_add(unsigned* p, unsigned v) { return __hip_atomic_fetch_add(p, v, __ATOMIC_RELAXED, __HIP_MEMORY_SCOPE_AGENT); }
__device__ __forceinline__ unsigned xb_xcc_id() { return (unsigned)__builtin_amdgcn_s_getreg((3 << 11) | 20) & 0xFu; }
#define XB_SPIN(cond, bar) do { unsigned _sp = 0; while (cond) { __builtin_amdgcn_s_sleep(1); \
    if ((++_sp & 255u) == 0u) { if (xb_ld(&(bar)[XB_TMO])) break; if (_sp > XB_SPIN_CAP) { atomicAdd(&(bar)[XB_TMO], 1u); break; } } } } while (0)

struct XcdBarrier {
    unsigned* bar; unsigned x; unsigned G;
    volatile LAS unsigned* st;
};

__device__ __forceinline__ XcdBarrier xcd_barrier_post(unsigned* bar, volatile LAS unsigned* st, unsigned G) {
    XcdBarrier b; b.bar = bar; b.x = xb_xcc_id(); b.st = st; b.G = G;
    if (threadIdx.x == 0) (void)xb_add(&bar[XB_XCNT(b.x)], 1u);
    return b;
}
__device__ __forceinline__ void xcd_barrier_complete(unsigned* bar, unsigned x, unsigned G, unsigned& nloc, unsigned& nx) {
    unsigned sum, cnt, mine, sp = 0u;
    for (;;) {
        sum = 0u; cnt = 0u; mine = 0u;
#pragma unroll
        for (unsigned j = 0; j < 16; ++j) { const unsigned c = xb_ld(&bar[XB_XCNT(j)]); sum += c; cnt += (c > 0u) ? 1u : 0u; mine = (j == x) ? c : mine; }
        if (sum == G) break;
        __builtin_amdgcn_s_sleep(1);
        if ((++sp & 255u) == 0u) { if (xb_ld(&bar[XB_TMO])) break; if (sp > XB_SPIN_CAP) { atomicAdd(&bar[XB_TMO], 1u); break; } }
    }
    nloc = mine > 0u ? mine : 1u; nx = cnt > 0u ? cnt : 1u;
}

__device__ __forceinline__ void xcd_barrier(const XcdBarrier& b) {
    asm volatile("s_waitcnt vmcnt(0)" ::: "memory");
    __syncthreads();
    if (threadIdx.x == 0) {
        unsigned* bar = b.bar; unsigned bx = b.x; asm volatile("" : "+s"(bx));
        __builtin_amdgcn_s_waitcnt(0);
        unsigned nloc = b.st[0], nx = b.st[1];
        if (nloc == 0u) { xcd_barrier_complete(bar, bx, b.G, nloc, nx); b.st[0] = nloc; b.st[1] = nx; }
        const unsigned old = xb_add(&bar[XB_XSUB(bx)], 1u);
        const unsigned gen = old / nloc;
        if (old + 1u == (gen + 1u) * nloc) {
            __builtin_amdgcn_fence(__ATOMIC_RELEASE, "agent");
            asm volatile("s_waitcnt vmcnt(0)" ::: "memory");
            const unsigned og = xb_add(&bar[XB_TOP], 1u);
            const unsigned tg = og / nx;
            if (og + 1u == (tg + 1u) * nx) xb_add(&bar[XB_TOPGEN], 1u);
            else XB_SPIN(xb_ld(&bar[XB_TOPGEN]) == tg, bar);
            __builtin_amdgcn_fence(__ATOMIC_ACQUIRE, "agent");
            xb_add(&bar[XB_XGEN(bx)], 1u);
            asm volatile("s_waitcnt vmcnt(0)" ::: "memory");
        } else {
            XB_SPIN(xb_ld(&bar[XB_XGEN(bx)]) == gen, bar);
            __builtin_amdgcn_fence(__ATOMIC_ACQUIRE, "agent");
            asm volatile("s_waitcnt vmcnt(0)" ::: "memory");
        }
    }
    __syncthreads();
}

using pg8::Unit;
template <bool RS> struct EpiAct {
    static constexpr bool PERM = true, AFTER_DRAIN = false;
    bf16_t* O; const float* sq;
    DI void operator()(const f32x4 (&acc)[2][2][4][2], const Unit& u, int wr, int wc, int fr, int fq) const {
        const int row0 = u.pm * 256 + wr * 64 + fr, col = u.pn * 128 + wc * 32 + 8 * fq;
        float rs[2][4];
#pragma unroll
        for (int ai = 0; ai < 2; ++ai)
#pragma unroll
            for (int m = 0; m < 4; ++m) rs[ai][m] = RS ? sq[row0 + ai * 128 + m * 16] : 1.f;
        SCHED_FENCE();
#pragma unroll
        for (int ai = 0; ai < 2; ++ai)
#pragma unroll
            for (int m = 0; m < 4; ++m) {
                const int row = row0 + ai * 128 + m * 16; float r1 = 1.f; if (RS) r1 = rsqrtf(rs[ai][m] * (1.f / 1024.f) + EPS);
                f32x4 o[2];
#pragma unroll
                for (int n = 0; n < 2; ++n)
#pragma unroll
                    for (int e = 0; e < 4; ++e) o[n][e] = silu(acc[ai][0][m][n][e] * r1) * (acc[ai][1][m][n][e] * r1);
                *(u32x4*)(O + (((size_t)(row >> 8) * (FF / 64) + (col >> 6)) * 256 + (row & 255)) * 64 + (col & 63)) = pack8(o[0], o[1]);
            }
    }
};
template <bool BF> struct EpiRes {
    static constexpr bool PERM = true, AFTER_DRAIN = false;
    const void* base; float* out; bf16_t* ob; float* sq; float scale;
    DI void operator()(const f32x4 (&acc)[2][2][4][2], const Unit& u, int wr, int wc, int fr, int fq) const {
        const int row0 = u.pm * 256 + wr * 64 + fr;
        constexpr int MB = BF ? 4 : 2;
#pragma unroll
        for (int ai = 0; ai < 2; ++ai)
#pragma unroll
        for (int m0 = 0; m0 < 4; m0 += MB) {
            f32x4 b0[MB][2], b1[MB][2]; u32x4 bw[MB][2];
            SCHED_FENCE();
#pragma unroll
            for (int mm = 0; mm < MB; ++mm)
#pragma unroll
                for (int bj = 0; bj < 2; ++bj) { const size_t off = (size_t)(row0 + ai * 128 + (m0 + mm) * 16) * DM + u.pn * 256 + bj * 128 + wc * 32 + 8 * fq;
                    if (BF) bw[mm][bj] = *(const u32x4*)((const bf16_t*)base + off);
                    else { b0[mm][bj] = *(const f32x4*)((const float*)base + off); b1[mm][bj] = *(const f32x4*)((const float*)base + off + 4); } }
            SCHED_FENCE();
#pragma unroll
            for (int mm = 0; mm < MB; ++mm) {
                const int m = m0 + mm; const int row = row0 + ai * 128 + m * 16; float ss = 0.f;
#pragma unroll
                for (int bj = 0; bj < 2; ++bj) {
                    const size_t off = (size_t)row * DM + u.pn * 256 + bj * 128 + wc * 32 + 8 * fq;
                    f32x4 c0, c1; if (BF) unpack8(bw[mm][bj], c0, c1); else { c0 = b0[mm][bj]; c1 = b1[mm][bj]; }
                    const f32x4 v0 = c0 + acc[ai][bj][m][0] * scale, v1 = c1 + acc[ai][bj][m][1] * scale;
                    if (out) { *(f32x4*)(out + off) = v0; *(f32x4*)(out + off + 4) = v1; }
                    if (ob) *(u32x4*)(ob + off) = pack8(v0, v1);
                    ss += (v0[0] * v0[0] + v0[1] * v0[1]) + (v0[2] * v0[2] + v0[3] * v0[3]) + (v1[0] * v1[0] + v1[1] * v1[1]) + (v1[2] * v1[2] + v1[3] * v1[3]);
                }
                if (sq) { ss += __shfl_xor(ss, 16); ss += __shfl_xor(ss, 32); if (fq == 0) atomicAdd(sq + row, ss); }
            }
        }
    }
};
struct EpiWin {
    static constexpr bool PERM = true, AFTER_DRAIN = false;
    const float* sq; bf16_t* UQKV; bf16_t* G; const float* gqk; float* out;
    DI void operator()(const f32x4 (&acc)[2][2][4][2], const Unit& u, int wr, int wc, int fr, int fq) const {
        const int row0 = u.pm * 256 + wr * 64 + fr, pn = u.pn;
        const int kind = (pn - 2) / 3, g = (pn - 2) % 3;
        float rsq[2][4]; f32x4 gn[2][2];
#pragma unroll
        for (int ai = 0; ai < 2; ++ai)
#pragma unroll
            for (int m = 0; m < 4; ++m) rsq[ai][m] = sq[row0 + ai * 128 + m * 16];
        if (pn >= 2 && pn < 8) { const float* gp = gqk + kind * 192 + g * 64 + 8 * fq;
#pragma unroll
            for (int bj = 0; bj < 2; ++bj) { gn[bj][0] = *(const f32x4*)(gp + bj * 32); gn[bj][1] = *(const f32x4*)(gp + bj * 32 + 4); } }
        else { const f32x4 one = {1.f, 1.f, 1.f, 1.f}; gn[0][0] = one; gn[0][1] = one; gn[1][0] = one; gn[1][1] = one; }
        SCHED_FENCE();
#pragma unroll
        for (int ai = 0; ai < 2; ++ai)
#pragma unroll
            for (int m = 0; m < 4; ++m) {
                const int row = row0 + ai * 128 + m * 16; const float rs = rsqrtf(rsq[ai][m] * (1.f / 1024.f) + EPS);
                f32x4 v[2][2];
#pragma unroll
                for (int bj = 0; bj < 2; ++bj)
#pragma unroll
                    for (int n = 0; n < 2; ++n) v[bj][n] = acc[ai][bj][m][n] * rs;
                if (pn < 2) {
#pragma unroll
                    for (int bj = 0; bj < 2; ++bj) *(u32x4*)(UQKV + (size_t)row * 512 + pn * 256 + wc * 64 + bj * 32 + 8 * fq) = pack8(v[bj][0], v[bj][1]);
                } else if (pn < 11) {
                    float rn = 1.f;
                    if (kind < 2) {
                        float ss = 0.f;
#pragma unroll
                        for (int bj = 0; bj < 2; ++bj)
#pragma unroll
                            for (int n = 0; n < 2; ++n) ss += (v[bj][n][0] * v[bj][n][0] + v[bj][n][1] * v[bj][n][1]) + (v[bj][n][2] * v[bj][n][2] + v[bj][n][3] * v[bj][n][3]);
                        ss += __shfl_xor(ss, 16); ss += __shfl_xor(ss, 32);
                        rn = rsqrtf(ss * (1.f / 64.f) + EPS) * (kind == 0 ? QSCALE : 1.f);
                    }
                    const int t = row & (SEQ - 1), b = row >> 13; const int w = g == 0 ? 128 : (g == 1 ? 512 : 2048);
                    const size_t kvo = g == 0 ? O_KVP0 : (g == 1 ? O_KVP1 : O_KVP2);
                    bf16_t* dstb = UQKV + (size_t)MT * 512 + (size_t)kind * ((size_t)MT * 768) + (size_t)row * 768 + g * 256 + wc * 64 + 8 * fq;
#pragma unroll
                    for (int bj = 0; bj < 2; ++bj) {
                        const f32x4 a0 = v[bj][0] * rn * gn[bj][0], a1 = v[bj][1] * rn * gn[bj][1];
                        *(u32x4*)(dstb + bj * 32) = pack8(a0, a1);
                        if (kind >= 1 && t >= SEQ - w) { float* o = out + kvo + ((size_t)(b * w + (t - (SEQ - w))) * 2 + (kind - 1)) * 256 + wc * 64 + bj * 32 + 8 * fq; *(f32x4*)o = a0; *(f32x4*)(o + 4) = a1; }
                    }
                } else {
#pragma unroll
                    for (int bj = 0; bj < 2; ++bj) {
                        f32x4 a0, a1;
#pragma unroll
                        for (int e = 0; e < 4; ++e) { a0[e] = sigm(v[bj][0][e]); a1[e] = sigm(v[bj][1][e]); }
                        *(u32x4*)(G + (size_t)row * 2048 + (pn - 11) * 256 + wc * 64 + bj * 32 + 8 * fq) = pack8(a0, a1);
                    }
                }
            }
    }
};
struct EpiGlu {
    static constexpr bool PERM = true, AFTER_DRAIN = false;
    const bf16_t* YG; const float* bias; bf16_t* YY;
    DI void operator()(const f32x4 (&acc)[2][2][4][2], const Unit& u, int wr, int wc, int fr, int fq) const {
        const int row0 = u.pm * 256 + wr * 64 + fr;
        f32x4 bb[2][2];
#pragma unroll
        for (int bj = 0; bj < 2; ++bj) { const int col = u.pn * 256 + bj * 128 + wc * 32 + 8 * fq; bb[bj][0] = *(const f32x4*)(bias + col); bb[bj][1] = *(const f32x4*)(bias + col + 4); }
#pragma unroll
        for (int ai = 0; ai < 2; ++ai) {
            u32x4 yw[2][4][2];
            SCHED_FENCE();
#pragma unroll
            for (int bj = 0; bj < 2; ++bj)
#pragma unroll
                for (int m = 0; m < 4; ++m) yw[ai][m][bj] = *(const u32x4*)(YG + (size_t)(row0 + ai * 128 + m * 16) * 512 + u.pn * 256 + bj * 128 + wc * 32 + 8 * fq);
            SCHED_FENCE();
#pragma unroll
            for (int m = 0; m < 4; ++m) {
                const int row = row0 + ai * 128 + m * 16;
#pragma unroll
                for (int bj = 0; bj < 2; ++bj) {
                    const int col = u.pn * 256 + bj * 128 + wc * 32 + 8 * fq;
                    f32x4 y0, y1; unpack8(yw[ai][m][bj], y0, y1);
                    f32x4 o0, o1;
#pragma unroll
                    for (int e = 0; e < 4; ++e) { o0[e] = y0[e] * sigm(acc[ai][bj][m][0][e] + bb[bj][0][e]); o1[e] = y1[e] * sigm(acc[ai][bj][m][1][e] + bb[bj][1][e]); }
                    *(u32x4*)(YY + (size_t)row * 768 + col) = pack8(o0, o1);
                }
            }
        }
    }
};
struct EpiGateScale {
    static constexpr bool PERM = true, AFTER_DRAIN = false;
    const bf16_t* G; bf16_t* T;
    DI void operator()(const f32x4 (&acc)[2][2][4][2], const Unit& u, int wr, int wc, int fr, int fq) const {
        const int row0 = u.pm * 256 + wr * 64 + fr;
#pragma unroll
        for (int ai = 0; ai < 2; ++ai) {
            u32x4 gw[2][4][2];
            SCHED_FENCE();
#pragma unroll
            for (int m = 0; m < 4; ++m)
#pragma unroll
                for (int bj = 0; bj < 2; ++bj) gw[ai][m][bj] = *(const u32x4*)(G + (size_t)(row0 + ai * 128 + m * 16) * 2048 + 1024 + u.pn * 256 + bj * 128 + wc * 32 + 8 * fq);
            SCHED_FENCE();
#pragma unroll
            for (int m = 0; m < 4; ++m) {
                const int row = row0 + ai * 128 + m * 16;
#pragma unroll
                for (int bj = 0; bj < 2; ++bj) { const int col = u.pn * 256 + bj * 128 + wc * 32 + 8 * fq;
                    f32x4 a0, a1; unpack8(gw[ai][m][bj], a0, a1);
                    *(u32x4*)(T + (size_t)row * DM + col) = pack8(a0 * acc[ai][bj][m][0], a1 * acc[ai][bj][m][1]); }
            }
        }
    }
};
struct EpiMix2 {
    static constexpr bool PERM = true, AFTER_DRAIN = false;
    const bf16_t* G; const bf16_t* T; bf16_t* O;
    DI void operator()(const f32x4 (&acc)[2][2][4][2], const Unit& u, int wr, int wc, int fr, int fq) const {
        const int row0 = u.pm * 256 + wr * 64 + fr;
#pragma unroll
        for (int ai = 0; ai < 2; ++ai)
#pragma unroll
        for (int mh = 0; mh < 4; mh += 2) {
            u32x4 gw[4][2], tw[4][2];
            SCHED_FENCE();
#pragma unroll
            for (int m = mh; m < mh + 2; ++m)
#pragma unroll
                for (int bj = 0; bj < 2; ++bj) { const int row = row0 + ai * 128 + m * 16, col = u.pn * 256 + bj * 128 + wc * 32 + 8 * fq;
                    gw[m][bj] = *(const u32x4*)(G + (size_t)row * 2048 + col); tw[m][bj] = *(const u32x4*)(T + (size_t)row * DM + col); }
            SCHED_FENCE();
#pragma unroll
            for (int m = mh; m < mh + 2; ++m) {
                const int row = row0 + ai * 128 + m * 16;
#pragma unroll
                for (int bj = 0; bj < 2; ++bj) { const int col = u.pn * 256 + bj * 128 + wc * 32 + 8 * fq;
                    f32x4 s0, s1, t0, t1; unpack8(gw[m][bj], s0, s1); unpack8(tw[m][bj], t0, t1);
                    *(u32x4*)(O + (size_t)row * DM + col) = pack8(s0 * acc[ai][bj][m][0] + t0, s1 * acc[ai][bj][m][1] + t1); }
            }
        }
    }
};

#define MFMA32(a, b, c) __builtin_amdgcn_mfma_f32_32x32x16_bf16((a), (b), (c), 0, 0, 0)
#define MFMA16(a, b, c) __builtin_amdgcn_mfma_f32_16x16x32_bf16((a), (b), (c), 0, 0, 0)
DI bf16x8 frag_from_f32(f32x4 a, f32x4 b) { return __builtin_bit_cast(bf16x8, pack8(a, b)); }

struct ProvBf16 { const bf16_t* A; int ld; static constexpr bool SQ = false; static constexpr int BATCH = 4;
    struct Raw { bf16x8 v; };
    DI Raw load(int r, int k) const { Raw w; w.v = *(const bf16x8*)(A + (size_t)r * ld + k); return w; }
    DI bf16x8 cvt(const Raw& w, float&) const { return w.v; } };
struct ProvAct { const float* raw; static constexpr bool SQ = false; static constexpr int BATCH = 4;
    struct Raw { f32x4 g0, g1, u0, u1; };
    DI Raw load(int r, int k) const { const float* p = raw + (size_t)r * 5632 + 256 * (k >> 7) + (k & 127); Raw w; w.g0 = *(const f32x4*)p; w.g1 = *(const f32x4*)(p + 4); w.u0 = *(const f32x4*)(p + 128); w.u1 = *(const f32x4*)(p + 132); return w; }
    DI bf16x8 cvt(const Raw& w, float&) const { f32x4 a, b;
#pragma unroll
        for (int e = 0; e < 4; ++e) { a[e] = silu(w.g0[e]) * w.u0[e]; b[e] = silu(w.g1[e]) * w.u1[e]; }
        return frag_from_f32(a, b); } };
template <bool HASO> struct ProvX { const float* xs; const float* rawd; const float* rawo; static constexpr bool SQ = true; static constexpr int BATCH = 2;
    struct Raw { f32x4 x0, x1, d0, d1, o0, o1; };
    DI Raw load(int r, int k) const { const size_t o = (size_t)r * DM + k; Raw w; w.x0 = *(const f32x4*)(xs + o); w.x1 = *(const f32x4*)(xs + o + 4); w.d0 = *(const f32x4*)(rawd + o); w.d1 = *(const f32x4*)(rawd + o + 4);
        if (HASO) { w.o0 = *(const f32x4*)(rawo + o); w.o1 = *(const f32x4*)(rawo + o + 4); } return w; }
    DI bf16x8 cvt(const Raw& w, float& ss) const { f32x4 a = w.x0 + w.d0 * 0.5f, b = w.x1 + w.d1 * 0.5f; if (HASO) { a += w.o0; b += w.o1; }
        ss += (a[0] * a[0] + a[1] * a[1]) + (a[2] * a[2] + a[3] * a[3]) + (b[0] * b[0] + b[1] * b[1]) + (b[2] * b[2] + b[3] * b[3]);
        return frag_from_f32(a, b); } };
struct ProvYY { const bf16_t* YG; const float* rawglu; const float* bias; const bf16_t* YY; static constexpr bool SQ = false; static constexpr int BATCH = 3;
    struct Raw { u32x4 y; f32x4 z0, z1, b0, b1; };
    DI Raw load(int r, int k) const { Raw w; const f32x4 z = {0.f, 0.f, 0.f, 0.f}; w.z0 = z; w.z1 = z; w.b0 = z; w.b1 = z;
        if (k >= 512) { w.y = *(const u32x4*)(YY + (size_t)(NPR + r) * 768 + k); }
        else { w.y = *(const u32x4*)(YG + (size_t)(NPR + r) * 512 + k); w.z0 = *(const f32x4*)(rawglu + r * 512 + k); w.z1 = *(const f32x4*)(rawglu + r * 512 + k + 4); w.b0 = *(const f32x4*)(bias + k); w.b1 = *(const f32x4*)(bias + k + 4); }
        return w; }
    DI bf16x8 cvt(const Raw& w, float&, int k) const { return __builtin_bit_cast(bf16x8, w.y); }
    DI bf16x8 cvt(const Raw& w, float&) const { return __builtin_bit_cast(bf16x8, w.y); }
    DI bf16x8 cvtk(const Raw& w, int k) const {
        if (k >= 512) return __builtin_bit_cast(bf16x8, w.y);
        f32x4 y0, y1; unpack8(w.y, y0, y1); f32x4 a, b;
#pragma unroll
        for (int e = 0; e < 4; ++e) { a[e] = y0[e] * sigm(w.z0[e] + w.b0[e]); b[e] = y1[e] * sigm(w.z1[e] + w.b1[e]); }
        return frag_from_f32(a, b); } };
struct ProvMixed { const float* raw3; const float* rawms; const float* rawma; static constexpr bool SQ = false; static constexpr int BATCH = 2;
    struct Raw { f32x4 s0, s1, a0, a1, m0, m1, n0, n1; };
    DI Raw load(int r, int k) const { const float* gs = raw3 + (size_t)r * INW + l2p(2816 + k); const float* ga = raw3 + (size_t)r * INW + l2p(3840 + k);
        Raw w; w.s0 = *(const f32x4*)gs; w.s1 = *(const f32x4*)(gs + 4); w.a0 = *(const f32x4*)ga; w.a1 = *(const f32x4*)(ga + 4);
        w.m0 = *(const f32x4*)(rawms + r * DM + k); w.m1 = *(const f32x4*)(rawms + r * DM + k + 4); w.n0 = *(const f32x4*)(rawma + r * DM + k); w.n1 = *(const f32x4*)(rawma + r * DM + k + 4); return w; }
    DI bf16x8 cvt(const Raw& w, float&) const { f32x4 a, b;
#pragma unroll
        for (int e = 0; e < 4; ++e) { a[e] = sigm(w.s0[e]) * w.m0[e] + sigm(w.a0[e]) * w.n0[e]; b[e] = sigm(w.s1[e]) * w.m1[e] + sigm(w.a1[e]) * w.n1[e]; }
        return frag_from_f32(a, b); } };
template <class P> struct ProvTraits { static constexpr bool NEEDK = false; };
template <> struct ProvTraits<ProvYY> { static constexpr bool NEEDK = true; };
struct SEpiRaw { float* dst; int ld; DI void operator()(int row, int col, float v, float) const { dst[(size_t)row * ld + col] = v; } };
struct SEpiRawScaled { float* dst; int ld; DI void operator()(int row, int col, float v, float rs) const { dst[(size_t)row * ld + col] = v * rs; } };
struct SEpiFinal { const float* xs; const float* rawd; const float* rawo; float* out; DI void operator()(int row, int col, float v, float) const { const size_t o = (size_t)row * DM + col; out[o] = xs[o] + 0.5f * rawd[o] + rawo[o] + 0.5f * v; } };

template <int N, int K, class Prov, class SEpi>
DI void skinny_phase(LAS unsigned char* lds, const bf16_t* Bt, const Prov& P, const SEpi& E) {
    const int tid = otid(), wave = tid >> 6, lane = tid & 63, r = lane & 31, hh = lane >> 5, G = gridDim.x;
    LAS float* red = (LAS float*)lds;
    LAS float* sqp = (LAS float*)(lds + 32768);
    LAS float* rsd = (LAS float*)(lds + 32768 + 2048);
    constexpr int ntiles = N / 32, kper = K / 8, NIT = kper / 32, BATCH = Prov::BATCH;
    for (int tile = G - 1 - (int)blockIdx.x; tile < ntiles; tile += G) {
        const int n0 = tile * 32;
        f32x16 acc = {};
        float ss = 0.f;
        const bf16_t* bp = Bt + (size_t)(n0 + r) * K + wave * kper + 16 * hh;
        const int kbase = wave * kper + 16 * hh;
#pragma unroll
        for (int i0 = 0; i0 < NIT; i0 += BATCH) {
            typename Prov::Raw ra[BATCH][2]; bf16x8 rb[BATCH][2];
            SCHED_FENCE();
#pragma unroll
            for (int u = 0; u < BATCH; ++u) if (i0 + u < NIT) { const int k = kbase + 32 * (i0 + u);
                ra[u][0] = P.load(r, k); ra[u][1] = P.load(r, k + 8); rb[u][0] = *(const bf16x8*)(bp + 32 * (i0 + u)); rb[u][1] = *(const bf16x8*)(bp + 32 * (i0 + u) + 8); }
            SCHED_FENCE();
#pragma unroll
            for (int u = 0; u < BATCH; ++u) if (i0 + u < NIT) { const int k = kbase + 32 * (i0 + u);
                bf16x8 a0, a1;
                if constexpr (ProvTraits<Prov>::NEEDK) { a0 = P.cvtk(ra[u][0], k); a1 = P.cvtk(ra[u][1], k + 8); } else { a0 = P.cvt(ra[u][0], ss); a1 = P.cvt(ra[u][1], ss); }
                acc = MFMA32(a0, rb[u][0], acc); acc = MFMA32(a1, rb[u][1], acc); }
        }
#pragma unroll
        for (int i = 0; i < 16; ++i) red[wave * 1024 + ((i & 3) + 8 * (i >> 2) + 4 * hh) * 32 + r] = acc[i];
        if (Prov::SQ) sqp[(wave * 2 + hh) * 32 + r] = ss;
        __syncthreads();
        if (Prov::SQ) { if (tid < 32) { float sm = 0.f; for (int j = 0; j < 16; ++j) sm += sqp[j * 32 + tid]; rsd[tid] = rsqrtf(sm * (1.f / 1024.f) + EPS); } __syncthreads(); }
#pragma unroll
        for (int h2 = 0; h2 < 2; ++h2) { const int e = tid + 512 * h2; float sm = 0.f;
#pragma unroll
            for (int w = 0; w < 8; ++w) sm += red[w * 1024 + e];
            E(e >> 5, n0 + (e & 31), sm, Prov::SQ ? rsd[e >> 5] : 1.f); }
        __syncthreads();
    }
}

DI int maprow(int mode, int c0) {
    if (mode == 0) return c0;
    if (mode == 1) return 256 * (c0 >> 7) + (c0 & 127);
    if (mode == 2) return 256 * (c0 >> 7) + 128 + (c0 & 127);
    return (c0 & ~255) | (((c0 >> 5) & 1) << 7) | (((c0 >> 6) & 3) << 5);
}
DI void tr_item(const float* W, int N, const float* g, bf16_t* dst, int ldd, int kofs, int mode, int item, LAS float* scr, int lane) {
    const int nblk = N / 32, kb = item / nblk, nb = item % nblk, k0 = 64 * kb, c0 = 32 * nb, p0 = maprow(mode, c0);
    const int kr = lane >> 3, c4 = lane & 7;
    f32x4 v[8];
#pragma unroll
    for (int i = 0; i < 8; ++i) v[i] = *(const f32x4*)(W + (size_t)(k0 + 8 * i + kr) * N + c0 + 4 * c4);
    if (g) {
#pragma unroll
        for (int i = 0; i < 8; ++i) v[i] = v[i] * g[k0 + 8 * i + kr];
    }
#pragma unroll
    for (int i = 0; i < 8; ++i) { LAS float* sp = scr + (8 * i + kr) * 33 + 4 * c4; sp[0] = v[i][0]; sp[1] = v[i][1]; sp[2] = v[i][2]; sp[3] = v[i][3]; }
    LDS_WAIT();
    const int c = lane & 7;
#pragma unroll
    for (int j = 0; j < 4; ++j) { const int n = (lane >> 3) + 8 * j; const LAS float* sq = scr + (8 * c) * 33 + n;
        u32x4 o; o.x = pk2(sq[0 * 33], sq[1 * 33]); o.y = pk2(sq[2 * 33], sq[3 * 33]); o.z = pk2(sq[4 * 33], sq[5 * 33]); o.w = pk2(sq[6 * 33], sq[7 * 33]);
        *(u32x4*)(dst + (size_t)(p0 + n) * ldd + kofs + k0 + 8 * c) = o; }
    LDS_WAIT();
}
DI void norm_rows2_bf16(const float* x0, const float* x1, const float* g, bf16_t* o0, bf16_t* o1, int lane) {
    const f32x4* xr0 = (const f32x4*)x0 + lane; const f32x4* xr1 = (const f32x4*)x1 + lane; const f32x4* gr = (const f32x4*)g + lane;
    f32x4 v[2][4]; float s0 = 0.f, s1 = 0.f;
#pragma unroll
    for (int j = 0; j < 4; ++j) { v[0][j] = xr0[64 * j]; v[1][j] = xr1[64 * j]; }
    SCHED_FENCE();
#pragma unroll
    for (int j = 0; j < 4; ++j) { s0 += (v[0][j][0] * v[0][j][0] + v[0][j][1] * v[0][j][1]) + (v[0][j][2] * v[0][j][2] + v[0][j][3] * v[0][j][3]); s1 += (v[1][j][0] * v[1][j][0] + v[1][j][1] * v[1][j][1]) + (v[1][j][2] * v[1][j][2] + v[1][j][3] * v[1][j][3]); }
    const float r0 = rsqrtf(wave_sum(s0) * (1.f / 1024.f) + EPS), r1 = rsqrtf(wave_sum(s1) * (1.f / 1024.f) + EPS);
    u32x2* p0 = (u32x2*)o0 + lane; u32x2* p1 = (u32x2*)o1 + lane;
#pragma unroll
    for (int j = 0; j < 4; ++j) { const f32x4 gg = gr[64 * j]; const f32x4 w0 = v[0][j] * r0 * gg, w1 = v[1][j] * r1 * gg; u32x2 a, b; a.x = pk2(w0[0], w0[1]); a.y = pk2(w0[2], w0[3]); b.x = pk2(w1[0], w1[1]); b.y = pk2(w1[2], w1[3]); p0[64 * j] = a; p1[64 * j] = b; }
}

constexpr int KVR0 = 32 * 127, KVR1 = KVR0 + 32 * 511, KVR_ALL = KVR1 + 32 * 2047;
constexpr int KVQ = 4;
constexpr int KV_TAIL_P10 = 19984, KV_TAIL_P3 = 8592, KV_TAIL_ROWS = KV_TAIL_P10 + KV_TAIL_P3;
struct KvCopy { f32x4 t[KVQ][2]; f32x4* dp[KVQ]; };
template <int NQ> DI void kv_issue(KvCopy& k, const float* c0, const float* c1, const float* c2, float* out, int rowbase, int slot, int lane) {
#pragma unroll
    for (int q = 0; q < NQ; ++q) {
        const int R0 = rowbase + NQ * slot + q; const int R = R0 < KVR_ALL ? R0 : KVR_ALL - 1;
        const int g = R < KVR0 ? 0 : (R < KVR1 ? 1 : 2); const int Rl = R - (g == 0 ? 0 : (g == 1 ? KVR0 : KVR1));
        const int w = g == 0 ? 128 : (g == 1 ? 512 : 2048), wm1 = w - 1; const int b = g == 0 ? Rl / 127 : (g == 1 ? Rl / 511 : Rl / 2047), r = Rl - b * wm1;
        const f32x4* sp = (const f32x4*)(g == 0 ? c0 : (g == 1 ? c1 : c2)) + ((size_t)b * w + r + 1) * 128 + lane;
        f32x4* d = (f32x4*)(out + (g == 0 ? O_KVS0 : (g == 1 ? O_KVS1 : O_KVS2))) + ((size_t)b * w + r) * 128 + lane;
        k.dp[q] = R0 < KVR_ALL ? d : nullptr;
        k.t[q][0] = __builtin_nontemporal_load(sp); k.t[q][1] = __builtin_nontemporal_load(sp + 64);
    }
}
template <int NQ> DI void kv_commit(const KvCopy& k) {
#pragma unroll
    for (int q = 0; q < NQ; ++q) if (k.dp[q]) { __builtin_nontemporal_store(k.t[q][0], k.dp[q]); __builtin_nontemporal_store(k.t[q][1], k.dp[q] + 64); }
}

struct SsmPar { float abr, abi, fr, fi; };
DI SsmPar ssm_par(const float* a_re, const float* a_im, const float* log_dt, int g, int p) {
    const float ar = a_re[g * 64 + p], ai = a_im[g * 64 + p], dt = expf(log_dt[g]);
    const float mag = expf(ar * dt); SsmPar o; o.abr = mag * cosf(ai * dt); o.abi = mag * sinf(ai * dt);
    const float inv = 1.0f / (ar * ar + ai * ai);
    o.fr = ((o.abr - 1.0f) * ar + o.abi * ai) * inv; o.fi = (o.abi * ar - (o.abr - 1.0f) * ai) * inv; return o;
}
struct SsmIn { const float *a_re, *a_im, *log_dt, *b_re, *b_im, *c_re, *c_im, *dsk; };

constexpr size_t WS_SSMT = 576 * 1024, SSMT_TC = 32 * 8 * 64 * 16, SSMT_TA = SSMT_TC + 32 * 4 * 64 * 16;
DI void ssm_build_tables(const SsmIn& W, unsigned char* tb, int g, int lane) {
    const int l15 = lane & 15, quad = lane >> 4;
    { const SsmPar sp = ssm_par(W.a_re, W.a_im, W.log_dt, g, lane); f32x2 ab = {sp.abr, sp.abi}; ((f32x2*)(tb + SSMT_TA))[g * 64 + lane] = ab; }
#pragma unroll
    for (int q = 0; q < 4; ++q) {
        const int p = 16 * q + l15; const SsmPar sp = ssm_par(W.a_re, W.a_im, W.log_dt, g, p);
        f32x4 re0 = {0, 0, 0, 0}, re1 = re0, im0 = re0, im1 = re0;
        if (quad < 2) { const float* br = W.b_re + ((size_t)(g * 64 + p)) * 16 + 8 * quad; const float* bi = W.b_im + ((size_t)(g * 64 + p)) * 16 + 8 * quad;
            const f32x4 r0 = *(const f32x4*)br, r1 = *(const f32x4*)(br + 4), i0 = *(const f32x4*)bi, i1 = *(const f32x4*)(bi + 4);
            re0 = r0 * sp.fr - i0 * sp.fi; re1 = r1 * sp.fr - i1 * sp.fi; im0 = i0 * sp.fr + r0 * sp.fi; im1 = i1 * sp.fr + r1 * sp.fi; }
        ((bf16x8*)tb)[(g * 8 + q) * 64 + lane] = frag_from_f32(re0, re1); ((bf16x8*)tb)[(g * 8 + q + 4) * 64 + lane] = frag_from_f32(im0, im1);
    }
#pragma unroll
    for (int s2 = 0; s2 < 4; ++s2) { const int p0 = 32 * (s2 & 1) + 8 * quad; const float* cp = (s2 < 2 ? W.c_re : W.c_im) + ((size_t)(g * 16 + l15)) * 64 + p0;
        f32x4 c0 = *(const f32x4*)cp, c1 = *(const f32x4*)(cp + 4); if (s2 >= 2) { c0 = -c0; c1 = -c1; } ((bf16x8*)(tb + SSMT_TC))[(g * 4 + s2) * 64 + lane] = frag_from_f32(c0, c1); }
}
struct KvSrc { const float *c0, *c1, *c2; float* out; int slotbase; };

DI void kvshift_rows(const float* c0, const float* c1, const float* c2, float* out, int r_lo, int r_hi, int wk, int nwk, int wave, int lane) {
    const int stride = nwk * 8;
    for (int R0 = r_lo + wk * 8 + wave; R0 < r_hi; R0 += 8 * stride) {
        f32x4 t[8][2]; f32x4* dp[8];
#pragma unroll
        for (int q = 0; q < 8; ++q) {
            int R = R0 + q * stride; R = R < r_hi ? R : r_hi - 1;
            const int g = R < KVR0 ? 0 : (R < KVR1 ? 1 : 2); const int Rl = R - (g == 0 ? 0 : (g == 1 ? KVR0 : KVR1));
            const int w = g == 0 ? 128 : (g == 1 ? 512 : 2048), wm1 = w - 1; const int b = g == 0 ? Rl / 127 : (g == 1 ? Rl / 511 : Rl / 2047), r = Rl - b * wm1;
            const f32x4* sp = (const f32x4*)(g == 0 ? c0 : (g == 1 ? c1 : c2)) + ((size_t)b * w + r + 1) * 128 + lane;
            dp[q] = (f32x4*)(out + (g == 0 ? O_KVS0 : (g == 1 ? O_KVS1 : O_KVS2))) + ((size_t)b * w + r) * 128 + lane;
            t[q][0] = __builtin_nontemporal_load(sp); t[q][1] = __builtin_nontemporal_load(sp + 64);
        }
        SCHED_FENCE();
#pragma unroll
        for (int q = 0; q < 8; ++q) if (R0 + q * stride < r_hi) { __builtin_nontemporal_store(t[q][0], dp[q]); __builtin_nontemporal_store(t[q][1], dp[q] + 64); }
    }
}
DI void kvshift_tail(const float* c0, const float* c1, const float* c2, float* out, int nwg, int r_lo, int r_hi, int wave, int lane) {
    const int G = gridDim.x; const int first = nwg % G; const int wk = (int)blockIdx.x - first;
    if (wk >= 0) kvshift_rows(c0, c1, c2, out, r_lo, r_hi, wk, G - first, wave, lane);
}
template <bool PASS2>
DI void ssm_pass(LAS unsigned char* lds, const SsmIn& W, const unsigned char* TBL, const bf16_t* U, float* SEND, const float* SIN, bf16_t* YG, const KvSrc& KS, int vblk, int vG) {
    const int tid = otid(), wave = tid >> 6, lane = tid & 63, l15 = lane & 15, quad = lane >> 4;
    LAS float* Xs = (LAS float*)(lds + wave * 13312);
    LAS bf16_t* Ss = (LAS bf16_t*)(lds + wave * 13312 + 8448);
    LAS bf16_t* Us = (LAS bf16_t*)(lds + wave * 13312 + 12800);
    const int NGW = vG * 8, gw = vblk * 8 + wave;
    int gcur = -1; bf16x8 bfr[8]; bf16x8 cfr[4]; float abr = 0.f, abi = 0.f, dk = 0.f;
    for (int it = gw; it < 2 * NCH * 32; it += NGW) {
        const int g = it & 31, bc = it >> 5, b = bc >> 7, ch = bc & 127;
        KvCopy kc; kv_issue<2>(kc, KS.c0, KS.c1, KS.c2, KS.out, KS.slotbase, it, lane);
        const int rowc = b * SEQ + ch * TCH;
        bf16x8 uf[4];
#pragma unroll
        for (int sub = 0; sub < 4; ++sub) { uf[sub] = (bf16x8){0, 0, 0, 0, 0, 0, 0, 0}; if (quad < 2) uf[sub] = *(const bf16x8*)(U + (size_t)(rowc + 16 * sub + l15) * 512 + 16 * g + 8 * quad); }
        float sr = 0.f, si = 0.f;
        const size_t sbase = ((size_t)(b * NCH + ch) * 32 + g) * 128;
        if (PASS2) { sr = SIN[sbase + lane]; si = SIN[sbase + 64 + lane]; }
        __builtin_amdgcn_sched_barrier(0);
        if (g != gcur) {
            gcur = g;
            { const f32x2 ab = ((const f32x2*)(TBL + SSMT_TA))[g * 64 + lane]; abr = ab[0]; abi = ab[1]; }
#pragma unroll
            for (int q = 0; q < 8; ++q) bfr[q] = ((const bf16x8*)TBL)[(g * 8 + q) * 64 + lane];
            if (PASS2) {
#pragma unroll
                for (int s2 = 0; s2 < 4; ++s2) cfr[s2] = ((const bf16x8*)(TBL + SSMT_TC))[(g * 4 + s2) * 64 + lane];
                dk = W.dsk[g * 16 + l15];
            }
        }
#pragma unroll
        for (int sub = 0; sub < 4; ++sub) {
            const int row0 = rowc + 16 * sub;
            if (PASS2) { if (quad < 2) *(LAS bf16x8*)(Us + l15 * 16 + 8 * quad) = uf[sub]; }
#pragma unroll
            for (int nt = 0; nt < 8; ++nt) { f32x4 x = {0.f, 0.f, 0.f, 0.f}; x = MFMA16(uf[sub], bfr[nt], x);
#pragma unroll
                for (int j = 0; j < 4; ++j) Xs[(4 * quad + j) * 132 + 16 * nt + l15] = x[j]; }
            LDS_WAIT();
#pragma unroll
            for (int tok = 0; tok < 16; ++tok) {
                const float xr = Xs[tok * 132 + lane], xi = Xs[tok * 132 + 64 + lane];
                const float nr = abr * sr - abi * si + xr, ni = abr * si + abi * sr + xi; sr = nr; si = ni;
                if (PASS2) { Ss[tok * 136 + lane] = f2bf(sr); Ss[tok * 136 + 64 + lane] = f2bf(si); }
            }
            LDS_WAIT();
            if (PASS2) {
                f32x4 y = {0.f, 0.f, 0.f, 0.f};
#pragma unroll
                for (int s2 = 0; s2 < 4; ++s2) { const bf16x8 af = *(const LAS bf16x8*)(Ss + l15 * 136 + 32 * s2 + 8 * quad); y = MFMA16(af, cfr[s2], y); }
#pragma unroll
                for (int j = 0; j < 4; ++j) { const float uv = bf2f(Us[(4 * quad + j) * 16 + l15]); YG[(size_t)(row0 + 4 * quad + j) * 512 + 16 * g + l15] = f2bf(gelu_tanh(y[j] + dk * uv)); }
                LDS_WAIT();
            }
        }
        if (!PASS2) { SEND[sbase + lane] = sr; SEND[sbase + 64 + lane] = si; }
        kv_commit<2>(kc);
    }
}

DI void ssm_carry(const SsmIn& W, const float* SEND, float* SIN, float* out_re, float* out_im, int vblk, int vG) {
    for (int gt = vblk * 512 + otid(); gt < 2 * 32 * 64; gt += vG * 512) {
        const int b = gt >> 11, g = (gt >> 6) & 31, p = gt & 63;
        const SsmPar sp = ssm_par(W.a_re, W.a_im, W.log_dt, g, p);
        float tr = sp.abr, ti = sp.abi;
#pragma unroll
        for (int i = 0; i < 6; ++i) { const float nr = tr * tr - ti * ti, ni = 2.f * tr * ti; tr = nr; ti = ni; }
        float sr = 0.f, si = 0.f;
        for (int c0 = 0; c0 < NCH; c0 += 32) {
            float er[32], ei[32];
#pragma unroll
            for (int j = 0; j < 32; ++j) { const size_t o = ((size_t)(b * NCH + c0 + j) * 32 + g) * 128; er[j] = SEND[o + p]; ei[j] = SEND[o + 64 + p]; }
            SCHED_FENCE();
#pragma unroll
            for (int j = 0; j < 32; ++j) { const size_t o = ((size_t)(b * NCH + c0 + j) * 32 + g) * 128; SIN[o + p] = sr; SIN[o + 64 + p] = si;
                const float nr = tr * sr - ti * si + er[j], ni = tr * si + ti * sr + ei[j]; sr = nr; si = ni; }
        }
        out_re[gt] = sr; out_im[gt] = si;
    }
}

DI void attn_unit(int b, int g, int h, int dl, int rho, int m0, const bf16_t* Q, const bf16_t* K, const bf16_t* V, bf16_t* OG, float* ML, LAS bf16_t* Vs, int lane) {
    const int r = lane & 31, hh = lane >> 5; const int rowb = b * SEQ; const int co = g * 256 + h * 64;
    const int rowq = rowb + rho + ((m0 + r) << dl);
    bf16x8 qf[4]; bf16x8 kf[5][4];
    { const bf16x8* qp = (const bf16x8*)(Q + (size_t)rowq * 768 + co + 32 * hh);
#pragma unroll
      for (int s = 0; s < 4; ++s) qf[s] = qp[s]; }
#pragma unroll
    for (int kb = 0; kb < 5; ++kb) {
        int mk = m0 - 128 + 32 * kb + r; mk = mk < 0 ? 0 : mk;
        const bf16x8* kp = (const bf16x8*)(K + (size_t)(rowb + rho + (mk << dl)) * 768 + co + 32 * hh);
#pragma unroll
        for (int s = 0; s < 4; ++s) kf[kb][s] = kp[s];
    }
    const bf16_t* vbase = V + (size_t)(rowb + rho) * 768 + co + 8 * (lane & 7);
    u32x4 vreg[4];
#define ATT_VLOAD(kb_) do { _Pragma("unroll") for (int i_ = 0; i_ < 4; ++i_) { int kidx_ = m0 - 128 + 32 * (kb_) + 8 * i_ + (lane >> 3); kidx_ = kidx_ < 0 ? 0 : kidx_; \
        vreg[i_] = *(const u32x4*)(vbase + (size_t)(kidx_ << dl) * 768); } } while (0)
#define ATT_VSTORE(buf_) do { _Pragma("unroll") for (int i_ = 0; i_ < 4; ++i_) *(LAS u32x4*)(Vs + (buf_) * 2304 + (8 * i_ + (lane >> 3)) * 72 + 8 * (lane & 7)) = vreg[i_]; } while (0)
    SCHED_FENCE();
    f32x16 st[5];
#pragma unroll
    for (int kb = 0; kb < 5; ++kb) {
        f32x16 a = {};
#pragma unroll
        for (int s = 0; s < 4; ++s) a = MFMA32(kf[kb][s], qf[s], a);
        st[kb] = a;
    }
    SCHED_FENCE();
    ATT_VLOAD(0);
    SCHED_FENCE();
    float mx = -INFINITY; const bool early = m0 < 128;
#pragma unroll
    for (int kb = 0; kb < 5; ++kb)
#pragma unroll
        for (int i = 0; i < 16; ++i) {
            const int c = (i & 3) + 8 * (i >> 2) + 4 * hh; const int kidx = m0 - 128 + 32 * kb + c; const int j = r + 128 - 32 * kb - c;
            float v = st[kb][i];
            if (kb == 0) v = (j <= 128) ? v : -INFINITY;
            if (kb == 4) v = (j >= 0) ? v : -INFINITY;
            if (early) v = (kidx >= 0) ? v : -INFINITY;
            st[kb][i] = v; mx = fmaxf(mx, v);
        }
    mx = fmaxf(mx, __shfl_xor(mx, 32));
    float den = 0.f;
#pragma unroll
    for (int kb = 0; kb < 5; ++kb)
#pragma unroll
        for (int i = 0; i < 16; ++i) { const float p = __builtin_amdgcn_exp2f(st[kb][i] - mx); st[kb][i] = p; den += p; }
    den += __shfl_xor(den, 32);
    SCHED_FENCE();
    ATT_VSTORE(0);
    ATT_VLOAD(1);
    SCHED_FENCE();
    f32x16 ot[2] = {{}, {}};
#pragma unroll
    for (int kb = 0; kb < 5; ++kb) {
        LDS_WAIT();
#pragma unroll
        for (int c = 0; c < 2; ++c) {
            f32x4 p0, p1;
#pragma unroll
            for (int e = 0; e < 4; ++e) { p0[e] = st[kb][8 * c + e]; p1[e] = st[kb][8 * c + 4 + e]; }
            const bf16x8 pf = frag_from_f32(p0, p1);
#pragma unroll
            for (int db = 0; db < 2; ++db) {
                bf16x8 vf;
#pragma unroll
                for (int jj = 0; jj < 8; ++jj) vf[jj] = (short)Vs[(kb & 1) * 2304 + (16 * c + 8 * (jj >> 2) + 4 * hh + (jj & 3)) * 72 + 32 * db + r];
                ot[db] = MFMA32(vf, pf, ot[db]);
            }
        }
        SCHED_FENCE();
        if (kb < 4) { ATT_VSTORE((kb + 1) & 1); if (kb < 3) ATT_VLOAD(kb + 2); }
        SCHED_FENCE();
    }
    LDS_WAIT();
#undef ATT_VLOAD
#undef ATT_VSTORE
    const float inv = 1.0f / den;
    bf16_t* op = OG + ((size_t)g * MT + rowq) * 256 + h * 64;
#pragma unroll
    for (int db = 0; db < 2; ++db)
#pragma unroll
        for (int ig = 0; ig < 4; ++ig) { u32x2 w; w.x = pk2(ot[db][4 * ig] * inv, ot[db][4 * ig + 1] * inv); w.y = pk2(ot[db][4 * ig + 2] * inv, ot[db][4 * ig + 3] * inv);
            *(u32x2*)(op + 32 * db + 8 * ig + 4 * hh) = w; }
    if (hh == 0) { f32x2 ml = {mx, den}; *(f32x2*)(ML + (((size_t)g * MT + rowq) * 4 + h) * 2) = ml; }
}
DI void attn_prompt_phase(LAS unsigned char* lds, const bf16_t* Q, const bf16_t* K, const bf16_t* V, bf16_t* OG, float* ML, const KvSrc& KS, int vblk, int vG) {
    const int tid = otid(); const int wave = tid >> 6, lane = tid & 63; const int NGW = vG * 8, gw = vblk * 8 + wave;
    for (int it = gw; it < 2 * 3 * 4 * 256; it += NGW) {
        const int tile = it & 255, h = (it >> 8) & 3, gb = it >> 10, g = gb % 3, b = gb / 3;
        const int dl = 2 * g;
        const int tpc = 256 >> dl;
        KvCopy kc; kv_issue<4>(kc, KS.c0, KS.c1, KS.c2, KS.out, KS.slotbase, it, lane);
        SCHED_FENCE();
        attn_unit(b, g, h, dl, tile / tpc, 32 * (tile % tpc), Q, K, V, OG, ML, (LAS bf16_t*)(lds + wave * 9216), lane);
        SCHED_FENCE();
        kv_commit<4>(kc);
    }
}
DI void attn_combine(const bf16_t* OG, const float* ML, bf16_t* YY, int vblk, int vG) {
    for (int it = vblk * 512 + otid(); it < MT * 32; it += vG * 512) {
        const int row = it >> 5, h = (it >> 3) & 3, dc = it & 7;
        float m[3], dn[3];
#pragma unroll
        for (int g = 0; g < 3; ++g) { const f32x2 v = *(const f32x2*)(ML + (((size_t)g * MT + row) * 4 + h) * 2); m[g] = v[0]; dn[g] = v[1]; }
        const float mt = fmaxf(m[0], fmaxf(m[1], m[2]));
        f32x4 a0 = {0, 0, 0, 0}, a1 = a0; float wsum = 0.f;
#pragma unroll
        for (int g = 0; g < 3; ++g) { const float w = dn[g] * __builtin_amdgcn_exp2f(m[g] - mt); wsum += w; f32x4 o0, o1; unpack8(*(const u32x4*)(OG + ((size_t)g * MT + row) * 256 + h * 64 + 8 * dc), o0, o1); a0 += o0 * w; a1 += o1 * w; }
        const float inv = 1.0f / wsum;
        *(u32x4*)(YY + (size_t)row * 768 + 512 + h * 64 + 8 * dc) = pack8(a0 * inv, a1 * inv);
    }
}

DI void sample_attn_item(int s, int h, int g, const float* raw3, const float* gqk, const float* cp, float* ko, bf16_t* OG, float* ML, LAS float* sl, int lane) {
    const float* r3 = raw3 + (size_t)s * INW;
    const int w = g == 0 ? 128 : (g == 1 ? 512 : 2048), dl = 2 * g;
    const float q = r3[l2p(512 + 256 * g + 64 * h + lane)], k = r3[l2p(1280 + 256 * g + 64 * h + lane)], v = r3[l2p(2048 + 256 * g + 64 * h + lane)];
    const float qs = wave_sum(q * q), ks = wave_sum(k * k);
    const float qv = q * rsqrtf(qs * (1.f / 64.f) + EPS) * gqk[g * 64 + lane] * QSCALE, kn = k * rsqrtf(ks * (1.f / 64.f) + EPS) * gqk[192 + g * 64 + lane];
    sl[lane] = qv; sl[192 + lane] = v;
    ko[((size_t)(s * w + (w - 1)) * 2 + 0) * 256 + h * 64 + lane] = kn; ko[((size_t)(s * w + (w - 1)) * 2 + 1) * 256 + h * 64 + lane] = v;
    const float s0 = wave_sum(qv * kn);
    LDS_WAIT();
    float sc[2];
#pragma unroll
    for (int half = 0; half < 2; ++half) {
        const int j = 1 + lane + 64 * half; const int rr = w - (j << dl);
        const float* kp = cp + ((size_t)(s * w + rr) * 2 + 0) * 256 + h * 64; float a = 0.f;
#pragma unroll
        for (int d4 = 0; d4 < 16; ++d4) { const f32x4 kk = *(const f32x4*)(kp + 4 * d4); const f32x4 qq = *(const LAS f32x4*)(sl + 4 * d4); a += (kk[0] * qq[0] + kk[1] * qq[1]) + (kk[2] * qq[2] + kk[3] * qq[3]); }
        sc[half] = a;
    }
    const float mx = wave_max(fmaxf(s0, fmaxf(sc[0], sc[1])));
    const float e0 = __builtin_amdgcn_exp2f(s0 - mx), p0 = __builtin_amdgcn_exp2f(sc[0] - mx), p1 = __builtin_amdgcn_exp2f(sc[1] - mx);
    const float den = wave_sum(p0 + p1) + e0;
    sl[64 + lane] = p0; sl[128 + lane] = p1;
    LDS_WAIT();
    const int d4 = lane & 15, kq = lane >> 4;
    f32x4 o = {0.f, 0.f, 0.f, 0.f};
#pragma unroll 8
    for (int i = 0; i < 32; ++i) { const int j = 1 + kq + 4 * i; const int rr = w - (j << dl);
        const f32x4 vv = *(const f32x4*)(cp + ((size_t)(s * w + rr) * 2 + 1) * 256 + h * 64 + 4 * d4); o += vv * sl[64 + j - 1]; }
#pragma unroll
    for (int e = 0; e < 4; ++e) { o[e] += __shfl_xor(o[e], 16); o[e] += __shfl_xor(o[e], 32); }
    if (lane < 16) {
        const f32x4 vn = *(const LAS f32x4*)(sl + 192 + 4 * d4); const float inv = 1.0f / den;
        o = (o + vn * e0) * inv;
        u32x2 wv; wv.x = pk2(o[0], o[1]); wv.y = pk2(o[2], o[3]);
        *(u32x2*)(OG + ((size_t)g * MT + NPR + s) * 256 + h * 64 + 4 * d4) = wv;
    }
    if (lane == 0) { f32x2 ml = {mx, den}; *(f32x2*)(ML + (((size_t)g * MT + NPR + s) * 4 + h) * 2) = ml; }
    LDS_WAIT();
}
DI void sample_ssm_item(int s, int g, const SsmIn& W, const float* raw3, const float* st_re, const float* st_im, float* out_re, float* out_im, bf16_t* YG, int lane) {
    const SsmPar sp = ssm_par(W.a_re, W.a_im, W.log_dt, g, lane);
    const float* r3 = raw3 + (size_t)s * INW;
    float xr = 0.f, xi = 0.f;
    const float* br = W.b_re + (size_t)(g * 64 + lane) * 16; const float* bi = W.b_im + (size_t)(g * 64 + lane) * 16;
#pragma unroll
    for (int c = 0; c < 16; ++c) { const float u = r3[l2p(16 * g + c)]; const float bbr = sp.fr * br[c] - sp.fi * bi[c], bbi = sp.fr * bi[c] + sp.fi * br[c]; xr += bbr * u; xi += bbi * u; }
    const size_t so = (size_t)(s * 32 + g) * 64 + lane;
    const float s0r = st_re[so], s0i = st_im[so];
    const float nr = sp.abr * s0r - sp.abi * s0i + xr, ni = sp.abr * s0i + sp.abi * s0r + xi;
    out_re[so] = nr; out_im[so] = ni;
    float ysel = 0.f;
#pragma unroll
    for (int c = 0; c < 16; ++c) { const float y = wave_sum(W.c_re[(size_t)(g * 16 + c) * 64 + lane] * nr - W.c_im[(size_t)(g * 16 + c) * 64 + lane] * ni); if (lane == c) ysel = y; }
    if (lane < 16) { const float u = r3[l2p(16 * g + lane)]; YG[(size_t)(NPR + s) * 512 + 16 * g + lane] = f2bf(gelu_tanh(ysel + W.dsk[16 * g + lane] * u)); }
}

struct Args { const float* in[32]; float* out; unsigned char* ws; };

__global__ void __launch_bounds__(512, 2) mega_fwd(Args a) {
    extern __shared__ __attribute__((aligned(16))) unsigned char lds_raw[];
    LAS unsigned char* lds = (LAS unsigned char*)lds_raw;
    cg::grid_group grid = cg::this_grid();
    const int tid = threadIdx.x, lane = tid & 63, wave = __builtin_amdgcn_readfirstlane(tid >> 6);
    const int G = gridDim.x, blk = blockIdx.x, gw = blk * 8 + wave, NGW = G * 8;
    unsigned char* const ws = a.ws;
    if (tid < 16) ((LAS unsigned*)(lds + 131072))[tid] = 0u;
    __syncthreads();
    unsigned* const barw = (unsigned*)(ws + 512 * 1024);
    const XcdBarrier xb = xcd_barrier_post(barw, (volatile LAS unsigned*)(lds + 131072 + 32), (unsigned)G);
    const int HG = G / 2;
    const XcdBarrier xbh = xcd_barrier_post(barw + (blk < HG ? 4096 : 8192), (volatile LAS unsigned*)(lds + 131072 + 48), (unsigned)(blk < HG ? HG : G - HG));
#define W1GU ((bf16_t*)(ws + WS_W1GU))
#define W1D ((bf16_t*)(ws + WS_W1D))
#define WIN ((bf16_t*)(ws + WS_WIN))
#define WGLU ((bf16_t*)(ws + WS_WGLU))
#define WSP ((bf16_t*)(ws + WS_WMIX))
#define WAP ((bf16_t*)(ws + WS_WMIX + MiB))
#define TBUF ((bf16_t*)(ws + WS_X1 + 33 * MiB))
#define WO ((bf16_t*)(ws + WS_WO))
#define W2GU ((bf16_t*)(ws + WS_W2GU))
#define W2D ((bf16_t*)(ws + WS_W2D))
#define SEND ((float*)(ws + WS_SEND))
#define SIN ((float*)(ws + WS_SIN))
#define ML ((float*)(ws + WS_ML))
#define SQ1 ((float*)(ws + WS_SQ1))
#define SQ2 ((float*)(ws + WS_SQ2))
#define SR ((float*)(ws + WS_SRAW))
#define XN ((bf16_t*)(ws + WS_XN))
#define X1B ((bf16_t*)(ws + WS_X1B))
#define ACT ((bf16_t*)(ws + WS_ACT))
#define GT ((bf16_t*)(ws + WS_G))
#define OG ((bf16_t*)(ws + WS_OG))
#define YG ((bf16_t*)(ws + WS_YG))
#define YY ((bf16_t*)(ws + WS_YY))
#define X1 ((float*)(ws + WS_X1))
#define GQK ((float*)ws)
#define X2B XN
#define MIXED ((bf16_t*)(ws + WS_X1))
#define Ub ACT
#define Qb (ACT + (size_t)MT * 512)
#define Kb (ACT + (size_t)MT * 512 + (size_t)MT * 768)
#define Vb (ACT + (size_t)MT * 512 + (size_t)MT * 1536)
#define raw1 (SR + SR_RAW1)
#define rawd (SR + SR_RAWD)
#define raw3 (SR + SR_RAW3)
#define rawglu (SR + SR_RAWGLU)
#define rawms (SR + SR_RAWMIX)
#define rawma (SR + SR_RAWMIX + 32 * 1024)
#define rawo (SR + SR_RAWO)
#define raw10 (SR + SR_RAW10)
#define xp (a.in[0])
#define xs (a.in[1])
    float* const out = a.out;
#define SSM_IN(SW) SsmIn SW; SW.a_re = a.in[15]; SW.a_im = a.in[16]; SW.log_dt = a.in[17]; SW.b_re = a.in[18]; SW.b_im = a.in[19]; SW.c_re = a.in[20]; SW.c_im = a.in[21]; SW.dsk = a.in[22];

    constexpr int I_GU = 16 * 88, I_DN = 44 * 32, I_IN = 16 * 152, I_GL = 8 * 16, I_SP = 8 * 32, I_AP = 4 * 32, I_WO = 16 * 32;
#ifndef REP_P0
#define REP_P0 1
#endif
    for (int rep0 = 0; rep0 < REP_P0; ++rep0) {
        LAS float* scr = (LAS float*)(lds + wave * 16384);
        constexpr int NIT = 3 * I_GU + I_IN + I_GL + I_SP + I_AP + I_WO + 3 * I_GU;
        static_assert(I_DN == I_GU, "item counts");
        (void)NIT;
#define TR_JOB(CNT, ...) for (int r = gw; r < (CNT); r += NGW) tr_item(__VA_ARGS__, r, scr, lane);
        TR_JOB(I_GU, a.in[8], FF, nullptr, W1GU, 1024, 0, 1)
        TR_JOB(I_GU, a.in[9], FF, nullptr, W1GU, 1024, 0, 2)
        TR_JOB(I_IN, a.in[12], INW, a.in[11], WIN, 1024, 0, 3)
#undef TR_JOB
        for (int i = blk * 512 + tid; i < NPR; i += G * 512) { SQ1[i] = 0.f; SQ2[i] = 0.f; }
        for (int i = blk * 512 + tid; i < 384; i += G * 512) GQK[i] = i < 192 ? a.in[13][i] : a.in[14][i - 192];
        if (gw >= NGW - 32) { SSM_IN(SWT) ssm_build_tables(SWT, ws + WS_SSMT, gw - (NGW - 32), lane); }
        for (int m = gw; m < MT; m += 2 * NGW) { const int m1 = (m + NGW < MT) ? m + NGW : m;
            norm_rows2_bf16(m < NPR ? xp + (size_t)m * DM : xs + (size_t)(m - NPR) * DM, m1 < NPR ? xp + (size_t)m1 * DM : xs + (size_t)(m1 - NPR) * DM, a.in[7], XN + (size_t)m * DM, XN + (size_t)m1 * DM, lane); }
    }
    if (a.ws == nullptr) grid.sync();
    xcd_barrier(xb);
    {
        pg8::Gemm g{XN, W1GU, NPR, 2 * FF, DM}; pg8::StaticOrder S; S.init(NPR, 2 * FF, G, blk);
        EpiAct<false> E{ACT, nullptr};
        pg8::gemm_phase<EpiAct<false>, pg8::StaticOrder, true, true>(lds, g, S, E);
        ProvBf16 P{XN + (size_t)NPR * DM, DM}; SEpiRaw SE{raw1, 5632};
        skinny_phase<2 * FF, DM>(lds, W1GU, P, SE);
        { const int first = (64 * 22) % G; const int wk = blk - first;
          if (wk >= 0) { LAS float* scr = (LAS float*)(lds + wave * 16384); const int gw2 = wk * 8 + wave, NGW2 = (G - first) * 8;
#define TR_JOB2(CNT, ...) for (int r = gw2; r < (CNT); r += NGW2) tr_item(__VA_ARGS__, r, scr, lane);
            TR_JOB2(I_DN, a.in[10], DM, nullptr, W1D, FF, 0, 0)
            TR_JOB2(I_GL, a.in[23], 512, nullptr, WGLU, 512, 0, 0)
            TR_JOB2(I_SP, a.in[25], DM, nullptr, WSP, 512, 0, 0)
            TR_JOB2(I_AP, a.in[26], DM, nullptr, WAP, 256, 0, 0)
            TR_JOB2(I_WO, a.in[27], DM, nullptr, WO, 1024, 0, 0)
            TR_JOB2(I_GU, a.in[29], FF, a.in[28], W2GU, 1024, 0, 1)
            TR_JOB2(I_GU, a.in[30], FF, a.in[28], W2GU, 1024, 0, 2)
            TR_JOB2(I_DN, a.in[31], DM, nullptr, W2D, FF, 0, 0)
#undef TR_JOB2
          } }
    }
    xcd_barrier(xb);
    {
        pg8::Gemm g{ACT, W1D, NPR, DM, FF}; pg8::StaticOrder S; S.init(NPR, DM, G, blk);
        EpiRes<false> E{xp, nullptr, X1B, SQ1, 0.5f};
        pg8::gemm_phase<EpiRes<false>, pg8::StaticOrder, true, true, -1>(lds, g, S, E);
        ProvAct P{raw1}; SEpiRaw SE{rawd, DM};
        skinny_phase<DM, FF>(lds, W1D, P, SE);
    }
    xcd_barrier(xb);
    {
        pg8::Gemm g{X1B, WIN, NPR, INW, DM}; pg8::StaticOrder S; S.init(NPR, INW, G, blk);
        EpiWin E{SQ1, ACT, GT, GQK, out};
        pg8::gemm_phase<EpiWin, pg8::StaticOrder, true, true>(lds, g, S, E);
        ProvX<false> P{xs, rawd, nullptr}; SEpiRawScaled SE{raw3, INW};
        skinny_phase<INW, DM>(lds, WIN, P, SE);
        kvshift_tail(a.in[2], a.in[3], a.in[4], out, 64 * 19, KV_TAIL_P10, KV_TAIL_ROWS, wave, lane);
    }
    xcd_barrier(xb);
    if (blk < HG) {
        SSM_IN(SW)
        { const KvSrc KS{a.in[2], a.in[3], a.in[4], out, KV_TAIL_ROWS}; ssm_pass<false>(lds, SW, ws + WS_SSMT, Ub, SEND, nullptr, nullptr, KS, blk, HG); }
        xcd_barrier(xbh);
        ssm_carry(SW, SEND, SIN, out + O_SREP, out + O_SIMP, blk, HG);
        xcd_barrier(xbh);
        { const KvSrc KS{a.in[2], a.in[3], a.in[4], out, KV_TAIL_ROWS + 40960}; ssm_pass<true>(lds, SW, ws + WS_SSMT, Ub, nullptr, SIN, YG, KS, blk, HG); }
    } else {
        const int vblk = blk - HG, vG = G - HG, vgw = vblk * 8 + wave, vNGW = vG * 8;
        { const KvSrc KS{a.in[2], a.in[3], a.in[4], out, KV_TAIL_ROWS + 16384}; attn_prompt_phase(lds, Qb, Kb, Vb, OG, ML, KS, vblk, vG); }
        LAS float* sl = (LAS float*)(lds + 110592 + wave * 2560);
        for (int it = vgw; it < 384; it += vNGW) { const int g = it % 3, sh = it / 3;
            sample_attn_item(sh >> 2, sh & 3, g, raw3, GQK, g == 0 ? a.in[2] : (g == 1 ? a.in[3] : a.in[4]), out + (g == 0 ? O_KVS0 : (g == 1 ? O_KVS1 : O_KVS2)), OG, ML, sl, lane); }
        { SSM_IN(SW)
          for (int it = vNGW - 1 - vgw; it < 1024; it += vNGW) sample_ssm_item(it >> 5, it & 31, SW, raw3, a.in[5], a.in[6], out + O_SRES, out + O_SIMS, YG, lane); }
        xcd_barrier(xbh);
        attn_combine(OG, ML, YY, vblk, vG);
    }
    xcd_barrier(xb);
    {
        { pg8::Gemm g{YG, WGLU, NPR, 512, 512}; pg8::StaticOrder S; S.init(NPR, 512, G, blk);
          EpiGlu E{YG, a.in[24], YY};
          pg8::gemm_phase<EpiGlu, pg8::StaticOrder, true, true>(lds, g, S, E); }
        { pg8::Gemm g{YY + 512, WAP, NPR, DM, 256}; pg8::StaticOrder S; S.init(NPR, DM, G, blk);
          EpiGateScale E{GT, TBUF};
          pg8::gemm_phase<EpiGateScale, pg8::StaticOrder, true, true, 768>(lds, g, S, E); }
        { ProvBf16 P{YG + (size_t)NPR * 512, 512}; SEpiRaw SE{rawglu, 512};
          skinny_phase<512, 512>(lds, WGLU, P, SE); }
        { ProvBf16 P{YY + (size_t)NPR * 768 + 512, 768}; SEpiRaw SE{rawma, DM};
          skinny_phase<DM, 256>(lds, WAP, P, SE); }
    }
    xcd_barrier(xb);
    {
        pg8::Gemm g{YY, WSP, NPR, DM, 512}; pg8::StaticOrder S; S.init(NPR, DM, G, blk);
        EpiMix2 E{GT, TBUF, MIXED};
        pg8::gemm_phase<EpiMix2, pg8::StaticOrder, true, true, 768>(lds, g, S, E);
        ProvYY P{YG, rawglu, a.in[24], YY}; SEpiRaw SE{rawms, DM};
        skinny_phase<DM, 512>(lds, WSP, P, SE);
    }
    xcd_barrier(xb);
    {
        pg8::Gemm g{MIXED, WO, NPR, DM, DM}; pg8::StaticOrder S; S.init(NPR, DM, G, blk);
        EpiRes<true> E{X1B, nullptr, X2B, SQ2, 1.0f};
        pg8::gemm_phase<EpiRes<true>, pg8::StaticOrder, true, true>(lds, g, S, E);
        ProvMixed P{raw3, rawms, rawma}; SEpiRaw SE{rawo, DM};
        skinny_phase<DM, DM>(lds, WO, P, SE);
    }
    xcd_barrier(xb);
    {
        pg8::Gemm g{X2B, W2GU, NPR, 2 * FF, DM}; pg8::StaticOrder S; S.init(NPR, 2 * FF, G, blk);
        EpiAct<true> E{ACT, SQ2};
        pg8::gemm_phase<EpiAct<true>, pg8::StaticOrder, true, true>(lds, g, S, E);
        ProvX<true> P{xs, rawd, rawo}; SEpiRawScaled SE{raw10, 5632};
        skinny_phase<2 * FF, DM>(lds, W2GU, P, SE);
        kvshift_tail(a.in[2], a.in[3], a.in[4], out, 64 * 22, 0, KV_TAIL_P10, wave, lane);
    }
    xcd_barrier(xb);
    {
        pg8::Gemm g{ACT, W2D, NPR, DM, FF}; pg8::StaticOrder S; S.init(NPR, DM, G, blk);
        EpiRes<true> E{X2B, out + O_YP, nullptr, nullptr, 0.5f};
        pg8::gemm_phase<EpiRes<true>, pg8::StaticOrder, true, true, -1>(lds, g, S, E);
        ProvAct P{raw10}; SEpiFinal SE{xs, rawd, rawo, out + O_YS};
        skinny_phase<DM, FF>(lds, W2D, P, SE);
    }
}

extern "C" void kernel_launch(void* const* d_in, const int* in_sizes, int n_in, void* d_out, int out_size, void* d_ws, size_t ws_size, hipStream_t stream) {
    static int grid = 0;
    if (grid == 0) {
        if (n_in != 32 || ws_size < WS_END) { fprintf(stderr, "kernel_launch: unexpected inputs (n_in %d, ws %zu)\n", n_in, ws_size); grid = -1; return; }
        int dev = 0, cus = 0, per_cu = 0;
        hipGetDevice(&dev); hipDeviceGetAttribute(&cus, hipDeviceAttributeMultiprocessorCount, dev);
        hipFuncSetAttribute((const void*)mega_fwd, hipFuncAttributeMaxDynamicSharedMemorySize, LDS_BYTES);
        hipOccupancyMaxActiveBlocksPerMultiprocessor(&per_cu, (const void*)mega_fwd, 512, LDS_BYTES);
        if (per_cu < 1) { fprintf(stderr, "kernel_launch: occupancy query says %d blocks/CU\n", per_cu); per_cu = 1; }
        if (per_cu > 1) per_cu = 1;
        grid = cus * per_cu;
        (void)hipGetLastError();
    }
    if (grid < 0) return;
    if (hipMemsetAsync((char*)d_ws + 512 * 1024, 0, 3 * 4096 * 4, stream) != hipSuccess) { fprintf(stderr, "kernel_launch: memset of barrier words failed\n"); return; }
    Args a{};
    for (int i = 0; i < 32; ++i) a.in[i] = (const float*)d_in[i];
    a.out = (float*)d_out; a.ws = (unsigned char*)d_ws;
    void* args[] = {&a};
    hipError_t e = hipLaunchCooperativeKernel((const void*)mega_fwd, dim3(grid), dim3(512), args, LDS_BYTES, stream);
    if (e != hipSuccess) fprintf(stderr, "cooperative launch failed: %s (grid %d)\n", hipGetErrorString(e), grid);
}
```

```cpp
#include <hip/hip_runtime.h>
#include <hip/hip_cooperative_groups.h>
#include <cstdio>
#include <cstdint>
namespace cg = cooperative_groups;
namespace pg8 {
#define PG8_LAS __attribute__((address_space(3)))
typedef unsigned short bf16_t;
typedef short bf16x8 __attribute__((ext_vector_type(8)));
typedef float f32x4 __attribute__((ext_vector_type(4)));
typedef unsigned u32x4 __attribute__((ext_vector_type(4)));
constexpr int BM = 256, BK = 64, HALF = 128, HTB = HALF * BK * 2  , STAGE_BYTES = 8 * HTB, NXCD = 8, WGM = 8;

__host__ __device__ __forceinline__ int lds_byte(int r, int c) { const int st = (r >> 4) * 2 + (c >> 5), rr = r & 15, cc = c & 31, ob = rr * 64 + cc * 2; return st * 1024 + (ob ^ (((ob >> 9) & 1) << 5)); }
__host__ __device__ __forceinline__ void stage_rc(int b, int& R, int& C) { const int st = b / 1024, sb = b % 1024, swz = sb ^ (((sb >> 9) & 1) << 5); R = (st >> 1) * 16 + swz / 64; C = (st & 1) * 32 + (swz % 64) / 2; }
__host__ __device__ __forceinline__ int perm32(int rho) { const int n = rho >> 4, i = rho & 15; return 8 * (i >> 2) + 4 * n + (i & 3); }

struct Unit { int pm, pn; };
struct Gemm { const bf16_t* A; const bf16_t* Bt; int M, N, K; };

struct StaticOrder {
    int nM, nN, nwg, G, c;
    __host__ __device__ void init(int M, int N, int G_, int c_) { nM = M / BM; nN = N / BM; nwg = nM * nN; G = G_; c = c_; }
    __host__ __device__ bool next(int i, Unit& u) const {
        const long L = (long)i * G + c; if (L >= nwg) return false;
        int wgid = (int)L; { const int q = nwg / NXCD, r = nwg % NXCD, xcd = wgid % NXCD, off = wgid / NXCD; wgid = (xcd < r ? xcd * (q + 1) : r * (q + 1) + (xcd - r) * q) + off; }
        const int nig = WGM * nN, gid = wgid / nig, fm = gid * WGM, gsz = (nM - fm) < WGM ? (nM - fm) : WGM;
        u.pm = fm + ((wgid % nig) % gsz); u.pn = (wgid % nig) / gsz; return true;
    }
    __device__ __forceinline__ void a_ready(const Unit&) const {}
    __device__ __forceinline__ void done(const Unit&) const {}
};
template <class Epi, class Sched, bool ALIGN_EPI = false, bool SP2 = false, int LDA_T = 0>
__device__ __forceinline__ void gemm_phase(PG8_LAS unsigned char* lds, const Gemm g, const Sched& S, const Epi& E) {
    int tid_ = threadIdx.x; asm volatile("" : "+v"(tid_));
    const int tid = tid_, wid = __builtin_amdgcn_readfirstlane(tid >> 6), lane = tid & 63, wr = wid >> 2, wc = wid & 3, fr = lane & 15, fq = lane >> 4;
    constexpr bool ABLK = (LDA_T == -1);
    const int K = g.K, nt = K / BK, LDA = ABLK ? BK : (LDA_T ? LDA_T : g.K);
    unsigned voffA[2], voffB[2];
#pragma unroll
    for (int i = 0; i < 2; ++i) { int R, C; stage_rc(tid * 16 + i * 8192, R, C); const int Rb = Epi::PERM ? ((R & ~31) + perm32(R & 31)) : R;
        voffA[i] = (unsigned)(R * LDA + C) * 2u; voffB[i] = (unsigned)(Rb * K + C) * 2u; }
    const size_t kstepB = (size_t)(BK * 2), kstepA = ABLK ? (size_t)(BM * BK * 2) : kstepB;
    const size_t hstepB = (size_t)HALF * K * 2, hstepA = (size_t)HALF * LDA * 2;
    const size_t tstepB = 2 * hstepB, tstepA = ABLK ? (size_t)nt * kstepA : 2 * hstepA;
    const unsigned ldsw = (unsigned)wid * 1024u;
    const int aoff = lds_byte(wr * 64 + fr, fq * 8), boff = lds_byte(wc * 32 + fr, fq * 8);
#define PG8_SA(b, h) (((b) * 2 + (h)) * HTB)
#define PG8_SB(b, h) ((4 + (b) * 2 + (h)) * HTB)
#define PG8_STAGE(bufoff, gbase, voff) do { _Pragma("unroll") for (int _i = 0; _i < 2; ++_i) \
        __builtin_amdgcn_global_load_lds((const unsigned*)((const char*)(gbase) + (voff)[_i]), (PG8_LAS unsigned*)(lds + (bufoff) + ldsw + _i * 8192), 16, 0, 0); } while (0)
#define PG8_LDA(dst, b, h) do { _Pragma("unroll") for (int m = 0; m < 4; ++m) _Pragma("unroll") for (int k = 0; k < 2; ++k) dst[m][k] = *(const PG8_LAS bf16x8*)(lds + PG8_SA(b, h) + aoff + m * 2048 + k * 1024); } while (0)
#define PG8_LDB(dst, b, h) do { _Pragma("unroll") for (int n = 0; n < 2; ++n) _Pragma("unroll") for (int k = 0; k < 2; ++k) dst[n][k] = *(const PG8_LAS bf16x8*)(lds + PG8_SB(b, h) + boff + n * 2048 + k * 1024); } while (0)
#define PG8_MMA(ai, bj, At, Bt) do { __builtin_amdgcn_s_setprio(1); _Pragma("unroll") for (int m = 0; m < 4; ++m) _Pragma("unroll") for (int n = 0; n < 2; ++n) _Pragma("unroll") for (int k = 0; k < 2; ++k) \
        acc[ai][bj][m][n] = __builtin_amdgcn_mfma_f32_16x16x32_bf16(Bt[n][k], At[m][k], acc[ai][bj][m][n], 0, 0, 0); __builtin_amdgcn_s_setprio(0); } while (0)
#define PG8_WAIT_V(n) asm volatile("s_waitcnt vmcnt(" #n ")" ::: "memory")
#define PG8_WAIT_L(n) asm volatile("s_waitcnt lgkmcnt(" #n ")" ::: "memory")
#define PG8_BAR __builtin_amdgcn_s_barrier()
#define PG8_SCHED __builtin_amdgcn_sched_barrier(0)
    Unit cur, nxt; int ui = 0;
    if (!S.next(0, cur)) return;
    f32x4 acc[2][2][4][2];
#pragma unroll
    for (int a = 0; a < 2; ++a)
#pragma unroll
        for (int b = 0; b < 2; ++b)
#pragma unroll
            for (int m = 0; m < 4; ++m)
#pragma unroll
                for (int n = 0; n < 2; ++n) acc[a][b][m][n] = (f32x4){0.f, 0.f, 0.f, 0.f};
    bf16x8 At[4][2], B0[2][2], B1[2][2];
    const char* cA = (const char*)g.A + (size_t)cur.pm * tstepA; const char* cB = (const char*)g.Bt + (size_t)cur.pn * tstepB;
    S.a_ready(cur);
    if constexpr (SP2) {
        PG8_STAGE(PG8_SB(0, 0), cB, voffB); PG8_STAGE(PG8_SB(0, 1), cB + hstepB, voffB); PG8_STAGE(PG8_SA(0, 0), cA, voffA); PG8_STAGE(PG8_SA(0, 1), cA + hstepA, voffA);
        if (wr == 1) PG8_BAR;
        PG8_WAIT_V(2); PG8_BAR;
        PG8_STAGE(PG8_SB(1, 0), cB + kstepB, voffB); PG8_STAGE(PG8_SA(1, 0), cA + kstepA, voffA); PG8_STAGE(PG8_SB(1, 1), cB + hstepB + kstepB, voffB);
        PG8_WAIT_V(6); PG8_BAR;
    } else {
        PG8_STAGE(PG8_SB(0, 0), cB, voffB); PG8_STAGE(PG8_SA(0, 0), cA, voffA); PG8_STAGE(PG8_SB(0, 1), cB + hstepB, voffB); PG8_STAGE(PG8_SA(0, 1), cA + hstepA, voffA);
        if (wr == 1) PG8_BAR;
        PG8_WAIT_V(4); PG8_BAR;
        PG8_STAGE(PG8_SB(1, 0), cB + kstepB, voffB); PG8_STAGE(PG8_SA(1, 0), cA + kstepA, voffA); PG8_STAGE(PG8_SB(1, 1), cB + hstepB + kstepB, voffB);
        PG8_WAIT_V(6); PG8_BAR;
    }
    for (;;) {
        const bool has_next = S.next(ui + 1, nxt);
        const char* nA = has_next ? (const char*)g.A + (size_t)nxt.pm * tstepA : cA; const char* nB = has_next ? (const char*)g.Bt + (size_t)nxt.pn * tstepB : cB;
        for (int t = 0; t < nt; t += 2) {
            const bool last = (t == nt - 2);
            const char* a1 = cA + (size_t)(t + 1) * kstepA;
            const char* a2 = last ? nA : cA + (size_t)(t + 2) * kstepA; const char* b2 = last ? nB : cB + (size_t)(t + 2) * kstepB;
            const char* a3 = a2 + kstepA; const char* b3 = b2 + kstepB;
            if (last && has_next) S.a_ready(nxt);
            if constexpr (SP2) {
            PG8_LDB(B0, 0, 0); PG8_LDB(B1, 0, 1); PG8_SCHED; PG8_LDA(At, 0, 0); PG8_STAGE(PG8_SA(1, 1), a1 + hstepA, voffA);
            PG8_WAIT_V(8); PG8_WAIT_L(0); PG8_BAR; PG8_MMA(0, 0, At, B0); PG8_MMA(0, 1, At, B1); PG8_BAR; PG8_SCHED;
            PG8_LDA(At, 0, 1); PG8_STAGE(PG8_SB(0, 0), b2, voffB); PG8_STAGE(PG8_SB(0, 1), b2 + hstepB, voffB); PG8_STAGE(PG8_SA(0, 0), a2, voffA);
            PG8_WAIT_V(8); PG8_WAIT_L(0); PG8_BAR; PG8_MMA(1, 0, At, B0); PG8_MMA(1, 1, At, B1); PG8_BAR; PG8_SCHED;
            PG8_LDB(B0, 1, 0); PG8_LDB(B1, 1, 1); PG8_SCHED; PG8_LDA(At, 1, 0); PG8_STAGE(PG8_SA(0, 1), a2 + hstepA, voffA);
            PG8_WAIT_V(8); PG8_WAIT_L(0); PG8_BAR; PG8_MMA(0, 0, At, B0); PG8_MMA(0, 1, At, B1); PG8_BAR; PG8_SCHED;
            PG8_LDA(At, 1, 1); PG8_STAGE(PG8_SB(1, 0), b3, voffB); PG8_STAGE(PG8_SB(1, 1), b3 + hstepB, voffB); PG8_STAGE(PG8_SA(1, 0), a3, voffA);
            PG8_WAIT_V(8); PG8_WAIT_L(0); PG8_BAR; PG8_MMA(1, 0, At, B0); PG8_MMA(1, 1, At, B1); PG8_BAR; PG8_SCHED;
            } else {
            PG8_LDB(B0, 0, 0); PG8_SCHED; PG8_LDA(At, 0, 0); PG8_STAGE(PG8_SA(1, 1), a1 + hstepA, voffA);
            PG8_WAIT_L(8); PG8_BAR; PG8_WAIT_L(0); PG8_MMA(0, 0, At, B0); PG8_BAR; PG8_SCHED;
            PG8_LDB(B1, 0, 1); PG8_STAGE(PG8_SB(0, 0), b2, voffB);
            PG8_BAR; PG8_WAIT_L(0); PG8_MMA(0, 1, At, B1); PG8_BAR;
            PG8_LDA(At, 0, 1); PG8_STAGE(PG8_SA(0, 0), a2, voffA);
            PG8_BAR; PG8_WAIT_L(0); PG8_MMA(1, 0, At, B0); PG8_BAR; PG8_SCHED;
            PG8_STAGE(PG8_SB(0, 1), b2 + hstepB, voffB);
            PG8_WAIT_V(6); PG8_BAR; PG8_MMA(1, 1, At, B1); PG8_BAR;
            PG8_LDB(B0, 1, 0); PG8_SCHED; PG8_LDA(At, 1, 0); PG8_STAGE(PG8_SA(0, 1), a2 + hstepA, voffA);
            PG8_WAIT_L(8); PG8_BAR; PG8_WAIT_L(0); PG8_MMA(0, 0, At, B0); PG8_BAR; PG8_SCHED;
            PG8_LDB(B1, 1, 1); PG8_STAGE(PG8_SB(1, 0), b3, voffB);
            PG8_BAR; PG8_WAIT_L(0); PG8_MMA(0, 1, At, B1); PG8_BAR;
            PG8_LDA(At, 1, 1); PG8_STAGE(PG8_SA(1, 0), a3, voffA);
            PG8_BAR; PG8_WAIT_L(0); PG8_MMA(1, 0, At, B0); PG8_BAR; PG8_SCHED;
            PG8_STAGE(PG8_SB(1, 1), b3 + hstepB, voffB);
            PG8_WAIT_V(6); PG8_BAR; PG8_MMA(1, 1, At, B1); PG8_BAR;
            }
        }
        if constexpr (ALIGN_EPI) { if (wr == 0) PG8_BAR; }
        if constexpr (!Epi::AFTER_DRAIN) { E(acc, cur, wr, wc, fr, fq); S.done(cur); }
        if (!has_next) break;
#pragma unroll
        for (int a = 0; a < 2; ++a)
#pragma unroll
            for (int b = 0; b < 2; ++b)
#pragma unroll
                for (int m = 0; m < 4; ++m)
#pragma unroll
                    for (int n = 0; n < 2; ++n) acc[a][b][m][n] = (f32x4){0.f, 0.f, 0.f, 0.f};
        cur = nxt; cA = nA; cB = nB; ++ui;
        if constexpr (ALIGN_EPI) { if (wr == 1) PG8_BAR; }
    }
    PG8_WAIT_V(0);
    if constexpr (!ALIGN_EPI) { if (wr == 0) PG8_BAR; }
    PG8_BAR;
    if constexpr (Epi::AFTER_DRAIN) { E.fused(acc, cur, wr, wc, fr, fq, lds, wid, lane); S.done(cur); }
#undef PG8_SA
#undef PG8_SB
#undef PG8_STAGE
#undef PG8_LDA
#undef PG8_LDB
#undef PG8_MMA
#undef PG8_WAIT_V
#undef PG8_WAIT_L
#undef PG8_BAR
#undef PG8_SCHED
}
}

#define LAS __attribute__((address_space(3)))
#define DI __device__ __forceinline__
typedef unsigned short bf16_t;
typedef short bf16x8 __attribute__((ext_vector_type(8)));
typedef float f32x4 __attribute__((ext_vector_type(4)));
typedef float f32x2 __attribute__((ext_vector_type(2)));
typedef float f32x16 __attribute__((ext_vector_type(16)));
typedef unsigned u32x4 __attribute__((ext_vector_type(4)));
typedef unsigned u32x2 __attribute__((ext_vector_type(2)));
typedef __bf16 bf16x2n __attribute__((ext_vector_type(2)));

constexpr int DM = 1024, FF = 2816, NPR = 16384, NSM = 32, MT = NPR + NSM, SEQ = 8192, INW = 4864;
constexpr float EPS = 1e-6f;
constexpr float QSCALE = 0.125f * 1.4426950408889634f;
constexpr int NCH = 128, TCH = 64;

constexpr size_t MiB = 1u << 20;
constexpr size_t WS_W1GU = 1 * MiB, WS_W1D = 12 * MiB, WS_WIN = 18 * MiB, WS_WGLU = 28 * MiB, WS_WMIX = 29 * MiB, WS_WO = 32 * MiB, WS_W2GU = 34 * MiB, WS_W2D = 45 * MiB;
constexpr size_t WS_SEND = 51 * MiB, WS_SIN = 55 * MiB, WS_ML = 59 * MiB, WS_SQ1 = 61 * MiB, WS_SQ2 = 63 * MiB, WS_SRAW = 65 * MiB;
constexpr size_t WS_XN = 70 * MiB, WS_X1B = 103 * MiB, WS_X1 = 136 * MiB, WS_ACT = 201 * MiB, WS_G = 290 * MiB, WS_OG = 355 * MiB, WS_YG = 380 * MiB, WS_YY = 397 * MiB, WS_END = 422 * MiB;
constexpr size_t SR_RAW1 = 0, SR_RAWD = SR_RAW1 + 32 * 5632, SR_RAW3 = SR_RAWD + 32 * 1024, SR_RAWGLU = SR_RAW3 + 32 * 4864, SR_RAWMIX = SR_RAWGLU + 32 * 512, SR_RAWO = SR_RAWMIX + 32 * 2048,
                 SR_RAW10 = SR_RAWO + 32 * 1024, SR_END = SR_RAW10 + 32 * 5632;
static_assert(SR_END * 4 <= 5 * MiB, "sample raw region");
constexpr size_t O_YP = 0, O_YS = 16777216, O_KVP0 = 16809984, O_KVP1 = 16941056, O_KVP2 = 17465344, O_SREP = 19562496, O_SIMP = 19566592,
                 O_KVS0 = 19570688, O_KVS1 = 21667840, O_KVS2 = 30056448, O_SRES = 63610880, O_SIMS = 63676416;

constexpr int LDS_BYTES = 147456;

DI int otid() { int t = threadIdx.x; asm volatile("" : "+v"(t)); return t; }
DI unsigned pk2(float a, float b) { f32x2 v = {a, b}; bf16x2n r = __builtin_convertvector(v, bf16x2n); return __builtin_bit_cast(unsigned, r); }
DI bf16_t f2bf(float a) { return (bf16_t)(pk2(a, a) & 0xffffu); }
DI float bflo(unsigned w) { return __uint_as_float(w << 16); }
DI float bfhi(unsigned w) { return __uint_as_float(w & 0xffff0000u); }
DI float bf2f(bf16_t b) { return __uint_as_float(((unsigned)b) << 16); }
DI float sigm(float x) { return __builtin_amdgcn_rcpf(1.f + __expf(-x)); }
DI float silu(float x) { return x * sigm(x); }
DI float gelu_tanh(float x) { const float z = 0.7978845608028654f * (x + 0.044715f * x * x * x); const float t = 1.f - 2.f * __builtin_amdgcn_rcpf(1.f + __expf(2.f * z)); return 0.5f * x * (1.f + t); }
DI u32x4 pack8(f32x4 a, f32x4 b) { u32x4 w; w.x = pk2(a[0], a[1]); w.y = pk2(a[2], a[3]); w.z = pk2(b[0], b[1]); w.w = pk2(b[2], b[3]); return w; }
DI void unpack8(u32x4 w, f32x4& a, f32x4& b) { a = (f32x4){bflo(w.x), bfhi(w.x), bflo(w.y), bfhi(w.y)}; b = (f32x4){bflo(w.z), bfhi(w.z), bflo(w.w), bfhi(w.w)}; }
DI float wave_sum(float v) {
#pragma unroll
    for (int o = 1; o < 64; o <<= 1) v += __shfl_xor(v, o);
    return v;
}
DI float wave_max(float v) {
#pragma unroll
    for (int o = 1; o < 64; o <<= 1) v = fmaxf(v, __shfl_xor(v, o));
    return v;
}
DI float rstd16(const float* sq, int row) { return rsqrtf(sq[row] * (1.f / 1024.f) + EPS); }
DI int l2p(int c) { return (c & ~255) | (((c >> 5) & 1) << 7) | (((c >> 6) & 3) << 5) | (c & 31); }
#define LDS_WAIT() asm volatile("s_waitcnt lgkmcnt(0)" ::: "memory")
#define SCHED_FENCE() __builtin_amdgcn_sched_barrier(0)


typedef __attribute__((address_space(1))) unsigned gu32;
#define XB_TMO      128
#define XB_XCNT(j)  (256  + 64 * (j))
#define XB_XSUB(j)  (1280 + 64 * (j))
#define XB_XGEN(j)  (2304 + 64 * (j))
#define XB_TOP      3328
#define XB_TOPGEN   3392
#define XCD_BAR_WORDS 3456
#define XB_SPIN_CAP (1u << 18)

__device__ __forceinline__ unsigned xb_ld(unsigned* p)              { return __hip_atomic_load(p, __ATOMIC_RELAXED, __HIP_MEMORY_SCOPE_AGENT); }
__device__ __forceinline__ unsigned xb_add(unsigned* p, unsigned v) { return __hip_atomic_fetch_add(p, v, __ATOMIC_RELAXED, __HIP_MEMORY_SCOPE_AGENT); }
__device__ __forceinline__ unsigned xb_xcc_id() { return (unsigned)__builtin_amdgcn_s_getreg((3 << 11) | 20) & 0xFu; }
#define XB_SPIN(cond, bar) do { unsigned _sp = 0; while (cond) { __builtin_amdgcn_s_sleep(1); \
    if ((++_sp & 255u) == 0u) { if (xb_ld(&(bar)[XB_TMO])) break; if (_sp > XB_SPIN_CAP) { atomicAdd(&(bar)[XB_TMO], 1u); break; } } } } while (0)

struct XcdBarrier {
    unsigned* bar; unsigned x; unsigned G;
    volatile LAS unsigned* st;
};

__device__ __forceinline__ XcdBarrier xcd_barrier_post(unsigned* bar, volatile LAS unsigned* st, unsigned G) {
    XcdBarrier b; b.bar = bar; b.x = xb_xcc_id(); b.st = st; b.G = G;
    if (threadIdx.x == 0) (void)xb_add(&bar[XB_XCNT(b.x)], 1u);
    return b;
}
__device__ __forceinline__ void xcd_barrier_complete(unsigned* bar, unsigned x, unsigned G, unsigned& nloc, unsigned& nx) {
    unsigned sum, cnt, mine, sp = 0u;
    for (;;) {
        sum = 0u; cnt = 0u; mine = 0u;
#pragma unroll
        for (unsigned j = 0; j < 16; ++j) { const unsigned c = xb_ld(&bar[XB_XCNT(j)]); sum += c; cnt += (c > 0u) ? 1u : 0u; mine = (j == x) ? c : mine; }
        if (sum == G) break;
        __builtin_amdgcn_s_sleep(1);
        if ((++sp & 255u) == 0u) { if (xb_ld(&bar[XB_TMO])) break; if (sp > XB_SPIN_CAP) { atomicAdd(&bar[XB_TMO], 1u); break; } }
    }
    nloc = mine > 0u ? mine : 1u; nx = cnt > 0u ? cnt : 1u;
}

__device__ __forceinline__ void xcd_barrier(const XcdBarrier& b) {
    asm volatile("s_waitcnt vmcnt(0)" ::: "memory");
    __syncthreads();
    if (threadIdx.x == 0) {
        unsigned* bar = b.bar; unsigned bx = b.x; asm volatile("" : "+s"(bx));
        __builtin_amdgcn_s_waitcnt(0);
        unsigned nloc = b.st[0], nx = b.st[1];
        if (nloc == 0u) { xcd_barrier_complete(bar, bx, b.G, nloc, nx); b.st[0] = nloc; b.st[1] = nx; }
        const unsigned old = xb_add(&bar[XB_XSUB(bx)], 1u);
        const unsigned gen = old / nloc;
        if (old + 1u == (gen + 1u) * nloc) {
            __builtin_amdgcn_fence(__ATOMIC_RELEASE, "agent");
            asm volatile("s_waitcnt vmcnt(0)" ::: "memory");
            const unsigned og = xb_add(&bar[XB_TOP], 1u);
            const unsigned tg = og / nx;
            if (og + 1u == (tg + 1u) * nx) xb_add(&bar[XB_TOPGEN], 1u);
            else XB_SPIN(xb_ld(&bar[XB_TOPGEN]) == tg, bar);
            __builtin_amdgcn_fence(__ATOMIC_ACQUIRE, "agent");
            xb_add(&bar[XB_XGEN(bx)], 1u);
            asm volatile("s_waitcnt vmcnt(0)" ::: "memory");
        } else {
            XB_SPIN(xb_ld(&bar[XB_XGEN(bx)]) == gen, bar);
            __builtin_amdgcn_fence(__ATOMIC_ACQUIRE, "agent");
            asm volatile("s_waitcnt vmcnt(0)" ::: "memory");
        }
    }
    __syncthreads();
}

using pg8::Unit;
template <bool RS> struct EpiAct {
    static constexpr bool PERM = true, AFTER_DRAIN = false;
    bf16_t* O; const float* sq;
    DI void operator()(const f32x4 (&acc)[2][2][4][2], const Unit& u, int wr, int wc, int fr, int fq) const {
        const int row0 = u.pm * 256 + wr * 64 + fr, col = u.pn * 128 + wc * 32 + 8 * fq;
        float rs[2][4];
#pragma unroll
        for (int ai = 0; ai < 2; ++ai)
#pragma unroll
            for (int m = 0; m < 4; ++m) rs[ai][m] = RS ? sq[row0 + ai * 128 + m * 16] : 1.f;
        SCHED_FENCE();
#pragma unroll
        for (int ai = 0; ai < 2; ++ai)
#pragma unroll
            for (int m = 0; m < 4; ++m) {
                const int row = row0 + ai * 128 + m * 16; float r1 = 1.f; if (RS) r1 = rsqrtf(rs[ai][m] * (1.f / 1024.f) + EPS);
                f32x4 o[2];
#pragma unroll
                for (int n = 0; n < 2; ++n)
#pragma unroll
                    for (int e = 0; e < 4; ++e) o[n][e] = silu(acc[ai][0][m][n][e] * r1) * (acc[ai][1][m][n][e] * r1);
                *(u32x4*)(O + (((size_t)(row >> 8) * (FF / 64) + (col >> 6)) * 256 + (row & 255)) * 64 + (col & 63)) = pack8(o[0], o[1]);
            }
    }
};
template <bool BF> struct EpiRes {
    static constexpr bool PERM = true, AFTER_DRAIN = false;
    const void* base; float* out; bf16_t* ob; float* sq; float scale;
    DI void operator()(const f32x4 (&acc)[2][2][4][2], const Unit& u, int wr, int wc, int fr, int fq) const {
        const int row0 = u.pm * 256 + wr * 64 + fr;
        constexpr int MB = BF ? 4 : 2;
#pragma unroll
        for (int ai = 0; ai < 2; ++ai)
#pragma unroll
        for (int m0 = 0; m0 < 4; m0 += MB) {
            f32x4 b0[MB][2], b1[MB][2]; u32x4 bw[MB][2];
            SCHED_FENCE();
#pragma unroll
            for (int mm = 0; mm < MB; ++mm)
#pragma unroll
                for (int bj = 0; bj < 2; ++bj) { const size_t off = (size_t)(row0 + ai * 128 + (m0 + mm) * 16) * DM + u.pn * 256 + bj * 128 + wc * 32 + 8 * fq;
                    if (BF) bw[mm][bj] = *(const u32x4*)((const bf16_t*)base + off);
                    else { b0[mm][bj] = *(const f32x4*)((const float*)base + off); b1[mm][bj] = *(const f32x4*)((const float*)base + off + 4); } }
            SCHED_FENCE();
#pragma unroll
            for (int mm = 0; mm < MB; ++mm) {
                const int m = m0 + mm; const int row = row0 + ai * 128 + m * 16; float ss = 0.f;
#pragma unroll
                for (int bj = 0; bj < 2; ++bj) {
                    const size_t off = (size_t)row * DM + u.pn * 256 + bj * 128 + wc * 32 + 8 * fq;
                    f32x4 c0, c1; if (BF) unpack8(bw[mm][bj], c0, c1); else { c0 = b0[mm][bj]; c1 = b1[mm][bj]; }
                    const f32x4 v0 = c0 + acc[ai][bj][m][0] * scale, v1 = c1 + acc[ai][bj][m][1] * scale;
                    if (out) { *(f32x4*)(out + off) = v0; *(f32x4*)(out + off + 4) = v1; }
                    if (ob) *(u32x4*)(ob + off) = pack8(v0, v1);
                    ss += (v0[0] * v0[0] + v0[1] * v0[1]) + (v0[2] * v0[2] + v0[3] * v0[3]) + (v1[0] * v1[0] + v1[1] * v1[1]) + (v1[2] * v1[2] + v1[3] * v1[3]);
                }
                if (sq) { ss += __shfl_xor(ss, 16); ss += __shfl_xor(ss, 32); if (fq == 0) atomicAdd(sq + row, ss); }
            }
        }
    }
};
struct EpiWin {
    static constexpr bool PERM = true, AFTER_DRAIN = false;
    const float* sq; bf16_t* UQKV; bf16_t* G; const float* gqk; float* out;
    DI void operator()(const f32x4 (&acc)[2][2][4][2], const Unit& u, int wr, int wc, int fr, int fq) const {
        const int row0 = u.pm * 256 + wr * 64 + fr, pn = u.pn;
        const int kind = (pn - 2) / 3, g = (pn - 2) % 3;
        float rsq[2][4]; f32x4 gn[2][2];
#pragma unroll
        for (int ai = 0; ai < 2; ++ai)
#pragma unroll
            for (int m = 0; m < 4; ++m) rsq[ai][m] = sq[row0 + ai * 128 + m * 16];
        if (pn >= 2 && pn < 8) { const float* gp = gqk + kind * 192 + g * 64 + 8 * fq;
#pragma unroll
            for (int bj = 0; bj < 2; ++bj) { gn[bj][0] = *(const f32x4*)(gp + bj * 32); gn[bj][1] = *(const f32x4*)(gp + bj * 32 + 4); } }
        else { const f32x4 one = {1.f, 1.f, 1.f, 1.f}; gn[0][0] = one; gn[0][1] = one; gn[1][0] = one; gn[1][1] = one; }
        SCHED_FENCE();
#pragma unroll
        for (int ai = 0; ai < 2; ++ai)
#pragma unroll
            for (int m = 0; m < 4; ++m) {
                const int row = row0 + ai * 128 + m * 16; const float rs = rsqrtf(rsq[ai][m] * (1.f / 1024.f) + EPS);
                f32x4 v[2][2];
#pragma unroll
                for (int bj = 0; bj < 2; ++bj)
#pragma unroll
                    for (int n = 0; n < 2; ++n) v[bj][n] = acc[ai][bj][m][n] * rs;
                if (pn < 2) {
#pragma unroll
                    for (int bj = 0; bj < 2; ++bj) *(u32x4*)(UQKV + (size_t)row * 512 + pn * 256 + wc * 64 + bj * 32 + 8 * fq) = pack8(v[bj][0], v[bj][1]);
                } else if (pn < 11) {
                    float rn = 1.f;
                    if (kind < 2) {
                        float ss = 0.f;
#pragma unroll
                        for (int bj = 0; bj < 2; ++bj)
#pragma unroll
                            for (int n = 0; n < 2; ++n) ss += (v[bj][n][0] * v[bj][n][0] + v[bj][n][1] * v[bj][n][1]) + (v[bj][n][2] * v[bj][n][2] + v[bj][n][3] * v[bj][n][3]);
                        ss += __shfl_xor(ss, 16); ss += __shfl_xor(ss, 32);
                        rn = rsqrtf(ss * (1.f / 64.f) + EPS) * (kind == 0 ? QSCALE : 1.f);
                    }
                    const int t = row & (SEQ - 1), b = row >> 13; const int w = g == 0 ? 128 : (g == 1 ? 512 : 2048);
                    const size_t kvo = g == 0 ? O_KVP0 : (g == 1 ? O_KVP1 : O_KVP2);
                    bf16_t* dstb = UQKV + (size_t)MT * 512 + (size_t)kind * ((size_t)MT * 768) + (size_t)row * 768 + g * 256 + wc * 64 + 8 * fq;
#pragma unroll
                    for (int bj = 0; bj < 2; ++bj) {
                        const f32x4 a0 = v[bj][0] * rn * gn[bj][0], a1 = v[bj][1] * rn * gn[bj][1];
                        *(u32x4*)(dstb + bj * 32) = pack8(a0, a1);
                        if (kind >= 1 && t >= SEQ - w) { float* o = out + kvo + ((size_t)(b * w + (t - (SEQ - w))) * 2 + (kind - 1)) * 256 + wc * 64 + bj * 32 + 8 * fq; *(f32x4*)o = a0; *(f32x4*)(o + 4) = a1; }
                    }
                } else {
#pragma unroll
                    for (int bj = 0; bj < 2; ++bj) {
                        f32x4 a0, a1;
#pragma unroll
                        for (int e = 0; e < 4; ++e) { a0[e] = sigm(v[bj][0][e]); a1[e] = sigm(v[bj][1][e]); }
                        *(u32x4*)(G + (size_t)row * 2048 + (pn - 11) * 256 + wc * 64 + bj * 32 + 8 * fq) = pack8(a0, a1);
                    }
                }
            }
    }
};
struct EpiGlu {
    static constexpr bool PERM = true, AFTER_DRAIN = false;
    const bf16_t* YG; const float* bias; bf16_t* YY;
    DI void operator()(const f32x4 (&acc)[2][2][4][2], const Unit& u, int wr, int wc, int fr, int fq) const {
        const int row0 = u.pm * 256 + wr * 64 + fr;
        f32x4 bb[2][2];
#pragma unroll
        for (int bj = 0; bj < 2; ++bj) { const int col = u.pn * 256 + bj * 128 + wc * 32 + 8 * fq; bb[bj][0] = *(const f32x4*)(bias + col); bb[bj][1] = *(const f32x4*)(bias + col + 4); }
#pragma unroll
        for (int ai = 0; ai < 2; ++ai) {
            u32x4 yw[2][4][2];
            SCHED_FENCE();
#pragma unroll
            for (int bj = 0; bj < 2; ++bj)
#pragma unroll
                for (int m = 0; m < 4; ++m) yw[ai][m][bj] = *(const u32x4*)(YG + (size_t)(row0 + ai * 128 + m * 16) * 512 + u.pn * 256 + bj * 128 + wc * 32 + 8 * fq);
            SCHED_FENCE();
#pragma unroll
            for (int m = 0; m < 4; ++m) {
                const int row = row0 + ai * 128 + m * 16;
#pragma unroll
                for (int bj = 0; bj < 2; ++bj) {
                    const int col = u.pn * 256 + bj * 128 + wc * 32 + 8 * fq;
                    f32x4 y0, y1; unpack8(yw[ai][m][bj], y0, y1);
                    f32x4 o0, o1;
#pragma unroll
                    for (int e = 0; e < 4; ++e) { o0[e] = y0[e] * sigm(acc[ai][bj][m][0][e] + bb[bj][0][e]); o1[e] = y1[e] * sigm(acc[ai][bj][m][1][e] + bb[bj][1][e]); }
                    *(u32x4*)(YY + (size_t)row * 768 + col) = pack8(o0, o1);
                }
            }
        }
    }
};
struct EpiGateScale {
    static constexpr bool PERM = true, AFTER_DRAIN = false;
    const bf16_t* G; bf16_t* T;
    DI void operator()(const f32x4 (&acc)[2][2][4][2], const Unit& u, int wr, int wc, int fr, int fq) const {
        const int row0 = u.pm * 256 + wr * 64 + fr;
#pragma unroll
        for (int ai = 0; ai < 2; ++ai) {
            u32x4 gw[2][4][2];
            SCHED_FENCE();
#pragma unroll
            for (int m = 0; m < 4; ++m)
#pragma unroll
                for (int bj = 0; bj < 2; ++bj) gw[ai][m][bj] = *(const u32x4*)(G + (size_t)(row0 + ai * 128 + m * 16) * 2048 + 1024 + u.pn * 256 + bj * 128 + wc * 32 + 8 * fq);
            SCHED_FENCE();
#pragma unroll
            for (int m = 0; m < 4; ++m) {
                const int row = row0 + ai * 128 + m * 16;
#pragma unroll
                for (int bj = 0; bj < 2; ++bj) { const int col = u.pn * 256 + bj * 128 + wc * 32 + 8 * fq;
                    f32x4 a0, a1; unpack8(gw[ai][m][bj], a0, a1);
                    *(u32x4*)(T + (size_t)row * DM + col) = pack8(a0 * acc[ai][bj][m][0], a1 * acc[ai][bj][m][1]); }
            }
        }
    }
};
struct EpiMix2 {
    static constexpr bool PERM = true, AFTER_DRAIN = false;
    const bf16_t* G; const bf16_t* T; bf16_t* O;
    DI void operator()(const f32x4 (&acc)[2][2][4][2], const Unit& u, int wr, int wc, int fr, int fq) const {
        const int row0 = u.pm * 256 + wr * 64 + fr;
#pragma unroll
        for (int ai = 0; ai < 2; ++ai)
#pragma unroll
        for (int mh = 0; mh < 4; mh += 2) {
            u32x4 gw[4][2], tw[4][2];
            SCHED_FENCE();
#pragma unroll
            for (int m = mh; m < mh + 2; ++m)
#pragma unroll
                for (int bj = 0; bj < 2; ++bj) { const int row = row0 + ai * 128 + m * 16, col = u.pn * 256 + bj * 128 + wc * 32 + 8 * fq;
                    gw[m][bj] = *(const u32x4*)(G + (size_t)row * 2048 + col); tw[m][bj] = *(const u32x4*)(T + (size_t)row * DM + col); }
            SCHED_FENCE();
#pragma unroll
            for (int m = mh; m < mh + 2; ++m) {
                const int row = row0 + ai * 128 + m * 16;
#pragma unroll
                for (int bj = 0; bj < 2; ++bj) { const int col = u.pn * 256 + bj * 128 + wc * 32 + 8 * fq;
                    f32x4 s0, s1, t0, t1; unpack8(gw[m][bj], s0, s1); unpack8(tw[m][bj], t0, t1);
                    *(u32x4*)(O + (size_t)row * DM + col) = pack8(s0 * acc[ai][bj][m][0] + t0, s1 * acc[ai][bj][m][1] + t1); }
            }
        }
    }
};

#define MFMA32(a, b, c) __builtin_amdgcn_mfma_f32_32x32x16_bf16((a), (b), (c), 0, 0, 0)
#define MFMA16(a, b, c) __builtin_amdgcn_mfma_f32_16x16x32_bf16((a), (b), (c), 0, 0, 0)
DI bf16x8 frag_from_f32(f32x4 a, f32x4 b) { return __builtin_bit_cast(bf16x8, pack8(a, b)); }

struct ProvBf16 { const bf16_t* A; int ld; static constexpr bool SQ = false; static constexpr int BATCH = 4;
    struct Raw { bf16x8 v; };
    DI Raw load(int r, int k) const { Raw w; w.v = *(const bf16x8*)(A + (size_t)r * ld + k); return w; }
    DI bf16x8 cvt(const Raw& w, float&) const { return w.v; } };
struct ProvAct { const float* raw; static constexpr bool SQ = false; static constexpr int BATCH = 4;
    struct Raw { f32x4 g0, g1, u0, u1; };
    DI Raw load(int r, int k) const { const float* p = raw + (size_t)r * 5632 + 256 * (k >> 7) + (k & 127); Raw w; w.g0 = *(const f32x4*)p; w.g1 = *(const f32x4*)(p + 4); w.u0 = *(const f32x4*)(p + 128); w.u1 = *(const f32x4*)(p + 132); return w; }
    DI bf16x8 cvt(const Raw& w, float&) const { f32x4 a, b;
#pragma unroll
        for (int e = 0; e < 4; ++e) { a[e] = silu(w.g0[e]) * w.u0[e]; b[e] = silu(w.g1[e]) * w.u1[e]; }
        return frag_from_f32(a, b); } };
template <bool HASO> struct ProvX { const float* xs; const float* rawd; const float* rawo; static constexpr bool SQ = true; static constexpr int BATCH = 2;
    struct Raw { f32x4 x0, x1, d0, d1, o0, o1; };
    DI Raw load(int r, int k) const { const size_t o = (size_t)r * DM + k; Raw w; w.x0 = *(const f32x4*)(xs + o); w.x1 = *(const f32x4*)(xs + o + 4); w.d0 = *(const f32x4*)(rawd + o); w.d1 = *(const f32x4*)(rawd + o + 4);
        if (HASO) { w.o0 = *(const f32x4*)(rawo + o); w.o1 = *(const f32x4*)(rawo + o + 4); } return w; }
    DI bf16x8 cvt(const Raw& w, float& ss) const { f32x4 a = w.x0 + w.d0 * 0.5f, b = w.x1 + w.d1 * 0.5f; if (HASO) { a += w.o0; b += w.o1; }
        ss += (a[0] * a[0] + a[1] * a[1]) + (a[2] * a[2] + a[3] * a[3]) + (b[0] * b[0] + b[1] * b[1]) + (b[2] * b[2] + b[3] * b[3]);
        return frag_from_f32(a, b); } };
struct ProvYY { const bf16_t* YG; const float* rawglu; const float* bias; const bf16_t* YY; static constexpr bool SQ = false; static constexpr int BATCH = 3;
    struct Raw { u32x4 y; f32x4 z0, z1, b0, b1; };
    DI Raw load(int r, int k) const { Raw w; const f32x4 z = {0.f, 0.f, 0.f, 0.f}; w.z0 = z; w.z1 = z; w.b0 = z; w.b1 = z;
        if (k >= 512) { w.y = *(const u32x4*)(YY + (size_t)(NPR + r) * 768 + k); }
        else { w.y = *(const u32x4*)(YG + (size_t)(NPR + r) * 512 + k); w.z0 = *(const f32x4*)(rawglu + r * 512 + k); w.z1 = *(const f32x4*)(rawglu + r * 512 + k + 4); w.b0 = *(const f32x4*)(bias + k); w.b1 = *(const f32x4*)(bias + k + 4); }
        return w; }
    DI bf16x8 cvt(const Raw& w, float&, int k) const { return __builtin_bit_cast(bf16x8, w.y); }
    DI bf16x8 cvt(const Raw& w, float&) const { return __builtin_bit_cast(bf16x8, w.y); }
    DI bf16x8 cvtk(const Raw& w, int k) const {
        if (k >= 512) return __builtin_bit_cast(bf16x8, w.y);
        f32x4 y0, y1; unpack8(w.y, y0, y1); f32x4 a, b;
#pragma unroll
        for (int e = 0; e < 4; ++e) { a[e] = y0[e] * sigm(w.z0[e] + w.b0[e]); b[e] = y1[e] * sigm(w.z1[e] + w.b1[e]); }
        return frag_from_f32(a, b); } };
struct ProvMixed { const float* raw3; const float* rawms; const float* rawma; static constexpr bool SQ = false; static constexpr int BATCH = 2;
    struct Raw { f32x4 s0, s1, a0, a1, m0, m1, n0, n1; };
    DI Raw load(int r, int k) const { const float* gs = raw3 + (size_t)r * INW + l2p(2816 + k); const float* ga = raw3 + (size_t)r * INW + l2p(3840 + k);
        Raw w; w.s0 = *(const f32x4*)gs; w.s1 = *(const f32x4*)(gs + 4); w.a0 = *(const f32x4*)ga; w.a1 = *(const f32x4*)(ga + 4);
        w.m0 = *(const f32x4*)(rawms + r * DM + k); w.m1 = *(const f32x4*)(rawms + r * DM + k + 4); w.n0 = *(const f32x4*)(rawma + r * DM + k); w.n1 = *(const f32x4*)(rawma + r * DM + k + 4); return w; }
    DI bf16x8 cvt(const Raw& w, float&) const { f32x4 a, b;
#pragma unroll
        for (int e = 0; e < 4; ++e) { a[e] = sigm(w.s0[e]) * w.m0[e] + sigm(w.a0[e]) * w.n0[e]; b[e] = sigm(w.s1[e]) * w.m1[e] + sigm(w.a1[e]) * w.n1[e]; }
        return frag_from_f32(a, b); } };
template <class P> struct ProvTraits { static constexpr bool NEEDK = false; };
template <> struct ProvTraits<ProvYY> { static constexpr bool NEEDK = true; };
struct SEpiRaw { float* dst; int ld; DI void operator()(int row, int col, float v, float) const { dst[(size_t)row * ld + col] = v; } };
struct SEpiRawScaled { float* dst; int ld; DI void operator()(int row, int col, float v, float rs) const { dst[(size_t)row * ld + col] = v * rs; } };
struct SEpiFinal { const float* xs; const float* rawd; const float* rawo; float* out; DI void operator()(int row, int col, float v, float) const { const size_t o = (size_t)row * DM + col; out[o] = xs[o] + 0.5f * rawd[o] + rawo[o] + 0.5f * v; } };

template <int N, int K, class Prov, class SEpi>
DI void skinny_phase(LAS unsigned char* lds, const bf16_t* Bt, const Prov& P, const SEpi& E) {
    const int tid = otid(), wave = tid >> 6, lane = tid & 63, r = lane & 31, hh = lane >> 5, G = gridDim.x;
    LAS float* red = (LAS float*)lds;
    LAS float* sqp = (LAS float*)(lds + 32768);
    LAS float* rsd = (LAS float*)(lds + 32768 + 2048);
    constexpr int ntiles = N / 32, kper = K / 8, NIT = kper / 32, BATCH = Prov::BATCH;
    for (int tile = G - 1 - (int)blockIdx.x; tile < ntiles; tile += G) {
        const int n0 = tile * 32;
        f32x16 acc = {};
        float ss = 0.f;
        const bf16_t* bp = Bt + (size_t)(n0 + r) * K + wave * kper + 16 * hh;
        const int kbase = wave * kper + 16 * hh;
#pragma unroll
        for (int i0 = 0; i0 < NIT; i0 += BATCH) {
            typename Prov::Raw ra[BATCH][2]; bf16x8 rb[BATCH][2];
            SCHED_FENCE();
#pragma unroll
            for (int u = 0; u < BATCH; ++u) if (i0 + u < NIT) { const int k = kbase + 32 * (i0 + u);
                ra[u][0] = P.load(r, k); ra[u][1] = P.load(r, k + 8); rb[u][0] = *(const bf16x8*)(bp + 32 * (i0 + u)); rb[u][1] = *(const bf16x8*)(bp + 32 * (i0 + u) + 8); }
            SCHED_FENCE();
#pragma unroll
            for (int u = 0; u < BATCH; ++u) if (i0 + u < NIT) { const int k = kbase + 32 * (i0 + u);
                bf16x8 a0, a1;
                if constexpr (ProvTraits<Prov>::NEEDK) { a0 = P.cvtk(ra[u][0], k); a1 = P.cvtk(ra[u][1], k + 8); } else { a0 = P.cvt(ra[u][0], ss); a1 = P.cvt(ra[u][1], ss); }
                acc = MFMA32(a0, rb[u][0], acc); acc = MFMA32(a1, rb[u][1], acc); }
        }
#pragma unroll
        for (int i = 0; i < 16; ++i) red[wave * 1024 + ((i & 3) + 8 * (i >> 2) + 4 * hh) * 32 + r] = acc[i];
        if (Prov::SQ) sqp[(wave * 2 + hh) * 32 + r] = ss;
        __syncthreads();
        if (Prov::SQ) { if (tid < 32) { float sm = 0.f; for (int j = 0; j < 16; ++j) sm += sqp[j * 32 + tid]; rsd[tid] = rsqrtf(sm * (1.f / 1024.f) + EPS); } __syncthreads(); }
#pragma unroll
        for (int h2 = 0; h2 < 2; ++h2) { const int e = tid + 512 * h2; float sm = 0.f;
#pragma unroll
            for (int w = 0; w < 8; ++w) sm += red[w * 1024 + e];
            E(e >> 5, n0 + (e & 31), sm, Prov::SQ ? rsd[e >> 5] : 1.f); }
        __syncthreads();
    }
}

DI int maprow(int mode, int c0) {
    if (mode == 0) return c0;
    if (mode == 1) return 256 * (c0 >> 7) + (c0 & 127);
    if (mode == 2) return 256 * (c0 >> 7) + 128 + (c0 & 127);
    return (c0 & ~255) | (((c0 >> 5) & 1) << 7) | (((c0 >> 6) & 3) << 5);
}
DI void tr_item(const float* W, int N, const float* g, bf16_t* dst, int ldd, int kofs, int mode, int item, LAS float* scr, int lane) {
    const int nblk = N / 32, kb = item / nblk, nb = item % nblk, k0 = 64 * kb, c0 = 32 * nb, p0 = maprow(mode, c0);
    const int kr = lane >> 3, c4 = lane & 7;
    f32x4 v[8];
#pragma unroll
    for (int i = 0; i < 8; ++i) v[i] = *(const f32x4*)(W + (size_t)(k0 + 8 * i + kr) * N + c0 + 4 * c4);
    if (g) {
#pragma unroll
        for (int i = 0; i < 8; ++i) v[i] = v[i] * g[k0 + 8 * i + kr];
    }
#pragma unroll
    for (int i = 0; i < 8; ++i) { LAS float* sp = scr + (8 * i + kr) * 33 + 4 * c4; sp[0] = v[i][0]; sp[1] = v[i][1]; sp[2] = v[i][2]; sp[3] = v[i][3]; }
    LDS_WAIT();
    const int c = lane & 7;
#pragma unroll
    for (int j = 0; j < 4; ++j) { const int n = (lane >> 3) + 8 * j; const LAS float* sq = scr + (8 * c) * 33 + n;
        u32x4 o; o.x = pk2(sq[0 * 33], sq[1 * 33]); o.y = pk2(sq[2 * 33], sq[3 * 33]); o.z = pk2(sq[4 * 33], sq[5 * 33]); o.w = pk2(sq[6 * 33], sq[7 * 33]);
        *(u32x4*)(dst + (size_t)(p0 + n) * ldd + kofs + k0 + 8 * c) = o; }
    LDS_WAIT();
}
DI void norm_rows2_bf16(const float* x0, const float* x1, const float* g, bf16_t* o0, bf16_t* o1, int lane) {
    const f32x4* xr0 = (const f32x4*)x0 + lane; const f32x4* xr1 = (const f32x4*)x1 + lane; const f32x4* gr = (const f32x4*)g + lane;
    f32x4 v[2][4]; float s0 = 0.f, s1 = 0.f;
#pragma unroll
    for (int j = 0; j < 4; ++j) { v[0][j] = xr0[64 * j]; v[1][j] = xr1[64 * j]; }
    SCHED_FENCE();
#pragma unroll
    for (int j = 0; j < 4; ++j) { s0 += (v[0][j][0] * v[0][j][0] + v[0][j][1] * v[0][j][1]) + (v[0][j][2] * v[0][j][2] + v[0][j][3] * v[0][j][3]); s1 += (v[1][j][0] * v[1][j][0] + v[1][j][1] * v[1][j][1]) + (v[1][j][2] * v[1][j][2] + v[1][j][3] * v[1][j][3]); }
    const float r0 = rsqrtf(wave_sum(s0) * (1.f / 1024.f) + EPS), r1 = rsqrtf(wave_sum(s1) * (1.f / 1024.f) + EPS);
    u32x2* p0 = (u32x2*)o0 + lane; u32x2* p1 = (u32x2*)o1 + lane;
#pragma unroll
    for (int j = 0; j < 4; ++j) { const f32x4 gg = gr[64 * j]; const f32x4 w0 = v[0][j] * r0 * gg, w1 = v[1][j] * r1 * gg; u32x2 a, b; a.x = pk2(w0[0], w0[1]); a.y = pk2(w0[2], w0[3]); b.x = pk2(w1[0], w1[1]); b.y = pk2(w1[2], w1[3]); p0[64 * j] = a; p1[64 * j] = b; }
}

constexpr int KVR0 = 32 * 127, KVR1 = KVR0 + 32 * 511, KVR_ALL = KVR1 + 32 * 2047;
constexpr int KVQ = 4;
constexpr int KV_TAIL_P10 = 19984, KV_TAIL_P3 = 8592, KV_TAIL_ROWS = KV_TAIL_P10 + KV_TAIL_P3;
struct KvCopy { f32x4 t[KVQ][2]; f32x4* dp[KVQ]; };
template <int NQ> DI void kv_issue(KvCopy& k, const float* c0, const float* c1, const float* c2, float* out, int rowbase, int slot, int lane) {
#pragma unroll
    for (int q = 0; q < NQ; ++q) {
        const int R0 = rowbase + NQ * slot + q; const int R = R0 < KVR_ALL ? R0 : KVR_ALL - 1;
        const int g = R < KVR0 ? 0 : (R < KVR1 ? 1 : 2); const int Rl = R - (g == 0 ? 0 : (g == 1 ? KVR0 : KVR1));
        const int w = g == 0 ? 128 : (g == 1 ? 512 : 2048), wm1 = w - 1; const int b = g == 0 ? Rl / 127 : (g == 1 ? Rl / 511 : Rl / 2047), r = Rl - b * wm1;
        const f32x4* sp = (const f32x4*)(g == 0 ? c0 : (g == 1 ? c1 : c2)) + ((size_t)b * w + r + 1) * 128 + lane;
        f32x4* d = (f32x4*)(out + (g == 0 ? O_KVS0 : (g == 1 ? O_KVS1 : O_KVS2))) + ((size_t)b * w + r) * 128 + lane;
        k.dp[q] = R0 < KVR_ALL ? d : nullptr;
        k.t[q][0] = __builtin_nontemporal_load(sp); k.t[q][1] = __builtin_nontemporal_load(sp + 64);
    }
}
template <int NQ> DI void kv_commit(const KvCopy& k) {
#pragma unroll
    for (int q = 0; q < NQ; ++q) if (k.dp[q]) { __builtin_nontemporal_store(k.t[q][0], k.dp[q]); __builtin_nontemporal_store(k.t[q][1], k.dp[q] + 64); }
}

struct SsmPar { float abr, abi, fr, fi; };
DI SsmPar ssm_par(const float* a_re, const float* a_im, const float* log_dt, int g, int p) {
    const float ar = a_re[g * 64 + p], ai = a_im[g * 64 + p], dt = expf(log_dt[g]);
    const float mag = expf(ar * dt); SsmPar o; o.abr = mag * cosf(ai * dt); o.abi = mag * sinf(ai * dt);
    const float inv = 1.0f / (ar * ar + ai * ai);
    o.fr = ((o.abr - 1.0f) * ar + o.abi * ai) * inv; o.fi = (o.abi * ar - (o.abr - 1.0f) * ai) * inv; return o;
}
struct SsmIn { const float *a_re, *a_im, *log_dt, *b_re, *b_im, *c_re, *c_im, *dsk; };

constexpr size_t WS_SSMT = 576 * 1024, SSMT_TC = 32 * 8 * 64 * 16, SSMT_TA = SSMT_TC + 32 * 4 * 64 * 16;
DI void ssm_build_tables(const SsmIn& W, unsigned char* tb, int g, int lane) {
    const int l15 = lane & 15, quad = lane >> 4;
    { const SsmPar sp = ssm_par(W.a_re, W.a_im, W.log_dt, g, lane); f32x2 ab = {sp.abr, sp.abi}; ((f32x2*)(tb + SSMT_TA))[g * 64 + lane] = ab; }
#pragma unroll
    for (int nt = 0; nt < 8; ++nt) {
        const int p = 8 * nt + (l15 >> 1), ri = l15 & 1; const SsmPar sp = ssm_par(W.a_re, W.a_im, W.log_dt, g, p);
        f32x4 v0 = {0, 0, 0, 0}, v1 = v0;
        if (quad < 2) { const float* br = W.b_re + ((size_t)(g * 64 + p)) * 16 + 8 * quad; const float* bi = W.b_im + ((size_t)(g * 64 + p)) * 16 + 8 * quad;
            const f32x4 r0 = *(const f32x4*)br, r1 = *(const f32x4*)(br + 4), i0 = *(const f32x4*)bi, i1 = *(const f32x4*)(bi + 4);
            if (ri == 0) { v0 = r0 * sp.fr - i0 * sp.fi; v1 = r1 * sp.fr - i1 * sp.fi; } else { v0 = i0 * sp.fr + r0 * sp.fi; v1 = i1 * sp.fr + r1 * sp.fi; } }
        ((bf16x8*)tb)[(g * 8 + nt) * 64 + lane] = frag_from_f32(v0, v1);
    }
#pragma unroll
    for (int s2 = 0; s2 < 4; ++s2) { const int p0 = 16 * s2 + 4 * quad; const float* cr = W.c_re + ((size_t)(g * 16 + l15)) * 64 + p0; const float* ci = W.c_im + ((size_t)(g * 16 + l15)) * 64 + p0;
        const f32x4 r = *(const f32x4*)cr, i = *(const f32x4*)ci;
        const f32x4 c0 = {r[0], -i[0], r[1], -i[1]}, c1 = {r[2], -i[2], r[3], -i[3]};
        ((bf16x8*)(tb + SSMT_TC))[(g * 4 + s2) * 64 + lane] = frag_from_f32(c0, c1); }
}
struct KvSrc { const float *c0, *c1, *c2; float* out; int slotbase; };

DI void kvshift_rows(const float* c0, const float* c1, const float* c2, float* out, int r_lo, int r_hi, int wk, int nwk, int wave, int lane) {
    const int stride = nwk * 8;
    for (int R0 = r_lo + wk * 8 + wave; R0 < r_hi; R0 += 8 * stride) {
        f32x4 t[8][2]; f32x4* dp[8];
#pragma unroll
        for (int q = 0; q < 8; ++q) {
            int R = R0 + q * stride; R = R < r_hi ? R : r_hi - 1;
            const int g = R < KVR0 ? 0 : (R < KVR1 ? 1 : 2); const int Rl = R - (g == 0 ? 0 : (g == 1 ? KVR0 : KVR1));
            const int w = g == 0 ? 128 : (g == 1 ? 512 : 2048), wm1 = w - 1; const int b = g == 0 ? Rl / 127 : (g == 1 ? Rl / 511 : Rl / 2047), r = Rl - b * wm1;
            const f32x4* sp = (const f32x4*)(g == 0 ? c0 : (g == 1 ? c1 : c2)) + ((size_t)b * w + r + 1) * 128 + lane;
            dp[q] = (f32x4*)(out + (g == 0 ? O_KVS0 : (g == 1 ? O_KVS1 : O_KVS2))) + ((size_t)b * w + r) * 128 + lane;
            t[q][0] = __builtin_nontemporal_load(sp); t[q][1] = __builtin_nontemporal_load(sp + 64);
        }
        SCHED_FENCE();
#pragma unroll
        for (int q = 0; q < 8; ++q) if (R0 + q * stride < r_hi) { __builtin_nontemporal_store(t[q][0], dp[q]); __builtin_nontemporal_store(t[q][1], dp[q] + 64); }
    }
}
DI void kvshift_tail(const float* c0, const float* c1, const float* c2, float* out, int nwg, int r_lo, int r_hi, int wave, int lane) {
    const int G = gridDim.x; const int first = nwg % G; const int wk = (int)blockIdx.x - first;
    if (wk >= 0) kvshift_rows(c0, c1, c2, out, r_lo, r_hi, wk, G - first, wave, lane);
}
template <bool PASS2>
DI void ssm_pass(LAS unsigned char* lds, const SsmIn& W, const unsigned char* TBL, const bf16_t* U, float* SEND, const float* SIN, bf16_t* YG, const KvSrc& KS, int vblk, int vG) {
    const int tid = otid(), wave = tid >> 6, lane = tid & 63, l15 = lane & 15, quad = lane >> 4;
    LAS float* Xs = (LAS float*)(lds + wave * 13312);
    LAS bf16_t* Ss = (LAS bf16_t*)(lds + wave * 13312 + 8448);
    LAS bf16_t* Us = (LAS bf16_t*)(lds + wave * 13312 + 12800);
    const int NGW = vG * 8, gw = vblk * 8 + wave;
    int gcur = -1; bf16x8 bfr[8]; bf16x8 cfr[4]; float abr = 0.f, abi = 0.f, dk = 0.f;
    for (int it = gw; it < 2 * NCH * 32; it += NGW) {
        const int g = it & 31, bc = it >> 5, b = bc >> 7, ch = bc & 127;
        KvCopy kc; kv_issue<2>(kc, KS.c0, KS.c1, KS.c2, KS.out, KS.slotbase, it, lane);
        const int rowc = b * SEQ + ch * TCH;
        bf16x8 uf[4];
#pragma unroll
        for (int sub = 0; sub < 4; ++sub) { uf[sub] = (bf16x8){0, 0, 0, 0, 0, 0, 0, 0}; if (quad < 2) uf[sub] = *(const bf16x8*)(U + (size_t)(rowc + 16 * sub + l15) * 512 + 16 * g + 8 * quad); }
        float sr = 0.f, si = 0.f;
        const size_t sbase = ((size_t)(b * NCH + ch) * 32 + g) * 128;
        if (PASS2) { sr = SIN[sbase + lane]; si = SIN[sbase + 64 + lane]; }
        __builtin_amdgcn_sched_barrier(0);
        if (g != gcur) {
            gcur = g;
            { const f32x2 ab = ((const f32x2*)(TBL + SSMT_TA))[g * 64 + lane]; abr = ab[0]; abi = ab[1]; }
#pragma unroll
            for (int q = 0; q < 8; ++q) bfr[q] = ((const bf16x8*)TBL)[(g * 8 + q) * 64 + lane];
            if (PASS2) {
#pragma unroll
                for (int s2 = 0; s2 < 4; ++s2) cfr[s2] = ((const bf16x8*)(TBL + SSMT_TC))[(g * 4 + s2) * 64 + lane];
                dk = W.dsk[g * 16 + l15];
            }
        }
#pragma unroll
        for (int sub = 0; sub < 4; ++sub) {
            const int row0 = rowc + 16 * sub;
            if (PASS2) { if (quad < 2) *(LAS bf16x8*)(Us + l15 * 16 + 8 * quad) = uf[sub]; }
#pragma unroll
            for (int nt = 0; nt < 8; ++nt) { f32x4 x = {0.f, 0.f, 0.f, 0.f}; x = MFMA16(uf[sub], bfr[nt], x);
#pragma unroll
                for (int j = 0; j < 4; ++j) Xs[(4 * quad + j) * 132 + 16 * nt + l15] = x[j]; }
            LDS_WAIT();
#pragma unroll
            for (int tok = 0; tok < 16; ++tok) {
                const f32x2 xx = *(const LAS f32x2*)(Xs + tok * 132 + 2 * lane);
                const float nr = abr * sr - abi * si + xx[0], ni = abr * si + abi * sr + xx[1]; sr = nr; si = ni;
                if (PASS2) *(LAS unsigned*)(Ss + tok * 136 + 2 * lane) = pk2(sr, si);
            }
            LDS_WAIT();
            if (PASS2) {
                f32x4 y = {0.f, 0.f, 0.f, 0.f};
#pragma unroll
                for (int s2 = 0; s2 < 4; ++s2) { const bf16x8 af = *(const LAS bf16x8*)(Ss + l15 * 136 + 32 * s2 + 8 * quad); y = MFMA16(af, cfr[s2], y); }
#pragma unroll
                for (int j = 0; j < 4; ++j) { const float uv = bf2f(Us[(4 * quad + j) * 16 + l15]); YG[(size_t)(row0 + 4 * quad + j) * 512 + 16 * g + l15] = f2bf(gelu_tanh(y[j] + dk * uv)); }
                LDS_WAIT();
            }
        }
        if (!PASS2) { SEND[sbase + lane] = sr; SEND[sbase + 64 + lane] = si; }
        kv_commit<2>(kc);
    }
}

DI void ssm_carry(const SsmIn& W, const float* SEND, float* SIN, float* out_re, float* out_im, int vblk, int vG) {
    for (int gt = vblk * 512 + otid(); gt < 2 * 32 * 64; gt += vG * 512) {
        const int b = gt >> 11, g = (gt >> 6) & 31, p = gt & 63;
        const SsmPar sp = ssm_par(W.a_re, W.a_im, W.log_dt, g, p);
        float tr = sp.abr, ti = sp.abi;
#pragma unroll
        for (int i = 0; i < 6; ++i) { const float nr = tr * tr - ti * ti, ni = 2.f * tr * ti; tr = nr; ti = ni; }
        float sr = 0.f, si = 0.f;
        for (int c0 = 0; c0 < NCH; c0 += 32) {
            float er[32], ei[32];
#pragma unroll
            for (int j = 0; j < 32; ++j) { const size_t o = ((size_t)(b * NCH + c0 + j) * 32 + g) * 128; er[j] = SEND[o + p]; ei[j] = SEND[o + 64 + p]; }
            SCHED_FENCE();
#pragma unroll
            for (int j = 0; j < 32; ++j) { const size_t o = ((size_t)(b * NCH + c0 + j) * 32 + g) * 128; SIN[o + p] = sr; SIN[o + 64 + p] = si;
                const float nr = tr * sr - ti * si + er[j], ni = tr * si + ti * sr + ei[j]; sr = nr; si = ni; }
        }
        out_re[gt] = sr; out_im[gt] = si;
    }
}

DI void attn_unit(int b, int g, int h, int dl, int rho, int m0, const bf16_t* Q, const bf16_t* K, const bf16_t* V, bf16_t* OG, float* ML, LAS bf16_t* Vs, int lane) {
    const int r = lane & 31, hh = lane >> 5; const int rowb = b * SEQ; const int co = g * 256 + h * 64;
    const int rowq = rowb + rho + ((m0 + r) << dl);
    bf16x8 qf[4]; bf16x8 kf[5][4];
    { const bf16x8* qp = (const bf16x8*)(Q + (size_t)rowq * 768 + co + 32 * hh);
#pragma unroll
      for (int s = 0; s < 4; ++s) qf[s] = qp[s]; }
#pragma unroll
    for (int kb = 0; kb < 5; ++kb) {
        int mk = m0 - 128 + 32 * kb + r; mk = mk < 0 ? 0 : mk;
        const bf16x8* kp = (const bf16x8*)(K + (size_t)(rowb + rho + (mk << dl)) * 768 + co + 32 * hh);
#pragma unroll
        for (int s = 0; s < 4; ++s) kf[kb][s] = kp[s];
    }
    const bf16_t* vbase = V + (size_t)(rowb + rho) * 768 + co + 8 * (lane & 7);
    u32x4 vreg[4];
#define ATT_VLOAD(kb_) do { _Pragma("unroll") for (int i_ = 0; i_ < 4; ++i_) { int kidx_ = m0 - 128 + 32 * (kb_) + 8 * i_ + (lane >> 3); kidx_ = kidx_ < 0 ? 0 : kidx_; \
        vreg[i_] = *(const u32x4*)(vbase + (size_t)(kidx_ << dl) * 768); } } while (0)
#define ATT_VSTORE(buf_) do { _Pragma("unroll") for (int i_ = 0; i_ < 4; ++i_) *(LAS u32x4*)(Vs + (buf_) * 2304 + (8 * i_ + (lane >> 3)) * 72 + 8 * (lane & 7)) = vreg[i_]; } while (0)
    SCHED_FENCE();
    f32x16 st[5];
#pragma unroll
    for (int kb = 0; kb < 5; ++kb) {
        f32x16 a = {};
#pragma unroll
        for (int s = 0; s < 4; ++s) a = MFMA32(kf[kb][s], qf[s], a);
        st[kb] = a;
    }
    SCHED_FENCE();
    ATT_VLOAD(0);
    SCHED_FENCE();
    float mx = -INFINITY; const bool early = m0 < 128;
#pragma unroll
    for (int kb = 0; kb < 5; ++kb)
#pragma unroll
        for (int i = 0; i < 16; ++i) {
            const int c = (i & 3) + 8 * (i >> 2) + 4 * hh; const int kidx = m0 - 128 + 32 * kb + c; const int j = r + 128 - 32 * kb - c;
            float v = st[kb][i];
            if (kb == 0) v = (j <= 128) ? v : -INFINITY;
            if (kb == 4) v = (j >= 0) ? v : -INFINITY;
            if (early) v = (kidx >= 0) ? v : -INFINITY;
            st[kb][i] = v; mx = fmaxf(mx, v);
        }
    mx = fmaxf(mx, __shfl_xor(mx, 32));
    float den = 0.f;
#pragma unroll
    for (int kb = 0; kb < 5; ++kb)
#pragma unroll
        for (int i = 0; i < 16; ++i) { const float p = __builtin_amdgcn_exp2f(st[kb][i] - mx); st[kb][i] = p; den += p; }
    den += __shfl_xor(den, 32);
    SCHED_FENCE();
    ATT_VSTORE(0);
    ATT_VLOAD(1);
    SCHED_FENCE();
    f32x16 ot[2] = {{}, {}};
#pragma unroll
    for (int kb = 0; kb < 5; ++kb) {
        LDS_WAIT();
#pragma unroll
        for (int c = 0; c < 2; ++c) {
            f32x4 p0, p1;
#pragma unroll
            for (int e = 0; e < 4; ++e) { p0[e] = st[kb][8 * c + e]; p1[e] = st[kb][8 * c + 4 + e]; }
            const bf16x8 pf = frag_from_f32(p0, p1);
#pragma unroll
            for (int db = 0; db < 2; ++db) {
                bf16x8 vf;
#pragma unroll
                for (int jj = 0; jj < 8; ++jj) vf[jj] = (short)Vs[(kb & 1) * 2304 + (16 * c + 8 * (jj >> 2) + 4 * hh + (jj & 3)) * 72 + 32 * db + r];
                ot[db] = MFMA32(vf, pf, ot[db]);
            }
        }
        SCHED_FENCE();
        if (kb < 4) { ATT_VSTORE((kb + 1) & 1); if (kb < 3) ATT_VLOAD(kb + 2); }
        SCHED_FENCE();
    }
    LDS_WAIT();
#undef ATT_VLOAD
#undef ATT_VSTORE
    const float inv = 1.0f / den;
    bf16_t* op = OG + ((size_t)g * MT + rowq) * 256 + h * 64;
#pragma unroll
    for (int db = 0; db < 2; ++db)
#pragma unroll
        for (int ig = 0; ig < 4; ++ig) { u32x2 w; w.x = pk2(ot[db][4 * ig] * inv, ot[db][4 * ig + 1] * inv); w.y = pk2(ot[db][4 * ig + 2] * inv, ot[db][4 * ig + 3] * inv);
            *(u32x2*)(op + 32 * db + 8 * ig + 4 * hh) = w; }
    if (hh == 0) { f32x2 ml = {mx, den}; *(f32x2*)(ML + (((size_t)g * MT + rowq) * 4 + h) * 2) = ml; }
}
DI void attn_prompt_phase(LAS unsigned char* lds, const bf16_t* Q, const bf16_t* K, const bf16_t* V, bf16_t* OG, float* ML, const KvSrc& KS, int vblk, int vG) {
    const int tid = otid(); const int wave = tid >> 6, lane = tid & 63; const int NGW = vG * 8, gw = vblk * 8 + wave;
    for (int it = gw; it < 2 * 3 * 4 * 256; it += NGW) {
        const int tile = it & 255, h = (it >> 8) & 3, gb = it >> 10, g = gb % 3, b = gb / 3;
        const int dl = 2 * g;
        const int tpc = 256 >> dl;
        KvCopy kc; kv_issue<4>(kc, KS.c0, KS.c1, KS.c2, KS.out, KS.slotbase, it, lane);
        SCHED_FENCE();
        attn_unit(b, g, h, dl, tile / tpc, 32 * (tile % tpc), Q, K, V, OG, ML, (LAS bf16_t*)(lds + wave * 9216), lane);
        SCHED_FENCE();
        kv_commit<4>(kc);
    }
}
DI void attn_combine(const bf16_t* OG, const float* ML, bf16_t* YY, int vblk, int vG) {
    for (int it = vblk * 512 + otid(); it < MT * 32; it += vG * 512) {
        const int row = it >> 5, h = (it >> 3) & 3, dc = it & 7;
        float m[3], dn[3];
#pragma unroll
        for (int g = 0; g < 3; ++g) { const f32x2 v = *(const f32x2*)(ML + (((size_t)g * MT + row) * 4 + h) * 2); m[g] = v[0]; dn[g] = v[1]; }
        const float mt = fmaxf(m[0], fmaxf(m[1], m[2]));
        f32x4 a0 = {0, 0, 0, 0}, a1 = a0; float wsum = 0.f;
#pragma unroll
        for (int g = 0; g < 3; ++g) { const float w = dn[g] * __builtin_amdgcn_exp2f(m[g] - mt); wsum += w; f32x4 o0, o1; unpack8(*(const u32x4*)(OG + ((size_t)g * MT + row) * 256 + h * 64 + 8 * dc), o0, o1); a0 += o0 * w; a1 += o1 * w; }
        const float inv = 1.0f / wsum;
        *(u32x4*)(YY + (size_t)row * 768 + 512 + h * 64 + 8 * dc) = pack8(a0 * inv, a1 * inv);
    }
}

DI void sample_attn_item(int s, int h, int g, const float* raw3, const float* gqk, const float* cp, float* ko, bf16_t* OG, float* ML, LAS float* sl, int lane) {
    const float* r3 = raw3 + (size_t)s * INW;
    const int w = g == 0 ? 128 : (g == 1 ? 512 : 2048), dl = 2 * g;
    const float q = r3[l2p(512 + 256 * g + 64 * h + lane)], k = r3[l2p(1280 + 256 * g + 64 * h + lane)], v = r3[l2p(2048 + 256 * g + 64 * h + lane)];
    const float qs = wave_sum(q * q), ks = wave_sum(k * k);
    const float qv = q * rsqrtf(qs * (1.f / 64.f) + EPS) * gqk[g * 64 + lane] * QSCALE, kn = k * rsqrtf(ks * (1.f / 64.f) + EPS) * gqk[192 + g * 64 + lane];
    sl[lane] = qv; sl[192 + lane] = v;
    ko[((size_t)(s * w + (w - 1)) * 2 + 0) * 256 + h * 64 + lane] = kn; ko[((size_t)(s * w + (w - 1)) * 2 + 1) * 256 + h * 64 + lane] = v;
    const float s0 = wave_sum(qv * kn);
    LDS_WAIT();
    float sc[2];
#pragma unroll
    for (int half = 0; half < 2; ++half) {
        const int j = 1 + lane + 64 * half; const int rr = w - (j << dl);
        const float* kp = cp + ((size_t)(s * w + rr) * 2 + 0) * 256 + h * 64; float a = 0.f;
#pragma unroll
        for (int d4 = 0; d4 < 16; ++d4) { const f32x4 kk = *(const f32x4*)(kp + 4 * d4); const f32x4 qq = *(const LAS f32x4*)(sl + 4 * d4); a += (kk[0] * qq[0] + kk[1] * qq[1]) + (kk[2] * qq[2] + kk[3] * qq[3]); }
        sc[half] = a;
    }
    const float mx = wave_max(fmaxf(s0, fmaxf(sc[0], sc[1])));
    const float e0 = __builtin_amdgcn_exp2f(s0 - mx), p0 = __builtin_amdgcn_exp2f(sc[0] - mx), p1 = __builtin_amdgcn_exp2f(sc[1] - mx);
    const float den = wave_sum(p0 + p1) + e0;
    sl[64 + lane] = p0; sl[128 + lane] = p1;
    LDS_WAIT();
    const int d4 = lane & 15, kq = lane >> 4;
    f32x4 o = {0.f, 0.f, 0.f, 0.f};
#pragma unroll 8
    for (int i = 0; i < 32; ++i) { const int j = 1 + kq + 4 * i; const int rr = w - (j << dl);
        const f32x4 vv = *(const f32x4*)(cp + ((size_t)(s * w + rr) * 2 + 1) * 256 + h * 64 + 4 * d4); o += vv * sl[64 + j - 1]; }
#pragma unroll
    for (int e = 0; e < 4; ++e) { o[e] += __shfl_xor(o[e], 16); o[e] += __shfl_xor(o[e], 32); }
    if (lane < 16) {
        const f32x4 vn = *(const LAS f32x4*)(sl + 192 + 4 * d4); const float inv = 1.0f / den;
        o = (o + vn * e0) * inv;
        u32x2 wv; wv.x = pk2(o[0], o[1]); wv.y = pk2(o[2], o[3]);
        *(u32x2*)(OG + ((size_t)g * MT + NPR + s) * 256 + h * 64 + 4 * d4) = wv;
    }
    if (lane == 0) { f32x2 ml = {mx, den}; *(f32x2*)(ML + (((size_t)g * MT + NPR + s) * 4 + h) * 2) = ml; }
    LDS_WAIT();
}
DI void sample_ssm_item(int s, int g, const SsmIn& W, const float* raw3, const float* st_re, const float* st_im, float* out_re, float* out_im, bf16_t* YG, int lane) {
    const SsmPar sp = ssm_par(W.a_re, W.a_im, W.log_dt, g, lane);
    const float* r3 = raw3 + (size_t)s * INW;
    float xr = 0.f, xi = 0.f;
    const float* br = W.b_re + (size_t)(g * 64 + lane) * 16; const float* bi = W.b_im + (size_t)(g * 64 + lane) * 16;
#pragma unroll
    for (int c = 0; c < 16; ++c) { const float u = r3[l2p(16 * g + c)]; const float bbr = sp.fr * br[c] - sp.fi * bi[c], bbi = sp.fr * bi[c] + sp.fi * br[c]; xr += bbr * u; xi += bbi * u; }
    const size_t so = (size_t)(s * 32 + g) * 64 + lane;
    const float s0r = st_re[so], s0i = st_im[so];
    const float nr = sp.abr * s0r - sp.abi * s0i + xr, ni = sp.abr * s0i + sp.abi * s0r + xi;
    out_re[so] = nr; out_im[so] = ni;
    float ysel = 0.f;
#pragma unroll
    for (int c = 0; c < 16; ++c) { const float y = wave_sum(W.c_re[(size_t)(g * 16 + c) * 64 + lane] * nr - W.c_im[(size_t)(g * 16 + c) * 64 + lane] * ni); if (lane == c) ysel = y; }
    if (lane < 16) { const float u = r3[l2p(16 * g + lane)]; YG[(size_t)(NPR + s) * 512 + 16 * g + lane] = f2bf(gelu_tanh(ysel + W.dsk[16 * g + lane] * u)); }
}

struct Args { const float* in[32]; float* out; unsigned char* ws; };

__global__ void __launch_bounds__(512, 2) mega_fwd(Args a) {
    extern __shared__ __attribute__((aligned(16))) unsigned char lds_raw[];
    LAS unsigned char* lds = (LAS unsigned char*)lds_raw;
    cg::grid_group grid = cg::this_grid();
    const int tid = threadIdx.x, lane = tid & 63, wave = __builtin_amdgcn_readfirstlane(tid >> 6);
    const int G = gridDim.x, blk = blockIdx.x, gw = blk * 8 + wave, NGW = G * 8;
    unsigned char* const ws = a.ws;
    if (tid < 16) ((LAS unsigned*)(lds + 131072))[tid] = 0u;
    __syncthreads();
    unsigned* const barw = (unsigned*)(ws + 512 * 1024);
    const XcdBarrier xb = xcd_barrier_post(barw, (volatile LAS unsigned*)(lds + 131072 + 32), (unsigned)G);
    const int HG = G / 2;
    const XcdBarrier xbh = xcd_barrier_post(barw + (blk < HG ? 4096 : 8192), (volatile LAS unsigned*)(lds + 131072 + 48), (unsigned)(blk < HG ? HG : G - HG));
#define W1GU ((bf16_t*)(ws + WS_W1GU))
#define W1D ((bf16_t*)(ws + WS_W1D))
#define WIN ((bf16_t*)(ws + WS_WIN))
#define WGLU ((bf16_t*)(ws + WS_WGLU))
#define WSP ((bf16_t*)(ws + WS_WMIX))
#define WAP ((bf16_t*)(ws + WS_WMIX + MiB))
#define TBUF ((bf16_t*)(ws + WS_X1 + 33 * MiB))
#define WO ((bf16_t*)(ws + WS_WO))
#define W2GU ((bf16_t*)(ws + WS_W2GU))
#define W2D ((bf16_t*)(ws + WS_W2D))
#define SEND ((float*)(ws + WS_SEND))
#define SIN ((float*)(ws + WS_SIN))
#define ML ((float*)(ws + WS_ML))
#define SQ1 ((float*)(ws + WS_SQ1))
#define SQ2 ((float*)(ws + WS_SQ2))
#define SR ((float*)(ws + WS_SRAW))
#define XN ((bf16_t*)(ws + WS_XN))
#define X1B ((bf16_t*)(ws + WS_X1B))
#define ACT ((bf16_t*)(ws + WS_ACT))
#define GT ((bf16_t*)(ws + WS_G))
#define OG ((bf16_t*)(ws + WS_OG))
#define YG ((bf16_t*)(ws + WS_YG))
#define YY ((bf16_t*)(ws + WS_YY))
#define X1 ((float*)(ws + WS_X1))
#define GQK ((float*)ws)
#define X2B XN
#define MIXED ((bf16_t*)(ws + WS_X1))
#define Ub ACT
#define Qb (ACT + (size_t)MT * 512)
#define Kb (ACT + (size_t)MT * 512 + (size_t)MT * 768)
#define Vb (ACT + (size_t)MT * 512 + (size_t)MT * 1536)
#define raw1 (SR + SR_RAW1)
#define rawd (SR + SR_RAWD)
#define raw3 (SR + SR_RAW3)
#define rawglu (SR + SR_RAWGLU)
#define rawms (SR + SR_RAWMIX)
#define rawma (SR + SR_RAWMIX + 32 * 1024)
#define rawo (SR + SR_RAWO)
#define raw10 (SR + SR_RAW10)
#define xp (a.in[0])
#define xs (a.in[1])
    float* const out = a.out;
#define SSM_IN(SW) SsmIn SW; SW.a_re = a.in[15]; SW.a_im = a.in[16]; SW.log_dt = a.in[17]; SW.b_re = a.in[18]; SW.b_im = a.in[19]; SW.c_re = a.in[20]; SW.c_im = a.in[21]; SW.dsk = a.in[22];

    constexpr int I_GU = 16 * 88, I_DN = 44 * 32, I_IN = 16 * 152, I_GL = 8 * 16, I_SP = 8 * 32, I_AP = 4 * 32, I_WO = 16 * 32;
#ifndef REP_P0
#define REP_P0 1
#endif
    for (int rep0 = 0; rep0 < REP_P0; ++rep0) {
        LAS float* scr = (LAS float*)(lds + wave * 16384);
        constexpr int NIT = 3 * I_GU + I_IN + I_GL + I_SP + I_AP + I_WO + 3 * I_GU;
        static_assert(I_DN == I_GU, "item counts");
        (void)NIT;
#define TR_JOB(CNT, ...) for (int r = gw; r < (CNT); r += NGW) tr_item(__VA_ARGS__, r, scr, lane);
        TR_JOB(I_GU, a.in[8], FF, nullptr, W1GU, 1024, 0, 1)
        TR_JOB(I_GU, a.in[9], FF, nullptr, W1GU, 1024, 0, 2)
        TR_JOB(I_IN, a.in[12], INW, a.in[11], WIN, 1024, 0, 3)
#undef TR_JOB
        for (int i = blk * 512 + tid; i < NPR; i += G * 512) { SQ1[i] = 0.f; SQ2[i] = 0.f; }
        for (int i = blk * 512 + tid; i < 384; i += G * 512) GQK[i] = i < 192 ? a.in[13][i] : a.in[14][i - 192];
        if (gw >= NGW - 32) { SSM_IN(SWT) ssm_build_tables(SWT, ws + WS_SSMT, gw - (NGW - 32), lane); }
        for (int m = gw; m < MT; m += 2 * NGW) { const int m1 = (m + NGW < MT) ? m + NGW : m;
            norm_rows2_bf16(m < NPR ? xp + (size_t)m * DM : xs + (size_t)(m - NPR) * DM, m1 < NPR ? xp + (size_t)m1 * DM : xs + (size_t)(m1 - NPR) * DM, a.in[7], XN + (size_t)m * DM, XN + (size_t)m1 * DM, lane); }
    }
    if (a.ws == nullptr) grid.sync();
    xcd_barrier(xb);
    {
        pg8::Gemm g{XN, W1GU, NPR, 2 * FF, DM}; pg8::StaticOrder S; S.init(NPR, 2 * FF, G, blk);
        EpiAct<false> E{ACT, nullptr};
        pg8::gemm_phase<EpiAct<false>, pg8::StaticOrder, true, true>(lds, g, S, E);
        ProvBf16 P{XN + (size_t)NPR * DM, DM}; SEpiRaw SE{raw1, 5632};
        skinny_phase<2 * FF, DM>(lds, W1GU, P, SE);
        { const int first = (64 * 22) % G; const int wk = blk - first;
          if (wk >= 0) { LAS float* scr = (LAS float*)(lds + wave * 16384); const int gw2 = wk * 8 + wave, NGW2 = (G - first) * 8;
#define TR_JOB2(CNT, ...) for (int r = gw2; r < (CNT); r += NGW2) tr_item(__VA_ARGS__, r, scr, lane);
            TR_JOB2(I_DN, a.in[10], DM, nullptr, W1D, FF, 0, 0)
            TR_JOB2(I_GL, a.in[23], 512, nullptr, WGLU, 512, 0, 0)
            TR_JOB2(I_SP, a.in[25], DM, nullptr, WSP, 512, 0, 0)
            TR_JOB2(I_AP, a.in[26], DM, nullptr, WAP, 256, 0, 0)
            TR_JOB2(I_WO, a.in[27], DM, nullptr, WO, 1024, 0, 0)
            TR_JOB2(I_GU, a.in[29], FF, a.in[28], W2GU, 1024, 0, 1)
            TR_JOB2(I_GU, a.in[30], FF, a.in[28], W2GU, 1024, 0, 2)
            TR_JOB2(I_DN, a.in[31], DM, nullptr, W2D, FF, 0, 0)
#undef TR_JOB2
          } }
    }
    xcd_barrier(xb);
    {
        pg8::Gemm g{ACT, W1D, NPR, DM, FF}; pg8::StaticOrder S; S.init(NPR, DM, G, blk);
        EpiRes<false> E{xp, nullptr, X1B, SQ1, 0.5f};
        pg8::gemm_phase<EpiRes<false>, pg8::StaticOrder, true, true, -1>(lds, g, S, E);
        ProvAct P{raw1}; SEpiRaw SE{rawd, DM};
        skinny_phase<DM, FF>(lds, W1D, P, SE);
    }
    xcd_barrier(xb);
    {
        pg8::Gemm g{X1B, WIN, NPR, INW, DM}; pg8::StaticOrder S; S.init(NPR, INW, G, blk);
        EpiWin E{SQ1, ACT, GT, GQK, out};
        pg8::gemm_phase<EpiWin, pg8::StaticOrder, true, true>(lds, g, S, E);
        ProvX<false> P{xs, rawd, nullptr}; SEpiRawScaled SE{raw3, INW};
        skinny_phase<INW, DM>(lds, WIN, P, SE);
        kvshift_tail(a.in[2], a.in[3], a.in[4], out, 64 * 19, KV_TAIL_P10, KV_TAIL_ROWS, wave, lane);
    }
    xcd_barrier(xb);
    if (blk < HG) {
        SSM_IN(SW)
        { const KvSrc KS{a.in[2], a.in[3], a.in[4], out, KV_TAIL_ROWS}; ssm_pass<false>(lds, SW, ws + WS_SSMT, Ub, SEND, nullptr, nullptr, KS, blk, HG); }
        xcd_barrier(xbh);
        ssm_carry(SW, SEND, SIN, out + O_SREP, out + O_SIMP, blk, HG);
        xcd_barrier(xbh);
        { const KvSrc KS{a.in[2], a.in[3], a.in[4], out, KV_TAIL_ROWS + 40960}; ssm_pass<true>(lds, SW, ws + WS_SSMT, Ub, nullptr, SIN, YG, KS, blk, HG); }
    } else {
        const int vblk = blk - HG, vG = G - HG, vgw = vblk * 8 + wave, vNGW = vG * 8;
        { const KvSrc KS{a.in[2], a.in[3], a.in[4], out, KV_TAIL_ROWS + 16384}; attn_prompt_phase(lds, Qb, Kb, Vb, OG, ML, KS, vblk, vG); }
        LAS float* sl = (LAS float*)(lds + 110592 + wave * 2560);
        for (int it = vgw; it < 384; it += vNGW) { const int g = it % 3, sh = it / 3;
            sample_attn_item(sh >> 2, sh & 3, g, raw3, GQK, g == 0 ? a.in[2] : (g == 1 ? a.in[3] : a.in[4]), out + (g == 0 ? O_KVS0 : (g == 1 ? O_KVS1 : O_KVS2)), OG, ML, sl, lane); }
        { SSM_IN(SW)
          for (int it = vNGW - 1 - vgw; it < 1024; it += vNGW) sample_ssm_item(it >> 5, it & 31, SW, raw3, a.in[5], a.in[6], out + O_SRES, out + O_SIMS, YG, lane); }
        xcd_barrier(xbh);
        attn_combine(OG, ML, YY, vblk, vG);
    }
    xcd_barrier(xb);
    {
        { pg8::Gemm g{YG, WGLU, NPR, 512, 512}; pg8::StaticOrder S; S.init(NPR, 512, G, blk);
          EpiGlu E{YG, a.in[24], YY};
          pg8::gemm_phase<EpiGlu, pg8::StaticOrder, true, true>(lds, g, S, E); }
        { pg8::Gemm g{YY + 512, WAP, NPR, DM, 256}; pg8::StaticOrder S; S.init(NPR, DM, G, blk);
          EpiGateScale E{GT, TBUF};
          pg8::gemm_phase<EpiGateScale, pg8::StaticOrder, true, true, 768>(lds, g, S, E); }
        { ProvBf16 P{YG + (size_t)NPR * 512, 512}; SEpiRaw SE{rawglu, 512};
          skinny_phase<512, 512>(lds, WGLU, P, SE); }
        { ProvBf16 P{YY + (size_t)NPR * 768 + 512, 768}; SEpiRaw SE{rawma, DM};
          skinny_phase<DM, 256>(lds, WAP, P, SE); }
    }
    xcd_barrier(xb);
    {
        pg8::Gemm g{YY, WSP, NPR, DM, 512}; pg8::StaticOrder S; S.init(NPR, DM, G, blk);
        EpiMix2 E{GT, TBUF, MIXED};
        pg8::gemm_phase<EpiMix2, pg8::StaticOrder, true, true, 768>(lds, g, S, E);
        ProvYY P{YG, rawglu, a.in[24], YY}; SEpiRaw SE{rawms, DM};
        skinny_phase<DM, 512>(lds, WSP, P, SE);
    }
    xcd_barrier(xb);
    {
        pg8::Gemm g{MIXED, WO, NPR, DM, DM}; pg8::StaticOrder S; S.init(NPR, DM, G, blk);
        EpiRes<true> E{X1B, nullptr, X2B, SQ2, 1.0f};
        pg8::gemm_phase<EpiRes<true>, pg8::StaticOrder, true, true>(lds, g, S, E);
        ProvMixed P{raw3, rawms, rawma}; SEpiRaw SE{rawo, DM};
        skinny_phase<DM, DM>(lds, WO, P, SE);
    }
    xcd_barrier(xb);
    {
        pg8::Gemm g{X2B, W2GU, NPR, 2 * FF, DM}; pg8::StaticOrder S; S.init(NPR, 2 * FF, G, blk);
        EpiAct<true> E{ACT, SQ2};
        pg8::gemm_phase<EpiAct<true>, pg8::StaticOrder, true, true>(lds, g, S, E);
        ProvX<true> P{xs, rawd, rawo}; SEpiRawScaled SE{raw10, 5632};
        skinny_phase<2 * FF, DM>(lds, W2GU, P, SE);
        kvshift_tail(a.in[2], a.in[3], a.in[4], out, 64 * 22, 0, KV_TAIL_P10, wave, lane);
    }
    xcd_barrier(xb);
    {
        pg8::Gemm g{ACT, W2D, NPR, DM, FF}; pg8::StaticOrder S; S.init(NPR, DM, G, blk);
        EpiRes<true> E{X2B, out + O_YP, nullptr, nullptr, 0.5f};
        pg8::gemm_phase<EpiRes<true>, pg8::StaticOrder, true, true, -1>(lds, g, S, E);
        ProvAct P{raw10}; SEpiFinal SE{xs, rawd, rawo, out + O_YS};
        skinny_phase<DM, FF>(lds, W2D, P, SE);
    }
}

extern "C" void kernel_launch(void* const* d_in, const int* in_sizes, int n_in, void* d_out, int out_size, void* d_ws, size_t ws_size, hipStream_t stream) {
    static int grid = 0;
    if (grid == 0) {
        if (n_in != 32 || ws_size < WS_END) { fprintf(stderr, "kernel_launch: unexpected inputs (n_in %d, ws %zu)\n", n_in, ws_size); grid = -1; return; }
        int dev = 0, cus = 0, per_cu = 0;
        hipGetDevice(&dev); hipDeviceGetAttribute(&cus, hipDeviceAttributeMultiprocessorCount, dev);
        hipFuncSetAttribute((const void*)mega_fwd, hipFuncAttributeMaxDynamicSharedMemorySize, LDS_BYTES);
        hipOccupancyMaxActiveBlocksPerMultiprocessor(&per_cu, (const void*)mega_fwd, 512, LDS_BYTES);
        if (per_cu < 1) { fprintf(stderr, "kernel_launch: occupancy query says %d blocks/CU\n", per_cu); per_cu = 1; }
        if (per_cu > 1) per_cu = 1;
        grid = cus * per_cu;
        (void)hipGetLastError();
    }
    if (grid < 0) return;
    if (hipMemsetAsync((char*)d_ws + 512 * 1024, 0, 3 * 4096 * 4, stream) != hipSuccess) { fprintf(stderr, "kernel_launch: memset of barrier words failed\n"); return; }
    Args a{};
    for (int i = 0; i < 32; ++i) a.in[i] = (const float*)d_in[i];
    a.out = (float*)d_out; a.ws = (unsigned char*)d_ws;
    void* args[] = {&a};
    hipError_t e = hipLaunchCooperativeKernel((const void*)mega_fwd, dim3(grid), dim3(512), args, LDS_BYTES, stream);
    if (e != hipSuccess) fprintf(stderr, "cooperative launch failed: %s (grid %d)\n", hipGetErrorString(e), grid);
}
```

```cpp
#include <hip/hip_runtime.h>
#include <hip/hip_cooperative_groups.h>
#include <cstdio>
#include <cstdint>
namespace cg = cooperative_groups;
namespace pg8 {
#define PG8_LAS __attribute__((address_space(3)))
typedef unsigned short bf16_t;
typedef short bf16x8 __attribute__((ext_vector_type(8)));
typedef float f32x4 __attribute__((ext_vector_type(4)));
typedef unsigned u32x4 __attribute__((ext_vector_type(4)));
constexpr int BM = 256, BK = 64, HALF = 128, HTB = HALF * BK * 2  , STAGE_BYTES = 8 * HTB, NXCD = 8, WGM = 8;

__host__ __device__ __forceinline__ int lds_byte(int r, int c) { const int st = (r >> 4) * 2 + (c >> 5), rr = r & 15, cc = c & 31, ob = rr * 64 + cc * 2; return st * 1024 + (ob ^ (((ob >> 9) & 1) << 5)); }
__host__ __device__ __forceinline__ void stage_rc(int b, int& R, int& C) { const int st = b / 1024, sb = b % 1024, swz = sb ^ (((sb >> 9) & 1) << 5); R = (st >> 1) * 16 + swz / 64; C = (st & 1) * 32 + (swz % 64) / 2; }
__host__ __device__ __forceinline__ int perm32(int rho) { const int n = rho >> 4, i = rho & 15; return 8 * (i >> 2) + 4 * n + (i & 3); }

struct Unit { int pm, pn; };
struct Gemm { const bf16_t* A; const bf16_t* Bt; int M, N, K; };

struct StaticOrder {
    int nM, nN, nwg, G, c;
    __host__ __device__ void init(int M, int N, int G_, int c_) { nM = M / BM; nN = N / BM; nwg = nM * nN; G = G_; c = c_; }
    __host__ __device__ bool next(int i, Unit& u) const {
        const long L = (long)i * G + c; if (L >= nwg) return false;
        int wgid = (int)L; { const int q = nwg / NXCD, r = nwg % NXCD, xcd = wgid % NXCD, off = wgid / NXCD; wgid = (xcd < r ? xcd * (q + 1) : r * (q + 1) + (xcd - r) * q) + off; }
        const int nig = WGM * nN, gid = wgid / nig, fm = gid * WGM, gsz = (nM - fm) < WGM ? (nM - fm) : WGM;
        u.pm = fm + ((wgid % nig) % gsz); u.pn = (wgid % nig) / gsz; return true;
    }
    __device__ __forceinline__ void a_ready(const Unit&) const {}
    __device__ __forceinline__ void done(const Unit&) const {}
};
template <class Epi, class Sched, bool ALIGN_EPI = false, bool SP2 = false, int LDA_T = 0>
__device__ __forceinline__ void gemm_phase(PG8_LAS unsigned char* lds, const Gemm g, const Sched& S, const Epi& E) {
    int tid_ = threadIdx.x; asm volatile("" : "+v"(tid_));
    const int tid = tid_, wid = __builtin_amdgcn_readfirstlane(tid >> 6), lane = tid & 63, wr = wid >> 2, wc = wid & 3, fr = lane & 15, fq = lane >> 4;
    constexpr bool ABLK = (LDA_T == -1);
    const int K = g.K, nt = K / BK, LDA = ABLK ? BK : (LDA_T ? LDA_T : g.K);
    unsigned voffA[2], voffB[2];
#pragma unroll
    for (int i = 0; i < 2; ++i) { int R, C; stage_rc(tid * 16 + i * 8192, R, C); const int Rb = Epi::PERM ? ((R & ~31) + perm32(R & 31)) : R;
        voffA[i] = (unsigned)(R * LDA + C) * 2u; voffB[i] = (unsigned)(Rb * K + C) * 2u; }
    const size_t kstepB = (size_t)(BK * 2), kstepA = ABLK ? (size_t)(BM * BK * 2) : kstepB;
    const size_t hstepB = (size_t)HALF * K * 2, hstepA = (size_t)HALF * LDA * 2;
    const size_t tstepB = 2 * hstepB, tstepA = ABLK ? (size_t)nt * kstepA : 2 * hstepA;
    const unsigned ldsw = (unsigned)wid * 1024u;
    const int aoff = lds_byte(wr * 64 + fr, fq * 8), boff = lds_byte(wc * 32 + fr, fq * 8);
#define PG8_SA(b, h) (((b) * 2 + (h)) * HTB)
#define PG8_SB(b, h) ((4 + (b) * 2 + (h)) * HTB)
#define PG8_STAGE(bufoff, gbase, voff) do { _Pragma("unroll") for (int _i = 0; _i < 2; ++_i) \
        __builtin_amdgcn_global_load_lds((const unsigned*)((const char*)(gbase) + (voff)[_i]), (PG8_LAS unsigned*)(lds + (bufoff) + ldsw + _i * 8192), 16, 0, 0); } while (0)
#define PG8_LDA(dst, b, h) do { _Pragma("unroll") for (int m = 0; m < 4; ++m) _Pragma("unroll") for (int k = 0; k < 2; ++k) dst[m][k] = *(const PG8_LAS bf16x8*)(lds + PG8_SA(b, h) + aoff + m * 2048 + k * 1024); } while (0)
#define PG8_LDB(dst, b, h) do { _Pragma("unroll") for (int n = 0; n < 2; ++n) _Pragma("unroll") for (int k = 0; k < 2; ++k) dst[n][k] = *(const PG8_LAS bf16x8*)(lds + PG8_SB(b, h) + boff + n * 2048 + k * 1024); } while (0)
#define PG8_MMA(ai, bj, At, Bt) do { __builtin_amdgcn_s_setprio(1); _Pragma("unroll") for (int m = 0; m < 4; ++m) _Pragma("unroll") for (int n = 0; n < 2; ++n) _Pragma("unroll") for (int k = 0; k < 2; ++k) \
        acc[ai][bj][m][n] = __builtin_amdgcn_mfma_f32_16x16x32_bf16(Bt[n][k], At[m][k], acc[ai][bj][m][n], 0, 0, 0); __builtin_amdgcn_s_setprio(0); } while (0)
#define PG8_WAIT_V(n) asm volatile("s_waitcnt vmcnt(" #n ")" ::: "memory")
#define PG8_WAIT_L(n) asm volatile("s_waitcnt lgkmcnt(" #n ")" ::: "memory")
#define PG8_BAR __builtin_amdgcn_s_barrier()
#define PG8_SCHED __builtin_amdgcn_sched_barrier(0)
    Unit cur, nxt; int ui = 0;
    if (!S.next(0, cur)) return;
    f32x4 acc[2][2][4][2];
#pragma unroll
    for (int a = 0; a < 2; ++a)
#pragma unroll
        for (int b = 0; b < 2; ++b)
#pragma unroll
            for (int m = 0; m < 4; ++m)
#pragma unroll
                for (int n = 0; n < 2; ++n) acc[a][b][m][n] = (f32x4){0.f, 0.f, 0.f, 0.f};
    bf16x8 At[4][2], B0[2][2], B1[2][2];
    const char* cA = (const char*)g.A + (size_t)cur.pm * tstepA; const char* cB = (const char*)g.Bt + (size_t)cur.pn * tstepB;
    S.a_ready(cur);
    if constexpr (SP2) {
        PG8_STAGE(PG8_SB(0, 0), cB, voffB); PG8_STAGE(PG8_SB(0, 1), cB + hstepB, voffB); PG8_STAGE(PG8_SA(0, 0), cA, voffA); PG8_STAGE(PG8_SA(0, 1), cA + hstepA, voffA);
        if (wr == 1) PG8_BAR;
        PG8_WAIT_V(2); PG8_BAR;
        PG8_STAGE(PG8_SB(1, 0), cB + kstepB, voffB); PG8_STAGE(PG8_SA(1, 0), cA + kstepA, voffA); PG8_STAGE(PG8_SB(1, 1), cB + hstepB + kstepB, voffB);
        PG8_WAIT_V(6); PG8_BAR;
    } else {
        PG8_STAGE(PG8_SB(0, 0), cB, voffB); PG8_STAGE(PG8_SA(0, 0), cA, voffA); PG8_STAGE(PG8_SB(0, 1), cB + hstepB, voffB); PG8_STAGE(PG8_SA(0, 1), cA + hstepA, voffA);
        if (wr == 1) PG8_BAR;
        PG8_WAIT_V(4); PG8_BAR;
        PG8_STAGE(PG8_SB(1, 0), cB + kstepB, voffB); PG8_STAGE(PG8_SA(1, 0), cA + kstepA, voffA); PG8_STAGE(PG8_SB(1, 1), cB + hstepB + kstepB, voffB);
        PG8_WAIT_V(6); PG8_BAR;
    }
    for (;;) {
        const bool has_next = S.next(ui + 1, nxt);
        const char* nA = has_next ? (const char*)g.A + (size_t)nxt.pm * tstepA : cA; const char* nB = has_next ? (const char*)g.Bt + (size_t)nxt.pn * tstepB : cB;
        for (int t = 0; t < nt; t += 2) {
            const bool last = (t == nt - 2);
            const char* a1 = cA + (size_t)(t + 1) * kstepA;
            const char* a2 = last ? nA : cA + (size_t)(t + 2) * kstepA; const char* b2 = last ? nB : cB + (size_t)(t + 2) * kstepB;
            const char* a3 = a2 + kstepA; const char* b3 = b2 + kstepB;
            if (last && has_next) S.a_ready(nxt);
            if constexpr (SP2) {
            PG8_LDB(B0, 0, 0); PG8_LDB(B1, 0, 1); PG8_SCHED; PG8_LDA(At, 0, 0); PG8_STAGE(PG8_SA(1, 1), a1 + hstepA, voffA);
            PG8_WAIT_V(8); PG8_WAIT_L(0); PG8_BAR; PG8_MMA(0, 0, At, B0); PG8_MMA(0, 1, At, B1); PG8_BAR; PG8_SCHED;
            PG8_LDA(At, 0, 1); PG8_STAGE(PG8_SB(0, 0), b2, voffB); PG8_STAGE(PG8_SB(0, 1), b2 + hstepB, voffB); PG8_STAGE(PG8_SA(0, 0), a2, voffA);
            PG8_WAIT_V(8); PG8_WAIT_L(0); PG8_BAR; PG8_MMA(1, 0, At, B0); PG8_MMA(1, 1, At, B1); PG8_BAR; PG8_SCHED;
            PG8_LDB(B0, 1, 0); PG8_LDB(B1, 1, 1); PG8_SCHED; PG8_LDA(At, 1, 0); PG8_STAGE(PG8_SA(0, 1), a2 + hstepA, voffA);
            PG8_WAIT_V(8); PG8_WAIT_L(0); PG8_BAR; PG8_MMA(0, 0, At, B0); PG8_MMA(0, 1, At, B1); PG8_BAR; PG8_SCHED;
            PG8_LDA(At, 1, 1); PG8_STAGE(PG8_SB(1, 0), b3, voffB); PG8_STAGE(PG8_SB(1, 1), b3 + hstepB, voffB); PG8_STAGE(PG8_SA(1, 0), a3, voffA);
            PG8_WAIT_V(8); PG8_WAIT_L(0); PG8_BAR; PG8_MMA(1, 0, At, B0); PG8_MMA(1, 1, At, B1); PG8_BAR; PG8_SCHED;
            } else {
            PG8_LDB(B0, 0, 0); PG8_SCHED; PG8_LDA(At, 0, 0); PG8_STAGE(PG8_SA(1, 1), a1 + hstepA, voffA);
            PG8_WAIT_L(8); PG8_BAR; PG8_WAIT_L(0); PG8_MMA(0, 0, At, B0); PG8_BAR; PG8_SCHED;
            PG8_LDB(B1, 0, 1); PG8_STAGE(PG8_SB(0, 0), b2, voffB);
            PG8_BAR; PG8_WAIT_L(0); PG8_MMA(0, 1, At, B1); PG8_BAR;
            PG8_LDA(At, 0, 1); PG8_STAGE(PG8_SA(0, 0), a2, voffA);
            PG8_BAR; PG8_WAIT_L(0); PG8_MMA(1, 0, At, B0); PG8_BAR; PG8_SCHED;
            PG8_STAGE(PG8_SB(0, 1), b2 + hstepB, voffB);
            PG8_WAIT_V(6); PG8_BAR; PG8_MMA(1, 1, At, B1); PG8_BAR;
            PG8_LDB(B0, 1, 0); PG8_SCHED; PG8_LDA(At, 1, 0); PG8_STAGE(PG8_SA(0, 1), a2 + hstepA, voffA);
            PG8_WAIT_L(8); PG8_BAR; PG8_WAIT_L(0); PG8_MMA(0, 0, At, B0); PG8_BAR; PG8_SCHED;
            PG8_LDB(B1, 1, 1); PG8_STAGE(PG8_SB(1, 0), b3, voffB);
            PG8_BAR; PG8_WAIT_L(0); PG8_MMA(0, 1, At, B1); PG8_BAR;
            PG8_LDA(At, 1, 1); PG8_STAGE(PG8_SA(1, 0), a3, voffA);
            PG8_BAR; PG8_WAIT_L(0); PG8_MMA(1, 0, At, B0); PG8_BAR; PG8_SCHED;
            PG8_STAGE(PG8_SB(1, 1), b3 + hstepB, voffB);
            PG8_WAIT_V(6); PG8_BAR; PG8_MMA(1, 1, At, B1); PG8_BAR;
            }
        }
        if constexpr (ALIGN_EPI) { if (wr == 0) PG8_BAR; }
        if constexpr (!Epi::AFTER_DRAIN) { E(acc, cur, wr, wc, fr, fq); S.done(cur); }
        if (!has_next) break;
#pragma unroll
        for (int a = 0; a < 2; ++a)
#pragma unroll
            for (int b = 0; b < 2; ++b)
#pragma unroll
                for (int m = 0; m < 4; ++m)
#pragma unroll
                    for (int n = 0; n < 2; ++n) acc[a][b][m][n] = (f32x4){0.f, 0.f, 0.f, 0.f};
        cur = nxt; cA = nA; cB = nB; ++ui;
        if constexpr (ALIGN_EPI) { if (wr == 1) PG8_BAR; }
    }
    PG8_WAIT_V(0);
    if constexpr (!ALIGN_EPI) { if (wr == 0) PG8_BAR; }
    PG8_BAR;
    if constexpr (Epi::AFTER_DRAIN) { E.fused(acc, cur, wr, wc, fr, fq, lds, wid, lane); S.done(cur); }
#undef PG8_SA
#undef PG8_SB
#undef PG8_STAGE
#undef PG8_LDA
#undef PG8_LDB
#undef PG8_MMA
#undef PG8_WAIT_V
#undef PG8_WAIT_L
#undef PG8_BAR
#undef PG8_SCHED
}
}

#define LAS __attribute__((address_space(3)))
#define DI __device__ __forceinline__
typedef unsigned short bf16_t;
typedef short bf16x8 __attribute__((ext_vector_type(8)));
typedef float f32x4 __attribute__((ext_vector_type(4)));
typedef float f32x2 __attribute__((ext_vector_type(2)));
typedef float f32x16 __attribute__((ext_vector_type(16)));
typedef unsigned u32x4 __attribute__((ext_vector_type(4)));
typedef unsigned u32x2 __attribute__((ext_vector_type(2)));
typedef __bf16 bf16x2n __attribute__((ext_vector_type(2)));

constexpr int DM = 1024, FF = 2816, NPR = 16384, NSM = 32, MT = NPR + NSM, SEQ = 8192, INW = 4864;
constexpr float EPS = 1e-6f;
constexpr float QSCALE = 0.125f * 1.4426950408889634f;
constexpr int NCH = 128, TCH = 64;

constexpr size_t MiB = 1u << 20;
constexpr size_t WS_W1GU = 1 * MiB, WS_W1D = 12 * MiB, WS_WIN = 18 * MiB, WS_WGLU = 28 * MiB, WS_WMIX = 29 * MiB, WS_WO = 32 * MiB, WS_W2GU = 34 * MiB, WS_W2D = 45 * MiB;
constexpr size_t WS_SEND = 51 * MiB, WS_SIN = 55 * MiB, WS_ML = 59 * MiB, WS_SQ1 = 61 * MiB, WS_SQ2 = 63 * MiB, WS_SRAW = 65 * MiB;
constexpr size_t WS_XN = 70 * MiB, WS_X1B = 103 * MiB, WS_X1 = 136 * MiB, WS_ACT = 201 * MiB, WS_G = 290 * MiB, WS_OG = 355 * MiB, WS_YG = 380 * MiB, WS_YY = 397 * MiB, WS_END = 422 * MiB;
constexpr size_t SR_RAW1 = 0, SR_RAWD = SR_RAW1 + 32 * 5632, SR_RAW3 = SR_RAWD + 32 * 1024, SR_RAWGLU = SR_RAW3 + 32 * 4864, SR_RAWMIX = SR_RAWGLU + 32 * 512, SR_RAWO = SR_RAWMIX + 32 * 2048,
                 SR_RAW10 = SR_RAWO + 32 * 1024, SR_END = SR_RAW10 + 32 * 5632;
static_assert(SR_END * 4 <= 5 * MiB, "sample raw region");
constexpr size_t O_YP = 0, O_YS = 16777216, O_KVP0 = 16809984, O_KVP1 = 16941056, O_KVP2 = 17465344, O_SREP = 19562496, O_SIMP = 19566592,
                 O_KVS0 = 19570688, O_KVS1 = 21667840, O_KVS2 = 30056448, O_SRES = 63610880, O_SIMS = 63676416;

constexpr int LDS_BYTES = 147456;

DI int otid() { int t = threadIdx.x; asm volatile("" : "+v"(t)); return t; }
DI unsigned pk2(float a, float b) { f32x2 v = {a, b}; bf16x2n r = __builtin_convertvector(v, bf16x2n); return __builtin_bit_cast(unsigned, r); }
DI bf16_t f2bf(float a) { return (bf16_t)(pk2(a, a) & 0xffffu); }
DI float bflo(unsigned w) { return __uint_as_float(w << 16); }
DI float bfhi(unsigned w) { return __uint_as_float(w & 0xffff0000u); }
DI float bf2f(bf16_t b) { return __uint_as_float(((unsigned)b) << 16); }
DI float sigm(float x) { return __builtin_amdgcn_rcpf(1.f + __expf(-x)); }
DI float silu(float x) { return x * sigm(x); }
DI float gelu_tanh(float x) { const float z = 0.7978845608028654f * (x + 0.044715f * x * x * x); const float t = 1.f - 2.f * __builtin_amdgcn_rcpf(1.f + __expf(2.f * z)); return 0.5f * x * (1.f + t); }
DI u32x4 pack8(f32x4 a, f32x4 b) { u32x4 w; w.x = pk2(a[0], a[1]); w.y = pk2(a[2], a[3]); w.z = pk2(b[0], b[1]); w.w = pk2(b[2], b[3]); return w; }
DI void unpack8(u32x4 w, f32x4& a, f32x4& b) { a = (f32x4){bflo(w.x), bfhi(w.x), bflo(w.y), bfhi(w.y)}; b = (f32x4){bflo(w.z), bfhi(w.z), bflo(w.w), bfhi(w.w)}; }
DI float wave_sum(float v) {
#pragma unroll
    for (int o = 1; o < 64; o <<= 1) v += __shfl_xor(v, o);
    return v;
}
DI float wave_max(float v) {
#pragma unroll
    for (int o = 1; o < 64; o <<= 1) v = fmaxf(v, __shfl_xor(v, o));
    return v;
}
DI float rstd16(const float* sq, int row) { return rsqrtf(sq[row] * (1.f / 1024.f) + EPS); }
DI int l2p(int c) { return (c & ~255) | (((c >> 5) & 1) << 7) | (((c >> 6) & 3) << 5) | (c & 31); }
#define LDS_WAIT() asm volatile("s_waitcnt lgkmcnt(0)" ::: "memory")
#define SCHED_FENCE() __builtin_amdgcn_sched_barrier(0)


typedef __attribute__((address_space(1))) unsigned gu32;
#define XB_TMO      128
#define XB_XCNT(j)  (256  + 64 * (j))
#define XB_XSUB(j)  (1280 + 64 * (j))
#define XB_XGEN(j)  (2304 + 64 * (j))
#define XB_TOP      3328
#define XB_TOPGEN   3392
#define XCD_BAR_WORDS 3456
#define XB_SPIN_CAP (1u << 18)

__device__ __forceinline__ unsigned xb_ld(unsigned* p)              { return __hip_atomic_load(p, __ATOMIC_RELAXED, __HIP_MEMORY_SCOPE_AGENT); }
__device__ __forceinline__ unsigned xb_add(unsigned* p, unsigned v) { return __hip_atomic_fetch_add(p, v, __ATOMIC_RELAXED, __HIP_MEMORY_SCOPE_AGENT); }
__device__ __forceinline__ unsigned xb_xcc_id() { return (unsigned)__builtin_amdgcn_s_getreg((3 << 11) | 20) & 0xFu; }
#define XB_SPIN(cond, bar) do { unsigned _sp = 0; while (cond) { __builtin_amdgcn_s_sleep(1); \
    if ((++_sp & 255u) == 0u) { if (xb_ld(&(bar)[XB_TMO])) break; if (_sp > XB_SPIN_CAP) { atomicAdd(&(bar)[XB_TMO], 1u); break; } } } } while (0)

struct XcdBarrier {
    unsigned* bar; unsigned x; unsigned G;
    volatile LAS unsigned* st;
};

__device__ __forceinline__ XcdBarrier xcd_barrier_post(unsigned* bar, volatile LAS unsigned* st, unsigned G) {
    XcdBarrier b; b.bar = bar; b.x = xb_xcc_id(); b.st = st; b.G = G;
    if (threadIdx.x == 0) (void)xb_add(&bar[XB_XCNT(b.x)], 1u);
    return b;
}
__device__ __forceinline__ void xcd_barrier_complete(unsigned* bar, unsigned x, unsigned G, unsigned& nloc, unsigned& nx) {
    unsigned sum, cnt, mine, sp = 0u;
    for (;;) {
        sum = 0u; cnt = 0u; mine = 0u;
#pragma unroll
        for (unsigned j = 0; j < 16; ++j) { const unsigned c = xb_ld(&bar[XB_XCNT(j)]); sum += c; cnt += (c > 0u) ? 1u : 0u; mine = (j == x) ? c : mine; }
        if (sum == G) break;
        __builtin_amdgcn_s_sleep(1);
        if ((++sp & 255u) == 0u) { if (xb_ld(&bar[XB_TMO])) break; if (sp > XB_SPIN_CAP) { atomicAdd(&bar[XB_TMO], 1u); break; } }
    }
    nloc = mine > 0u ? mine : 1u; nx = cnt > 0u ? cnt : 1u;
}

__device__ __forceinline__ void xcd_barrier(const XcdBarrier& b) {
    asm volatile("s_waitcnt vmcnt(0)" ::: "memory");
    __syncthreads();
    if (threadIdx.x == 0) {
        unsigned* bar = b.bar; unsigned bx = b.x; asm volatile("" : "+s"(bx));
        __builtin_amdgcn_s_waitcnt(0);
        unsigned nloc = b.st[0], nx = b.st[1];
        if (nloc == 0u) { xcd_barrier_complete(bar, bx, b.G, nloc, nx); b.st[0] = nloc; b.st[1] = nx; }
        const unsigned old = xb_add(&bar[XB_XSUB(bx)], 1u);
        const unsigned gen = old / nloc;
        if (old + 1u == (gen + 1u) * nloc) {
            __builtin_amdgcn_fence(__ATOMIC_RELEASE, "agent");
            asm volatile("s_waitcnt vmcnt(0)" ::: "memory");
            const unsigned og = xb_add(&bar[XB_TOP], 1u);
            const unsigned tg = og / nx;
            if (og + 1u == (tg + 1u) * nx) xb_add(&bar[XB_TOPGEN], 1u);
            else XB_SPIN(xb_ld(&bar[XB_TOPGEN]) == tg, bar);
            __builtin_amdgcn_fence(__ATOMIC_ACQUIRE, "agent");
            xb_add(&bar[XB_XGEN(bx)], 1u);
            asm volatile("s_waitcnt vmcnt(0)" ::: "memory");
        } else {
            XB_SPIN(xb_ld(&bar[XB_XGEN(bx)]) == gen, bar);
            __builtin_amdgcn_fence(__ATOMIC_ACQUIRE, "agent");
            asm volatile("s_waitcnt vmcnt(0)" ::: "memory");
        }
    }
    __syncthreads();
}

using pg8::Unit;
template <bool RS> struct EpiAct {
    static constexpr bool PERM = true, AFTER_DRAIN = false;
    bf16_t* O; const float* sq;
    DI void operator()(const f32x4 (&acc)[2][2][4][2], const Unit& u, int wr, int wc, int fr, int fq) const {
        const int row0 = u.pm * 256 + wr * 64 + fr, col = u.pn * 128 + wc * 32 + 8 * fq;
        float rs[2][4];
#pragma unroll
        for (int ai = 0; ai < 2; ++ai)
#pragma unroll
            for (int m = 0; m < 4; ++m) rs[ai][m] = RS ? sq[row0 + ai * 128 + m * 16] : 1.f;
        SCHED_FENCE();
#pragma unroll
        for (int ai = 0; ai < 2; ++ai)
#pragma unroll
            for (int m = 0; m < 4; ++m) {
                const int row = row0 + ai * 128 + m * 16; float r1 = 1.f; if (RS) r1 = rsqrtf(rs[ai][m] * (1.f / 1024.f) + EPS);
                f32x4 o[2];
#pragma unroll
                for (int n = 0; n < 2; ++n)
#pragma unroll
                    for (int e = 0; e < 4; ++e) o[n][e] = silu(acc[ai][0][m][n][e] * r1) * (acc[ai][1][m][n][e] * r1);
                *(u32x4*)(O + (((size_t)(row >> 8) * (FF / 64) + (col >> 6)) * 256 + (row & 255)) * 64 + (col & 63)) = pack8(o[0], o[1]);
            }
    }
};
template <bool BF> struct EpiRes {
    static constexpr bool PERM = true, AFTER_DRAIN = false;
    const void* base; float* out; bf16_t* ob; float* sq; float scale;
    DI void operator()(const f32x4 (&acc)[2][2][4][2], const Unit& u, int wr, int wc, int fr, int fq) const {
        const int row0 = u.pm * 256 + wr * 64 + fr;
        constexpr int MB = BF ? 4 : 2;
#pragma unroll
        for (int ai = 0; ai < 2; ++ai)
#pragma unroll
        for (int m0 = 0; m0 < 4; m0 += MB) {
            f32x4 b0[MB][2], b1[MB][2]; u32x4 bw[MB][2];
            SCHED_FENCE();
#pragma unroll
            for (int mm = 0; mm < MB; ++mm)
#pragma unroll
                for (int bj = 0; bj < 2; ++bj) { const size_t off = (size_t)(row0 + ai * 128 + (m0 + mm) * 16) * DM + u.pn * 256 + bj * 128 + wc * 32 + 8 * fq;
                    if (BF) bw[mm][bj] = *(const u32x4*)((const bf16_t*)base + off);
                    else { b0[mm][bj] = *(const f32x4*)((const float*)base + off); b1[mm][bj] = *(const f32x4*)((const float*)base + off + 4); } }
            SCHED_FENCE();
#pragma unroll
            for (int mm = 0; mm < MB; ++mm) {
                const int m = m0 + mm; const int row = row0 + ai * 128 + m * 16; float ss = 0.f;
#pragma unroll
                for (int bj = 0; bj < 2; ++bj) {
                    const size_t off = (size_t)row * DM + u.pn * 256 + bj * 128 + wc * 32 + 8 * fq;
                    f32x4 c0, c1; if (BF) unpack8(bw[mm][bj], c0, c1); else { c0 = b0[mm][bj]; c1 = b1[mm][bj]; }
                    const f32x4 v0 = c0 + acc[ai][bj][m][0] * scale, v1 = c1 + acc[ai][bj][m][1] * scale;
                    if (out) { *(f32x4*)(out + off) = v0; *(f32x4*)(out + off + 4) = v1; }
                    if (ob) *(u32x4*)(ob + off) = pack8(v0, v1);
                    ss += (v0[0] * v0[0] + v0[1] * v0[1]) + (v0[2] * v0[2] + v0[3] * v0[3]) + (v1[0] * v1[0] + v1[1] * v1[1]) + (v1[2] * v1[2] + v1[3] * v1[3]);
                }
                if (sq) { ss += __shfl_xor(ss, 16); ss += __shfl_xor(ss, 32); if (fq == 0) atomicAdd(sq + row, ss); }
            }
        }
    }
};
struct EpiWin {
    static constexpr bool PERM = true, AFTER_DRAIN = false;
    const float* sq; bf16_t* UQKV; bf16_t* G; const float* gqk; float* out;
    DI void operator()(const f32x4 (&acc)[2][2][4][2], const Unit& u, int wr, int wc, int fr, int fq) const {
        const int row0 = u.pm * 256 + wr * 64 + fr, pn = u.pn;
        const int kind = (pn - 2) / 3, g = (pn - 2) % 3;
        float rsq[2][4]; f32x4 gn[2][2];
#pragma unroll
        for (int ai = 0; ai < 2; ++ai)
#pragma unroll
            for (int m = 0; m < 4; ++m) rsq[ai][m] = sq[row0 + ai * 128 + m * 16];
        if (pn >= 2 && pn < 8) { const float* gp = gqk + kind * 192 + g * 64 + 8 * fq;
#pragma unroll
            for (int bj = 0; bj < 2; ++bj) { gn[bj][0] = *(const f32x4*)(gp + bj * 32); gn[bj][1] = *(const f32x4*)(gp + bj * 32 + 4); } }
        else { const f32x4 one = {1.f, 1.f, 1.f, 1.f}; gn[0][0] = one; gn[0][1] = one; gn[1][0] = one; gn[1][1] = one; }
        SCHED_FENCE();
#pragma unroll
        for (int ai = 0; ai < 2; ++ai)
#pragma unroll
            for (int m = 0; m < 4; ++m) {
                const int row = row0 + ai * 128 + m * 16; const float rs = rsqrtf(rsq[ai][m] * (1.f / 1024.f) + EPS);
                f32x4 v[2][2];
#pragma unroll
                for (int bj = 0; bj < 2; ++bj)
#pragma unroll
                    for (int n = 0; n < 2; ++n) v[bj][n] = acc[ai][bj][m][n] * rs;
                if (pn < 2) {
#pragma unroll
                    for (int bj = 0; bj < 2; ++bj) *(u32x4*)(UQKV + (size_t)row * 512 + pn * 256 + wc * 64 + bj * 32 + 8 * fq) = pack8(v[bj][0], v[bj][1]);
                } else if (pn < 11) {
                    float rn = 1.f;
                    if (kind < 2) {
                        float ss = 0.f;
#pragma unroll
                        for (int bj = 0; bj < 2; ++bj)
#pragma unroll
                            for (int n = 0; n < 2; ++n) ss += (v[bj][n][0] * v[bj][n][0] + v[bj][n][1] * v[bj][n][1]) + (v[bj][n][2] * v[bj][n][2] + v[bj][n][3] * v[bj][n][3]);
                        ss += __shfl_xor(ss, 16); ss += __shfl_xor(ss, 32);
                        rn = rsqrtf(ss * (1.f / 64.f) + EPS) * (kind == 0 ? QSCALE : 1.f);
                    }
                    const int t = row & (SEQ - 1), b = row >> 13; const int w = g == 0 ? 128 : (g == 1 ? 512 : 2048);
                    const size_t kvo = g == 0 ? O_KVP0 : (g == 1 ? O_KVP1 : O_KVP2);
                    bf16_t* dstb = UQKV + (size_t)MT * 512 + (size_t)kind * ((size_t)MT * 768) + (size_t)row * 768 + g * 256 + wc * 64 + 8 * fq;
#pragma unroll
                    for (int bj = 0; bj < 2; ++bj) {
                        const f32x4 a0 = v[bj][0] * rn * gn[bj][0], a1 = v[bj][1] * rn * gn[bj][1];
                        *(u32x4*)(dstb + bj * 32) = pack8(a0, a1);
                        if (kind >= 1 && t >= SEQ - w) { float* o = out + kvo + ((size_t)(b * w + (t - (SEQ - w))) * 2 + (kind - 1)) * 256 + wc * 64 + bj * 32 + 8 * fq; *(f32x4*)o = a0; *(f32x4*)(o + 4) = a1; }
                    }
                } else {
#pragma unroll
                    for (int bj = 0; bj < 2; ++bj) {
                        f32x4 a0, a1;
#pragma unroll
                        for (int e = 0; e < 4; ++e) { a0[e] = sigm(v[bj][0][e]); a1[e] = sigm(v[bj][1][e]); }
                        *(u32x4*)(G + (size_t)row * 2048 + (pn - 11) * 256 + wc * 64 + bj * 32 + 8 * fq) = pack8(a0, a1);
                    }
                }
            }
    }
};
struct EpiGlu {
    static constexpr bool PERM = true, AFTER_DRAIN = false;
    const bf16_t* YG; const float* bias; bf16_t* YY;
    DI void operator()(const f32x4 (&acc)[2][2][4][2], const Unit& u, int wr, int wc, int fr, int fq) const {
        const int row0 = u.pm * 256 + wr * 64 + fr;
        f32x4 bb[2][2];
#pragma unroll
        for (int bj = 0; bj < 2; ++bj) { const int col = u.pn * 256 + bj * 128 + wc * 32 + 8 * fq; bb[bj][0] = *(const f32x4*)(bias + col); bb[bj][1] = *(const f32x4*)(bias + col + 4); }
#pragma unroll
        for (int ai = 0; ai < 2; ++ai) {
            u32x4 yw[2][4][2];
            SCHED_FENCE();
#pragma unroll
            for (int bj = 0; bj < 2; ++bj)
#pragma unroll
                for (int m = 0; m < 4; ++m) yw[ai][m][bj] = *(const u32x4*)(YG + (size_t)(row0 + ai * 128 + m * 16) * 512 + u.pn * 256 + bj * 128 + wc * 32 + 8 * fq);
            SCHED_FENCE();
#pragma unroll
            for (int m = 0; m < 4; ++m) {
                const int row = row0 + ai * 128 + m * 16;
#pragma unroll
                for (int bj = 0; bj < 2; ++bj) {
                    const int col = u.pn * 256 + bj * 128 + wc * 32 + 8 * fq;
                    f32x4 y0, y1; unpack8(yw[ai][m][bj], y0, y1);
                    f32x4 o0, o1;
#pragma unroll
                    for (int e = 0; e < 4; ++e) { o0[e] = y0[e] * sigm(acc[ai][bj][m][0][e] + bb[bj][0][e]); o1[e] = y1[e] * sigm(acc[ai][bj][m][1][e] + bb[bj][1][e]); }
                    *(u32x4*)(YY + (size_t)row * 768 + col) = pack8(o0, o1);
                }
            }
        }
    }
};
struct EpiGateScale {
    static constexpr bool PERM = true, AFTER_DRAIN = false;
    const bf16_t* G; bf16_t* T;
    DI void operator()(const f32x4 (&acc)[2][2][4][2], const Unit& u, int wr, int wc, int fr, int fq) const {
        const int row0 = u.pm * 256 + wr * 64 + fr;
#pragma unroll
        for (int ai = 0; ai < 2; ++ai) {
            u32x4 gw[2][4][2];
            SCHED_FENCE();
#pragma unroll
            for (int m = 0; m < 4; ++m)
#pragma unroll
                for (int bj = 0; bj < 2; ++bj) gw[ai][m][bj] = *(const u32x4*)(G + (size_t)(row0 + ai * 128 + m * 16) * 2048 + 1024 + u.pn * 256 + bj * 128 + wc * 32 + 8 * fq);
            SCHED_FENCE();
#pragma unroll
            for (int m = 0; m < 4; ++m) {
                const int row = row0 + ai * 128 + m * 16;
#pragma unroll
                for (int bj = 0; bj < 2; ++bj) { const int col = u.pn * 256 + bj * 128 + wc * 32 + 8 * fq;
                    f32x4 a0, a1; unpack8(gw[ai][m][bj], a0, a1);
                    *(u32x4*)(T + (size_t)row * DM + col) = pack8(a0 * acc[ai][bj][m][0], a1 * acc[ai][bj][m][1]); }
            }
        }
    }
};
struct EpiMix2 {
    static constexpr bool PERM = true, AFTER_DRAIN = false;
    const bf16_t* G; const bf16_t* T; bf16_t* O;
    DI void operator()(const f32x4 (&acc)[2][2][4][2], const Unit& u, int wr, int wc, int fr, int fq) const {
        const int row0 = u.pm * 256 + wr * 64 + fr;
#pragma unroll
        for (int ai = 0; ai < 2; ++ai)
#pragma unroll
        for (int mh = 0; mh < 4; mh += 2) {
            u32x4 gw[4][2], tw[4][2];
            SCHED_FENCE();
#pragma unroll
            for (int m = mh; m < mh + 2; ++m)
#pragma unroll
                for (int bj = 0; bj < 2; ++bj) { const int row = row0 + ai * 128 + m * 16, col = u.pn * 256 + bj * 128 + wc * 32 + 8 * fq;
                    gw[m][bj] = *(const u32x4*)(G + (size_t)row * 2048 + col); tw[m][bj] = *(const u32x4*)(T + (size_t)row * DM + col); }
            SCHED_FENCE();
#pragma unroll
            for (int m = mh; m < mh + 2; ++m) {
                const int row = row0 + ai * 128 + m * 16;
#pragma unroll
                for (int bj = 0; bj < 2; ++bj) { const int col = u.pn * 256 + bj * 128 + wc * 32 + 8 * fq;
                    f32x4 s0, s1, t0, t1; unpack8(gw[m][bj], s0, s1); unpack8(tw[m][bj], t0, t1);
                    *(u32x4*)(O + (size_t)row * DM + col) = pack8(s0 * acc[ai][bj][m][0] + t0, s1 * acc[ai][bj][m][1] + t1); }
            }
        }
    }
};

#define MFMA32(a, b, c) __builtin_amdgcn_mfma_f32_32x32x16_bf16((a), (b), (c), 0, 0, 0)
#define MFMA16(a, b, c) __builtin_amdgcn_mfma_f32_16x16x32_bf16((a), (b), (c), 0, 0, 0)
DI bf16x8 frag_from_f32(f32x4 a, f32x4 b) { return __builtin_bit_cast(bf16x8, pack8(a, b)); }

struct ProvBf16 { const bf16_t* A; int ld; static constexpr bool SQ = false; static constexpr int BATCH = 11;
    struct Raw { bf16x8 v; };
    DI Raw load(int r, int k) const { Raw w; w.v = *(const bf16x8*)(A + (size_t)r * ld + k); return w; }
    DI bf16x8 cvt(const Raw& w, float&) const { return w.v; } };
struct ProvAct { const float* raw; static constexpr bool SQ = false; static constexpr int BATCH = 4;
    struct Raw { f32x4 g0, g1, u0, u1; };
    DI Raw load(int r, int k) const { const float* p = raw + (size_t)r * 5632 + 256 * (k >> 7) + (k & 127); Raw w; w.g0 = *(const f32x4*)p; w.g1 = *(const f32x4*)(p + 4); w.u0 = *(const f32x4*)(p + 128); w.u1 = *(const f32x4*)(p + 132); return w; }
    DI bf16x8 cvt(const Raw& w, float&) const { f32x4 a, b;
#pragma unroll
        for (int e = 0; e < 4; ++e) { a[e] = silu(w.g0[e]) * w.u0[e]; b[e] = silu(w.g1[e]) * w.u1[e]; }
        return frag_from_f32(a, b); } };
template <bool HASO> struct ProvX { const float* xs; const float* rawd; const float* rawo; static constexpr bool SQ = true; static constexpr int BATCH = 2;
    struct Raw { f32x4 x0, x1, d0, d1, o0, o1; };
    DI Raw load(int r, int k) const { const size_t o = (size_t)r * DM + k; Raw w; w.x0 = *(const f32x4*)(xs + o); w.x1 = *(const f32x4*)(xs + o + 4); w.d0 = *(const f32x4*)(rawd + o); w.d1 = *(const f32x4*)(rawd + o + 4);
        if (HASO) { w.o0 = *(const f32x4*)(rawo + o); w.o1 = *(const f32x4*)(rawo + o + 4); } return w; }
    DI bf16x8 cvt(const Raw& w, float& ss) const { f32x4 a = w.x0 + w.d0 * 0.5f, b = w.x1 + w.d1 * 0.5f; if (HASO) { a += w.o0; b += w.o1; }
        ss += (a[0] * a[0] + a[1] * a[1]) + (a[2] * a[2] + a[3] * a[3]) + (b[0] * b[0] + b[1] * b[1]) + (b[2] * b[2] + b[3] * b[3]);
        return frag_from_f32(a, b); } };
struct ProvYY { const bf16_t* YG; const float* rawglu; const float* bias; const bf16_t* YY; static constexpr bool SQ = false; static constexpr int BATCH = 3;
    struct Raw { u32x4 y; f32x4 z0, z1, b0, b1; };
    DI Raw load(int r, int k) const { Raw w; const f32x4 z = {0.f, 0.f, 0.f, 0.f}; w.z0 = z; w.z1 = z; w.b0 = z; w.b1 = z;
        if (k >= 512) { w.y = *(const u32x4*)(YY + (size_t)(NPR + r) * 768 + k); }
        else { w.y = *(const u32x4*)(YG + (size_t)(NPR + r) * 512 + k); w.z0 = *(const f32x4*)(rawglu + r * 512 + k); w.z1 = *(const f32x4*)(rawglu + r * 512 + k + 4); w.b0 = *(const f32x4*)(bias + k); w.b1 = *(const f32x4*)(bias + k + 4); }
        return w; }
    DI bf16x8 cvt(const Raw& w, float&, int k) const { return __builtin_bit_cast(bf16x8, w.y); }
    DI bf16x8 cvt(const Raw& w, float&) const { return __builtin_bit_cast(bf16x8, w.y); }
    DI bf16x8 cvtk(const Raw& w, int k) const {
        if (k >= 512) return __builtin_bit_cast(bf16x8, w.y);
        f32x4 y0, y1; unpack8(w.y, y0, y1); f32x4 a, b;
#pragma unroll
        for (int e = 0; e < 4; ++e) { a[e] = y0[e] * sigm(w.z0[e] + w.b0[e]); b[e] = y1[e] * sigm(w.z1[e] + w.b1[e]); }
        return frag_from_f32(a, b); } };
struct ProvMixed { const float* raw3; const float* rawms; const float* rawma; static constexpr bool SQ = false; static constexpr int BATCH = 2;
    struct Raw { f32x4 s0, s1, a0, a1, m0, m1, n0, n1; };
    DI Raw load(int r, int k) const { const float* gs = raw3 + (size_t)r * INW + l2p(2816 + k); const float* ga = raw3 + (size_t)r * INW + l2p(3840 + k);
        Raw w; w.s0 = *(const f32x4*)gs; w.s1 = *(const f32x4*)(gs + 4); w.a0 = *(const f32x4*)ga; w.a1 = *(const f32x4*)(ga + 4);
        w.m0 = *(const f32x4*)(rawms + r * DM + k); w.m1 = *(const f32x4*)(rawms + r * DM + k + 4); w.n0 = *(const f32x4*)(rawma + r * DM + k); w.n1 = *(const f32x4*)(rawma + r * DM + k + 4); return w; }
    DI bf16x8 cvt(const Raw& w, float&) const { f32x4 a, b;
#pragma unroll
        for (int e = 0; e < 4; ++e) { a[e] = sigm(w.s0[e]) * w.m0[e] + sigm(w.a0[e]) * w.n0[e]; b[e] = sigm(w.s1[e]) * w.m1[e] + sigm(w.a1[e]) * w.n1[e]; }
        return frag_from_f32(a, b); } };
template <class P> struct ProvTraits { static constexpr bool NEEDK = false; };
template <> struct ProvTraits<ProvYY> { static constexpr bool NEEDK = true; };
struct SEpiRaw { float* dst; int ld; DI void operator()(int row, int col, float v, float) const { dst[(size_t)row * ld + col] = v; } };
struct SEpiRawScaled { float* dst; int ld; DI void operator()(int row, int col, float v, float rs) const { dst[(size_t)row * ld + col] = v * rs; } };
struct SEpiFinal { const float* xs; const float* rawd; const float* rawo; float* out; DI void operator()(int row, int col, float v, float) const { const size_t o = (size_t)row * DM + col; out[o] = xs[o] + 0.5f * rawd[o] + rawo[o] + 0.5f * v; } };

template <int N, int K, class Prov, class SEpi>
DI void skinny_phase(LAS unsigned char* lds, const bf16_t* Bt, const Prov& P, const SEpi& E) {
    const int tid = otid(), wave = tid >> 6, lane = tid & 63, r = lane & 31, hh = lane >> 5, G = gridDim.x;
    LAS float* red = (LAS float*)lds;
    LAS float* sqp = (LAS float*)(lds + 32768);
    LAS float* rsd = (LAS float*)(lds + 32768 + 2048);
    constexpr int ntiles = N / 32, kper = K / 8, NIT = kper / 32, BATCH = Prov::BATCH;
    for (int tile = G - 1 - (int)blockIdx.x; tile < ntiles; tile += G) {
        const int n0 = tile * 32;
        f32x16 acc = {};
        float ss = 0.f;
        const bf16_t* bp = Bt + (size_t)(n0 + r) * K + wave * kper + 16 * hh;
        const int kbase = wave * kper + 16 * hh;
#pragma unroll
        for (int i0 = 0; i0 < NIT; i0 += BATCH) {
            typename Prov::Raw ra[BATCH][2]; bf16x8 rb[BATCH][2];
            SCHED_FENCE();
#pragma unroll
            for (int u = 0; u < BATCH; ++u) if (i0 + u < NIT) { const int k = kbase + 32 * (i0 + u);
                ra[u][0] = P.load(r, k); ra[u][1] = P.load(r, k + 8); rb[u][0] = *(const bf16x8*)(bp + 32 * (i0 + u)); rb[u][1] = *(const bf16x8*)(bp + 32 * (i0 + u) + 8); }
            SCHED_FENCE();
#pragma unroll
            for (int u = 0; u < BATCH; ++u) if (i0 + u < NIT) { const int k = kbase + 32 * (i0 + u);
                bf16x8 a0, a1;
                if constexpr (ProvTraits<Prov>::NEEDK) { a0 = P.cvtk(ra[u][0], k); a1 = P.cvtk(ra[u][1], k + 8); } else { a0 = P.cvt(ra[u][0], ss); a1 = P.cvt(ra[u][1], ss); }
                acc = MFMA32(a0, rb[u][0], acc); acc = MFMA32(a1, rb[u][1], acc); }
        }
#pragma unroll
        for (int i = 0; i < 16; ++i) red[wave * 1024 + ((i & 3) + 8 * (i >> 2) + 4 * hh) * 32 + r] = acc[i];
        if (Prov::SQ) sqp[(wave * 2 + hh) * 32 + r] = ss;
        __syncthreads();
        if (Prov::SQ) { if (tid < 32) { float sm = 0.f; for (int j = 0; j < 16; ++j) sm += sqp[j * 32 + tid]; rsd[tid] = rsqrtf(sm * (1.f / 1024.f) + EPS); } __syncthreads(); }
#pragma unroll
        for (int h2 = 0; h2 < 2; ++h2) { const int e = tid + 512 * h2; float sm = 0.f;
#pragma unroll
            for (int w = 0; w < 8; ++w) sm += red[w * 1024 + e];
            E(e >> 5, n0 + (e & 31), sm, Prov::SQ ? rsd[e >> 5] : 1.f); }
        __syncthreads();
    }
}

template <int K, class Prov>
DI void skinny_gu_phase(LAS unsigned char* lds, const bf16_t* Bt, const Prov& P, bf16_t* act) {
    const int tid = otid(), wave = tid >> 6, lane = tid & 63, r = lane & 31, hh = lane >> 5, G = gridDim.x;
    LAS float* red = (LAS float*)lds;
    LAS float* sqp = (LAS float*)(lds + 32768);
    LAS float* rsd = (LAS float*)(lds + 32768 + 2048);
    constexpr int ntiles = FF / 16, kper = K / 8, NIT = kper / 32, BATCH = Prov::BATCH;
    for (int tile = G - 1 - (int)blockIdx.x; tile < ntiles; tile += G) {
        f32x16 acc = {};
        float ss = 0.f;
        const int brow = 256 * (tile >> 3) + 16 * (tile & 7) + (r < 16 ? r : 112 + r);
        const bf16_t* bp = Bt + (size_t)brow * K + wave * kper + 16 * hh;
        const int kbase = wave * kper + 16 * hh;
#pragma unroll
        for (int i0 = 0; i0 < NIT; i0 += BATCH) {
            typename Prov::Raw ra[BATCH][2]; bf16x8 rb[BATCH][2];
            SCHED_FENCE();
#pragma unroll
            for (int u = 0; u < BATCH; ++u) if (i0 + u < NIT) { const int k = kbase + 32 * (i0 + u);
                ra[u][0] = P.load(r, k); ra[u][1] = P.load(r, k + 8); rb[u][0] = *(const bf16x8*)(bp + 32 * (i0 + u)); rb[u][1] = *(const bf16x8*)(bp + 32 * (i0 + u) + 8); }
            SCHED_FENCE();
#pragma unroll
            for (int u = 0; u < BATCH; ++u) if (i0 + u < NIT) {
                const bf16x8 a0 = P.cvt(ra[u][0], ss), a1 = P.cvt(ra[u][1], ss);
                acc = MFMA32(a0, rb[u][0], acc); acc = MFMA32(a1, rb[u][1], acc); }
        }
#pragma unroll
        for (int i = 0; i < 16; ++i) red[wave * 1024 + ((i & 3) + 8 * (i >> 2) + 4 * hh) * 32 + r] = acc[i];
        if (Prov::SQ) sqp[(wave * 2 + hh) * 32 + r] = ss;
        __syncthreads();
        if (Prov::SQ) { if (tid < 32) { float sm = 0.f; for (int j = 0; j < 16; ++j) sm += sqp[j * 32 + tid]; rsd[tid] = rsqrtf(sm * (1.f / 1024.f) + EPS); } __syncthreads(); }
        { const int row = tid >> 4, c = tid & 15; float sg = 0.f, su = 0.f;
#pragma unroll
          for (int w = 0; w < 8; ++w) { sg += red[w * 1024 + row * 32 + c]; su += red[w * 1024 + row * 32 + 16 + c]; }
          const float rs = Prov::SQ ? rsd[row] : 1.f;
          act[(size_t)row * FF + 16 * tile + c] = f2bf(silu(sg * rs) * (su * rs)); }
        __syncthreads();
    }
}

DI int maprow(int mode, int c0) {
    if (mode == 0) return c0;
    if (mode == 1) return 256 * (c0 >> 7) + (c0 & 127);
    if (mode == 2) return 256 * (c0 >> 7) + 128 + (c0 & 127);
    return (c0 & ~255) | (((c0 >> 5) & 1) << 7) | (((c0 >> 6) & 3) << 5);
}
DI void tr_item(const float* W, int N, const float* g, bf16_t* dst, int ldd, int kofs, int mode, int item, LAS float* scr, int lane) {
    const int nblk = N / 32, kb = item / nblk, nb = item % nblk, k0 = 64 * kb, c0 = 32 * nb, p0 = maprow(mode, c0);
    const int kr = lane >> 3, c4 = lane & 7;
    f32x4 v[8];
#pragma unroll
    for (int i = 0; i < 8; ++i) v[i] = *(const f32x4*)(W + (size_t)(k0 + 8 * i + kr) * N + c0 + 4 * c4);
    if (g) {
#pragma unroll
        for (int i = 0; i < 8; ++i) v[i] = v[i] * g[k0 + 8 * i + kr];
    }
#pragma unroll
    for (int i = 0; i < 8; ++i) { LAS float* sp = scr + (8 * i + kr) * 33 + 4 * c4; sp[0] = v[i][0]; sp[1] = v[i][1]; sp[2] = v[i][2]; sp[3] = v[i][3]; }
    LDS_WAIT();
    const int c = lane & 7;
#pragma unroll
    for (int j = 0; j < 4; ++j) { const int n = (lane >> 3) + 8 * j; const LAS float* sq = scr + (8 * c) * 33 + n;
        u32x4 o; o.x = pk2(sq[0 * 33], sq[1 * 33]); o.y = pk2(sq[2 * 33], sq[3 * 33]); o.z = pk2(sq[4 * 33], sq[5 * 33]); o.w = pk2(sq[6 * 33], sq[7 * 33]);
        *(u32x4*)(dst + (size_t)(p0 + n) * ldd + kofs + k0 + 8 * c) = o; }
    LDS_WAIT();
}
DI void norm_rows2_bf16(const float* x0, const float* x1, const float* g, bf16_t* o0, bf16_t* o1, int lane) {
    const f32x4* xr0 = (const f32x4*)x0 + lane; const f32x4* xr1 = (const f32x4*)x1 + lane; const f32x4* gr = (const f32x4*)g + lane;
    f32x4 v[2][4]; float s0 = 0.f, s1 = 0.f;
#pragma unroll
    for (int j = 0; j < 4; ++j) { v[0][j] = xr0[64 * j]; v[1][j] = xr1[64 * j]; }
    SCHED_FENCE();
#pragma unroll
    for (int j = 0; j < 4; ++j) { s0 += (v[0][j][0] * v[0][j][0] + v[0][j][1] * v[0][j][1]) + (v[0][j][2] * v[0][j][2] + v[0][j][3] * v[0][j][3]); s1 += (v[1][j][0] * v[1][j][0] + v[1][j][1] * v[1][j][1]) + (v[1][j][2] * v[1][j][2] + v[1][j][3] * v[1][j][3]); }
    const float r0 = rsqrtf(wave_sum(s0) * (1.f / 1024.f) + EPS), r1 = rsqrtf(wave_sum(s1) * (1.f / 1024.f) + EPS);
    u32x2* p0 = (u32x2*)o0 + lane; u32x2* p1 = (u32x2*)o1 + lane;
#pragma unroll
    for (int j = 0; j < 4; ++j) { const f32x4 gg = gr[64 * j]; const f32x4 w0 = v[0][j] * r0 * gg, w1 = v[1][j] * r1 * gg; u32x2 a, b; a.x = pk2(w0[0], w0[1]); a.y = pk2(w0[2], w0[3]); b.x = pk2(w1[0], w1[1]); b.y = pk2(w1[2], w1[3]); p0[64 * j] = a; p1[64 * j] = b; }
}

constexpr int KVR0 = 32 * 127, KVR1 = KVR0 + 32 * 511, KVR_ALL = KVR1 + 32 * 2047;
constexpr int KVQ = 4;
constexpr int KV_TAIL_P10 = 19984, KV_TAIL_P3 = 8592, KV_TAIL_ROWS = KV_TAIL_P10 + KV_TAIL_P3;
struct KvCopy { f32x4 t[KVQ][2]; f32x4* dp[KVQ]; };
template <int NQ> DI void kv_issue(KvCopy& k, const float* c0, const float* c1, const float* c2, float* out, int rowbase, int slot, int lane) {
#pragma unroll
    for (int q = 0; q < NQ; ++q) {
        const int R0 = rowbase + NQ * slot + q; const int R = R0 < KVR_ALL ? R0 : KVR_ALL - 1;
        const int g = R < KVR0 ? 0 : (R < KVR1 ? 1 : 2); const int Rl = R - (g == 0 ? 0 : (g == 1 ? KVR0 : KVR1));
        const int w = g == 0 ? 128 : (g == 1 ? 512 : 2048), wm1 = w - 1; const int b = g == 0 ? Rl / 127 : (g == 1 ? Rl / 511 : Rl / 2047), r = Rl - b * wm1;
        const f32x4* sp = (const f32x4*)(g == 0 ? c0 : (g == 1 ? c1 : c2)) + ((size_t)b * w + r + 1) * 128 + lane;
        f32x4* d = (f32x4*)(out + (g == 0 ? O_KVS0 : (g == 1 ? O_KVS1 : O_KVS2))) + ((size_t)b * w + r) * 128 + lane;
        k.dp[q] = R0 < KVR_ALL ? d : nullptr;
        k.t[q][0] = __builtin_nontemporal_load(sp); k.t[q][1] = __builtin_nontemporal_load(sp + 64);
    }
}
template <int NQ> DI void kv_commit(const KvCopy& k) {
#pragma unroll
    for (int q = 0; q < NQ; ++q) if (k.dp[q]) { __builtin_nontemporal_store(k.t[q][0], k.dp[q]); __builtin_nontemporal_store(k.t[q][1], k.dp[q] + 64); }
}

struct SsmPar { float abr, abi, fr, fi; };
DI SsmPar ssm_par(const float* a_re, const float* a_im, const float* log_dt, int g, int p) {
    const float ar = a_re[g * 64 + p], ai = a_im[g * 64 + p], dt = expf(log_dt[g]);
    const float mag = expf(ar * dt); SsmPar o; o.abr = mag * cosf(ai * dt); o.abi = mag * sinf(ai * dt);
    const float inv = 1.0f / (ar * ar + ai * ai);
    o.fr = ((o.abr - 1.0f) * ar + o.abi * ai) * inv; o.fi = (o.abi * ar - (o.abr - 1.0f) * ai) * inv; return o;
}
struct SsmIn { const float *a_re, *a_im, *log_dt, *b_re, *b_im, *c_re, *c_im, *dsk; };

constexpr size_t WS_SSMT = 576 * 1024, SSMT_TC = 32 * 8 * 64 * 16, SSMT_TA = SSMT_TC + 32 * 4 * 64 * 16;
DI void ssm_build_tables(const SsmIn& W, unsigned char* tb, int g, int lane) {
    const int l15 = lane & 15, quad = lane >> 4;
    { const SsmPar sp = ssm_par(W.a_re, W.a_im, W.log_dt, g, lane); f32x2 ab = {sp.abr, sp.abi}; ((f32x2*)(tb + SSMT_TA))[g * 64 + lane] = ab; }
#pragma unroll
    for (int nt = 0; nt < 8; ++nt) {
        const int p = 8 * nt + (l15 >> 1), ri = l15 & 1; const SsmPar sp = ssm_par(W.a_re, W.a_im, W.log_dt, g, p);
        f32x4 v0 = {0, 0, 0, 0}, v1 = v0;
        if (quad < 2) { const float* br = W.b_re + ((size_t)(g * 64 + p)) * 16 + 8 * quad; const float* bi = W.b_im + ((size_t)(g * 64 + p)) * 16 + 8 * quad;
            const f32x4 r0 = *(const f32x4*)br, r1 = *(const f32x4*)(br + 4), i0 = *(const f32x4*)bi, i1 = *(const f32x4*)(bi + 4);
            if (ri == 0) { v0 = r0 * sp.fr - i0 * sp.fi; v1 = r1 * sp.fr - i1 * sp.fi; } else { v0 = i0 * sp.fr + r0 * sp.fi; v1 = i1 * sp.fr + r1 * sp.fi; } }
        ((bf16x8*)tb)[(g * 8 + nt) * 64 + lane] = frag_from_f32(v0, v1);
    }
#pragma unroll
    for (int s2 = 0; s2 < 4; ++s2) { const int p0 = 16 * s2 + 4 * quad; const float* cr = W.c_re + ((size_t)(g * 16 + l15)) * 64 + p0; const float* ci = W.c_im + ((size_t)(g * 16 + l15)) * 64 + p0;
        const f32x4 r = *(const f32x4*)cr, i = *(const f32x4*)ci;
        const f32x4 c0 = {r[0], -i[0], r[1], -i[1]}, c1 = {r[2], -i[2], r[3], -i[3]};
        ((bf16x8*)(tb + SSMT_TC))[(g * 4 + s2) * 64 + lane] = frag_from_f32(c0, c1); }
}
struct KvSrc { const float *c0, *c1, *c2; float* out; int slotbase; };

DI void kvshift_rows(const float* c0, const float* c1, const float* c2, float* out, int r_lo, int r_hi, int wk, int nwk, int wave, int lane) {
    const int stride = nwk * 8;
    for (int R0 = r_lo + wk * 8 + wave; R0 < r_hi; R0 += 8 * stride) {
        f32x4 t[8][2]; f32x4* dp[8];
#pragma unroll
        for (int q = 0; q < 8; ++q) {
            int R = R0 + q * stride; R = R < r_hi ? R : r_hi - 1;
            const int g = R < KVR0 ? 0 : (R < KVR1 ? 1 : 2); const int Rl = R - (g == 0 ? 0 : (g == 1 ? KVR0 : KVR1));
            const int w = g == 0 ? 128 : (g == 1 ? 512 : 2048), wm1 = w - 1; const int b = g == 0 ? Rl / 127 : (g == 1 ? Rl / 511 : Rl / 2047), r = Rl - b * wm1;
            const f32x4* sp = (const f32x4*)(g == 0 ? c0 : (g == 1 ? c1 : c2)) + ((size_t)b * w + r + 1) * 128 + lane;
            dp[q] = (f32x4*)(out + (g == 0 ? O_KVS0 : (g == 1 ? O_KVS1 : O_KVS2))) + ((size_t)b * w + r) * 128 + lane;
            t[q][0] = __builtin_nontemporal_load(sp); t[q][1] = __builtin_nontemporal_load(sp + 64);
        }
        SCHED_FENCE();
#pragma unroll
        for (int q = 0; q < 8; ++q) if (R0 + q * stride < r_hi) { __builtin_nontemporal_store(t[q][0], dp[q]); __builtin_nontemporal_store(t[q][1], dp[q] + 64); }
    }
}
DI void kvshift_tail(const float* c0, const float* c1, const float* c2, float* out, int nwg, int r_lo, int r_hi, int wave, int lane) {
    const int G = gridDim.x; const int first = nwg % G; const int wk = (int)blockIdx.x - first;
    if (wk >= 0) kvshift_rows(c0, c1, c2, out, r_lo, r_hi, wk, G - first, wave, lane);
}
template <bool PASS2>
DI void ssm_pass(LAS unsigned char* lds, const SsmIn& W, const unsigned char* TBL, const bf16_t* U, float* SEND, const float* SIN, bf16_t* YG, const KvSrc& KS, int vblk, int vG) {
    const int tid = otid(), wave = tid >> 6, lane = tid & 63, l15 = lane & 15, quad = lane >> 4;
    LAS float* Xs = (LAS float*)(lds + wave * 13312);
    LAS bf16_t* Ss = (LAS bf16_t*)(lds + wave * 13312 + 8448);
    LAS bf16_t* Us = (LAS bf16_t*)(lds + wave * 13312 + 12800);
    const int NGW = vG * 8, gw = vblk * 8 + wave;
    int gcur = -1; bf16x8 bfr[8]; bf16x8 cfr[4]; float abr = 0.f, abi = 0.f, dk = 0.f;
    for (int it = gw; it < 2 * NCH * 32; it += NGW) {
        const int g = it & 31, bc = it >> 5, b = bc >> 7, ch = bc & 127;
        KvCopy kc; kv_issue<2>(kc, KS.c0, KS.c1, KS.c2, KS.out, KS.slotbase, it, lane);
        const int rowc = b * SEQ + ch * TCH;
        bf16x8 uf[4];
#pragma unroll
        for (int sub = 0; sub < 4; ++sub) { uf[sub] = (bf16x8){0, 0, 0, 0, 0, 0, 0, 0}; if (quad < 2) uf[sub] = *(const bf16x8*)(U + (size_t)(rowc + 16 * sub + l15) * 512 + 16 * g + 8 * quad); }
        float sr = 0.f, si = 0.f;
        const size_t sbase = ((size_t)(b * NCH + ch) * 32 + g) * 128;
        if (PASS2) { sr = SIN[sbase + lane]; si = SIN[sbase + 64 + lane]; }
        __builtin_amdgcn_sched_barrier(0);
        if (g != gcur) {
            gcur = g;
            { const f32x2 ab = ((const f32x2*)(TBL + SSMT_TA))[g * 64 + lane]; abr = ab[0]; abi = ab[1]; }
#pragma unroll
            for (int q = 0; q < 8; ++q) bfr[q] = ((const bf16x8*)TBL)[(g * 8 + q) * 64 + lane];
            if (PASS2) {
#pragma unroll
                for (int s2 = 0; s2 < 4; ++s2) cfr[s2] = ((const bf16x8*)(TBL + SSMT_TC))[(g * 4 + s2) * 64 + lane];
                dk = W.dsk[g * 16 + l15];
            }
        }
#pragma unroll
        for (int sub = 0; sub < 4; ++sub) {
            const int row0 = rowc + 16 * sub;
            if (PASS2) { if (quad < 2) *(LAS bf16x8*)(Us + l15 * 16 + 8 * quad) = uf[sub]; }
#pragma unroll
            for (int nt = 0; nt < 8; ++nt) { f32x4 x = {0.f, 0.f, 0.f, 0.f}; x = MFMA16(uf[sub], bfr[nt], x);
#pragma unroll
                for (int j = 0; j < 4; ++j) Xs[(4 * quad + j) * 132 + 16 * nt + l15] = x[j]; }
            LDS_WAIT();
#pragma unroll
            for (int tok = 0; tok < 16; ++tok) {
                const f32x2 xx = *(const LAS f32x2*)(Xs + tok * 132 + 2 * lane);
                const float nr = abr * sr - abi * si + xx[0], ni = abr * si + abi * sr + xx[1]; sr = nr; si = ni;
                if (PASS2) *(LAS unsigned*)(Ss + tok * 136 + 2 * lane) = pk2(sr, si);
            }
            LDS_WAIT();
            if (PASS2) {
                f32x4 y = {0.f, 0.f, 0.f, 0.f};
#pragma unroll
                for (int s2 = 0; s2 < 4; ++s2) { const bf16x8 af = *(const LAS bf16x8*)(Ss + l15 * 136 + 32 * s2 + 8 * quad); y = MFMA16(af, cfr[s2], y); }
#pragma unroll
                for (int j = 0; j < 4; ++j) { const float uv = bf2f(Us[(4 * quad + j) * 16 + l15]); YG[(size_t)(row0 + 4 * quad + j) * 512 + 16 * g + l15] = f2bf(gelu_tanh(y[j] + dk * uv)); }
                LDS_WAIT();
            }
        }
        if (!PASS2) { SEND[sbase + lane] = sr; SEND[sbase + 64 + lane] = si; }
        kv_commit<2>(kc);
    }
}

DI void ssm_carry(const SsmIn& W, const float* SEND, float* SIN, float* out_re, float* out_im, int vblk, int vG) {
    for (int gt = vblk * 512 + otid(); gt < 2 * 32 * 64; gt += vG * 512) {
        const int b = gt >> 11, g = (gt >> 6) & 31, p = gt & 63;
        const SsmPar sp = ssm_par(W.a_re, W.a_im, W.log_dt, g, p);
        float tr = sp.abr, ti = sp.abi;
#pragma unroll
        for (int i = 0; i < 6; ++i) { const float nr = tr * tr - ti * ti, ni = 2.f * tr * ti; tr = nr; ti = ni; }
        float sr = 0.f, si = 0.f;
        for (int c0 = 0; c0 < NCH; c0 += 32) {
            float er[32], ei[32];
#pragma unroll
            for (int j = 0; j < 32; ++j) { const size_t o = ((size_t)(b * NCH + c0 + j) * 32 + g) * 128; er[j] = SEND[o + p]; ei[j] = SEND[o + 64 + p]; }
            SCHED_FENCE();
#pragma unroll
            for (int j = 0; j < 32; ++j) { const size_t o = ((size_t)(b * NCH + c0 + j) * 32 + g) * 128; SIN[o + p] = sr; SIN[o + 64 + p] = si;
                const float nr = tr * sr - ti * si + er[j], ni = tr * si + ti * sr + ei[j]; sr = nr; si = ni; }
        }
        out_re[gt] = sr; out_im[gt] = si;
    }
}

DI void attn_unit(int b, int g, int h, int dl, int rho, int m0, const bf16_t* Q, const bf16_t* K, const bf16_t* V, bf16_t* OG, float* ML, LAS bf16_t* Vs, int lane) {
    const int r = lane & 31, hh = lane >> 5; const int rowb = b * SEQ; const int co = g * 256 + h * 64;
    const int rowq = rowb + rho + ((m0 + r) << dl);
    bf16x8 qf[4]; bf16x8 kf[5][4];
    { const bf16x8* qp = (const bf16x8*)(Q + (size_t)rowq * 768 + co + 32 * hh);
#pragma unroll
      for (int s = 0; s < 4; ++s) qf[s] = qp[s]; }
#pragma unroll
    for (int kb = 0; kb < 5; ++kb) {
        int mk = m0 - 128 + 32 * kb + r; mk = mk < 0 ? 0 : mk;
        const bf16x8* kp = (const bf16x8*)(K + (size_t)(rowb + rho + (mk << dl)) * 768 + co + 32 * hh);
#pragma unroll
        for (int s = 0; s < 4; ++s) kf[kb][s] = kp[s];
    }
    const bf16_t* vbase = V + (size_t)(rowb + rho) * 768 + co + 8 * (lane & 7);
    u32x4 vreg[4];
#define ATT_VLOAD(kb_) do { _Pragma("unroll") for (int i_ = 0; i_ < 4; ++i_) { int kidx_ = m0 - 128 + 32 * (kb_) + 8 * i_ + (lane >> 3); kidx_ = kidx_ < 0 ? 0 : kidx_; \
        vreg[i_] = *(const u32x4*)(vbase + (size_t)(kidx_ << dl) * 768); } } while (0)
#define ATT_VSTORE(buf_) do { _Pragma("unroll") for (int i_ = 0; i_ < 4; ++i_) *(LAS u32x4*)(Vs + (buf_) * 2304 + (8 * i_ + (lane >> 3)) * 72 + 8 * (lane & 7)) = vreg[i_]; } while (0)
    SCHED_FENCE();
    f32x16 st[5];
#pragma unroll
    for (int kb = 0; kb < 5; ++kb) {
        f32x16 a = {};
#pragma unroll
        for (int s = 0; s < 4; ++s) a = MFMA32(kf[kb][s], qf[s], a);
        st[kb] = a;
    }
    SCHED_FENCE();
    ATT_VLOAD(0);
    SCHED_FENCE();
    float mx = -INFINITY; const bool early = m0 < 128;
#pragma unroll
    for (int kb = 0; kb < 5; ++kb)
#pragma unroll
        for (int i = 0; i < 16; ++i) {
            const int c = (i & 3) + 8 * (i >> 2) + 4 * hh; const int kidx = m0 - 128 + 32 * kb + c; const int j = r + 128 - 32 * kb - c;
            float v = st[kb][i];
            if (kb == 0) v = (j <= 128) ? v : -INFINITY;
            if (kb == 4) v = (j >= 0) ? v : -INFINITY;
            if (early) v = (kidx >= 0) ? v : -INFINITY;
            st[kb][i] = v; mx = fmaxf(mx, v);
        }
    mx = fmaxf(mx, __shfl_xor(mx, 32));
    float den = 0.f;
#pragma unroll
    for (int kb = 0; kb < 5; ++kb)
#pragma unroll
        for (int i = 0; i < 16; ++i) { const float p = __builtin_amdgcn_exp2f(st[kb][i] - mx); st[kb][i] = p; den += p; }
    den += __shfl_xor(den, 32);
    SCHED_FENCE();
    ATT_VSTORE(0);
    ATT_VLOAD(1);
    SCHED_FENCE();
    f32x16 ot[2] = {{}, {}};
#pragma unroll
    for (int kb = 0; kb < 5; ++kb) {
        LDS_WAIT();
#pragma unroll
        for (int c = 0; c < 2; ++c) {
            f32x4 p0, p1;
#pragma unroll
            for (int e = 0; e < 4; ++e) { p0[e] = st[kb][8 * c + e]; p1[e] = st[kb][8 * c + 4 + e]; }
            const bf16x8 pf = frag_from_f32(p0, p1);
#pragma unroll
            for (int db = 0; db < 2; ++db) {
                bf16x8 vf;
#pragma unroll
                for (int jj = 0; jj < 8; ++jj) vf[jj] = (short)Vs[(kb & 1) * 2304 + (16 * c + 8 * (jj >> 2) + 4 * hh + (jj & 3)) * 72 + 32 * db + r];
                ot[db] = MFMA32(vf, pf, ot[db]);
            }
        }
        SCHED_FENCE();
        if (kb < 4) { ATT_VSTORE((kb + 1) & 1); if (kb < 3) ATT_VLOAD(kb + 2); }
        SCHED_FENCE();
    }
    LDS_WAIT();
#undef ATT_VLOAD
#undef ATT_VSTORE
    const float inv = 1.0f / den;
    bf16_t* op = OG + ((size_t)g * MT + rowq) * 256 + h * 64;
#pragma unroll
    for (int db = 0; db < 2; ++db)
#pragma unroll
        for (int ig = 0; ig < 4; ++ig) { u32x2 w; w.x = pk2(ot[db][4 * ig] * inv, ot[db][4 * ig + 1] * inv); w.y = pk2(ot[db][4 * ig + 2] * inv, ot[db][4 * ig + 3] * inv);
            *(u32x2*)(op + 32 * db + 8 * ig + 4 * hh) = w; }
    if (hh == 0) { f32x2 ml = {mx, den}; *(f32x2*)(ML + (((size_t)g * MT + rowq) * 4 + h) * 2) = ml; }
}
DI void attn_prompt_phase(LAS unsigned char* lds, const bf16_t* Q, const bf16_t* K, const bf16_t* V, bf16_t* OG, float* ML, const KvSrc& KS, int vblk, int vG) {
    const int tid = otid(); const int wave = tid >> 6, lane = tid & 63; const int NGW = vG * 8, gw = vblk * 8 + wave;
    for (int it = gw; it < 2 * 3 * 4 * 256; it += NGW) {
        const int tile = it & 255, h = (it >> 8) & 3, gb = it >> 10, g = gb % 3, b = gb / 3;
        const int dl = 2 * g;
        const int tpc = 256 >> dl;
        KvCopy kc; kv_issue<4>(kc, KS.c0, KS.c1, KS.c2, KS.out, KS.slotbase, it, lane);
        SCHED_FENCE();
        attn_unit(b, g, h, dl, tile / tpc, 32 * (tile % tpc), Q, K, V, OG, ML, (LAS bf16_t*)(lds + wave * 9216), lane);
        SCHED_FENCE();
        kv_commit<4>(kc);
    }
}
DI void attn_combine(const bf16_t* OG, const float* ML, bf16_t* YY, int vblk, int vG) {
    for (int it = vblk * 512 + otid(); it < MT * 32; it += vG * 512) {
        const int row = it >> 5, h = (it >> 3) & 3, dc = it & 7;
        float m[3], dn[3];
#pragma unroll
        for (int g = 0; g < 3; ++g) { const f32x2 v = *(const f32x2*)(ML + (((size_t)g * MT + row) * 4 + h) * 2); m[g] = v[0]; dn[g] = v[1]; }
        const float mt = fmaxf(m[0], fmaxf(m[1], m[2]));
        f32x4 a0 = {0, 0, 0, 0}, a1 = a0; float wsum = 0.f;
#pragma unroll
        for (int g = 0; g < 3; ++g) { const float w = dn[g] * __builtin_amdgcn_exp2f(m[g] - mt); wsum += w; f32x4 o0, o1; unpack8(*(const u32x4*)(OG + ((size_t)g * MT + row) * 256 + h * 64 + 8 * dc), o0, o1); a0 += o0 * w; a1 += o1 * w; }
        const float inv = 1.0f / wsum;
        *(u32x4*)(YY + (size_t)row * 768 + 512 + h * 64 + 8 * dc) = pack8(a0 * inv, a1 * inv);
    }
}

DI void sample_attn_item(int s, int h, int g, const float* raw3, const float* gqk, const float* cp, float* ko, bf16_t* OG, float* ML, LAS float* sl, int lane) {
    const float* r3 = raw3 + (size_t)s * INW;
    const int w = g == 0 ? 128 : (g == 1 ? 512 : 2048), dl = 2 * g;
    const float q = r3[l2p(512 + 256 * g + 64 * h + lane)], k = r3[l2p(1280 + 256 * g + 64 * h + lane)], v = r3[l2p(2048 + 256 * g + 64 * h + lane)];
    const float qs = wave_sum(q * q), ks = wave_sum(k * k);
    const float qv = q * rsqrtf(qs * (1.f / 64.f) + EPS) * gqk[g * 64 + lane] * QSCALE, kn = k * rsqrtf(ks * (1.f / 64.f) + EPS) * gqk[192 + g * 64 + lane];
    sl[lane] = qv; sl[192 + lane] = v;
    ko[((size_t)(s * w + (w - 1)) * 2 + 0) * 256 + h * 64 + lane] = kn; ko[((size_t)(s * w + (w - 1)) * 2 + 1) * 256 + h * 64 + lane] = v;
    const float s0 = wave_sum(qv * kn);
    LDS_WAIT();
    float sc[2];
#pragma unroll
    for (int half = 0; half < 2; ++half) {
        const int j = 1 + lane + 64 * half; const int rr = w - (j << dl);
        const float* kp = cp + ((size_t)(s * w + rr) * 2 + 0) * 256 + h * 64; float a = 0.f;
#pragma unroll
        for (int d4 = 0; d4 < 16; ++d4) { const f32x4 kk = *(const f32x4*)(kp + 4 * d4); const f32x4 qq = *(const LAS f32x4*)(sl + 4 * d4); a += (kk[0] * qq[0] + kk[1] * qq[1]) + (kk[2] * qq[2] + kk[3] * qq[3]); }
        sc[half] = a;
    }
    const float mx = wave_max(fmaxf(s0, fmaxf(sc[0], sc[1])));
    const float e0 = __builtin_amdgcn_exp2f(s0 - mx), p0 = __builtin_amdgcn_exp2f(sc[0] - mx), p1 = __builtin_amdgcn_exp2f(sc[1] - mx);
    const float den = wave_sum(p0 + p1) + e0;
    sl[64 + lane] = p0; sl[128 + lane] = p1;
    LDS_WAIT();
    const int d4 = lane & 15, kq = lane >> 4;
    f32x4 o = {0.f, 0.f, 0.f, 0.f};
#pragma unroll 8
    for (int i = 0; i < 32; ++i) { const int j = 1 + kq + 4 * i; const int rr = w - (j << dl);
        const f32x4 vv = *(const f32x4*)(cp + ((size_t)(s * w + rr) * 2 + 1) * 256 + h * 64 + 4 * d4); o += vv * sl[64 + j - 1]; }
#pragma unroll
    for (int e = 0; e < 4; ++e) { o[e] += __shfl_xor(o[e], 16); o[e] += __shfl_xor(o[e], 32); }
    if (lane < 16) {
        const f32x4 vn = *(const LAS f32x4*)(sl + 192 + 4 * d4); const float inv = 1.0f / den;
        o = (o + vn * e0) * inv;
        u32x2 wv; wv.x = pk2(o[0], o[1]); wv.y = pk2(o[2], o[3]);
        *(u32x2*)(OG + ((size_t)g * MT + NPR + s) * 256 + h * 64 + 4 * d4) = wv;
    }
    if (lane == 0) { f32x2 ml = {mx, den}; *(f32x2*)(ML + (((size_t)g * MT + NPR + s) * 4 + h) * 2) = ml; }
    LDS_WAIT();
}
DI void sample_ssm_item(int s, int g, const SsmIn& W, const float* raw3, const float* st_re, const float* st_im, float* out_re, float* out_im, bf16_t* YG, int lane) {
    const SsmPar sp = ssm_par(W.a_re, W.a_im, W.log_dt, g, lane);
    const float* r3 = raw3 + (size_t)s * INW;
    float xr = 0.f, xi = 0.f;
    const float* br = W.b_re + (size_t)(g * 64 + lane) * 16; const float* bi = W.b_im + (size_t)(g * 64 + lane) * 16;
#pragma unroll
    for (int c = 0; c < 16; ++c) { const float u = r3[l2p(16 * g + c)]; const float bbr = sp.fr * br[c] - sp.fi * bi[c], bbi = sp.fr * bi[c] + sp.fi * br[c]; xr += bbr * u; xi += bbi * u; }
    const size_t so = (size_t)(s * 32 + g) * 64 + lane;
    const float s0r = st_re[so], s0i = st_im[so];
    const float nr = sp.abr * s0r - sp.abi * s0i + xr, ni = sp.abr * s0i + sp.abi * s0r + xi;
    out_re[so] = nr; out_im[so] = ni;
    float ysel = 0.f;
#pragma unroll
    for (int c = 0; c < 16; ++c) { const float y = wave_sum(W.c_re[(size_t)(g * 16 + c) * 64 + lane] * nr - W.c_im[(size_t)(g * 16 + c) * 64 + lane] * ni); if (lane == c) ysel = y; }
    if (lane < 16) { const float u = r3[l2p(16 * g + lane)]; YG[(size_t)(NPR + s) * 512 + 16 * g + lane] = f2bf(gelu_tanh(ysel + W.dsk[16 * g + lane] * u)); }
}

struct Args { const float* in[32]; float* out; unsigned char* ws; };

__global__ void __launch_bounds__(512, 2) mega_fwd(Args a) {
    extern __shared__ __attribute__((aligned(16))) unsigned char lds_raw[];
    LAS unsigned char* lds = (LAS unsigned char*)lds_raw;
    cg::grid_group grid = cg::this_grid();
    const int tid = threadIdx.x, lane = tid & 63, wave = __builtin_amdgcn_readfirstlane(tid >> 6);
    const int G = gridDim.x, blk = blockIdx.x, gw = blk * 8 + wave, NGW = G * 8;
    unsigned char* const ws = a.ws;
    if (tid < 16) ((LAS unsigned*)(lds + 131072))[tid] = 0u;
    __syncthreads();
    unsigned* const barw = (unsigned*)(ws + 512 * 1024);
    const XcdBarrier xb = xcd_barrier_post(barw, (volatile LAS unsigned*)(lds + 131072 + 32), (unsigned)G);
    const int HG = G / 2;
    const XcdBarrier xbh = xcd_barrier_post(barw + (blk < HG ? 4096 : 8192), (volatile LAS unsigned*)(lds + 131072 + 48), (unsigned)(blk < HG ? HG : G - HG));
#define W1GU ((bf16_t*)(ws + WS_W1GU))
#define W1D ((bf16_t*)(ws + WS_W1D))
#define WIN ((bf16_t*)(ws + WS_WIN))
#define WGLU ((bf16_t*)(ws + WS_WGLU))
#define WSP ((bf16_t*)(ws + WS_WMIX))
#define WAP ((bf16_t*)(ws + WS_WMIX + MiB))
#define TBUF ((bf16_t*)(ws + WS_X1 + 33 * MiB))
#define WO ((bf16_t*)(ws + WS_WO))
#define W2GU ((bf16_t*)(ws + WS_W2GU))
#define W2D ((bf16_t*)(ws + WS_W2D))
#define SEND ((float*)(ws + WS_SEND))
#define SIN ((float*)(ws + WS_SIN))
#define ML ((float*)(ws + WS_ML))
#define SQ1 ((float*)(ws + WS_SQ1))
#define SQ2 ((float*)(ws + WS_SQ2))
#define SR ((float*)(ws + WS_SRAW))
#define XN ((bf16_t*)(ws + WS_XN))
#define X1B ((bf16_t*)(ws + WS_X1B))
#define ACT ((bf16_t*)(ws + WS_ACT))
#define GT ((bf16_t*)(ws + WS_G))
#define OG ((bf16_t*)(ws + WS_OG))
#define YG ((bf16_t*)(ws + WS_YG))
#define YY ((bf16_t*)(ws + WS_YY))
#define X1 ((float*)(ws + WS_X1))
#define GQK ((float*)ws)
#define X2B XN
#define MIXED ((bf16_t*)(ws + WS_X1))
#define Ub ACT
#define Qb (ACT + (size_t)MT * 512)
#define Kb (ACT + (size_t)MT * 512 + (size_t)MT * 768)
#define Vb (ACT + (size_t)MT * 512 + (size_t)MT * 1536)
#define acts1 ((bf16_t*)(SR + SR_RAW1))
#define rawd (SR + SR_RAWD)
#define raw3 (SR + SR_RAW3)
#define rawglu (SR + SR_RAWGLU)
#define rawms (SR + SR_RAWMIX)
#define rawma (SR + SR_RAWMIX + 32 * 1024)
#define rawo (SR + SR_RAWO)
#define acts2 ((bf16_t*)(SR + SR_RAW10))
#define xp (a.in[0])
#define xs (a.in[1])
    float* const out = a.out;
#define SSM_IN(SW) SsmIn SW; SW.a_re = a.in[15]; SW.a_im = a.in[16]; SW.log_dt = a.in[17]; SW.b_re = a.in[18]; SW.b_im = a.in[19]; SW.c_re = a.in[20]; SW.c_im = a.in[21]; SW.dsk = a.in[22];

    constexpr int I_GU = 16 * 88, I_DN = 44 * 32, I_IN = 16 * 152, I_GL = 8 * 16, I_SP = 8 * 32, I_AP = 4 * 32, I_WO = 16 * 32;
#ifndef REP_P0
#define REP_P0 1
#endif
    for (int rep0 = 0; rep0 < REP_P0; ++rep0) {
        LAS float* scr = (LAS float*)(lds + wave * 16384);
        constexpr int NIT = 3 * I_GU + I_IN + I_GL + I_SP + I_AP + I_WO + 3 * I_GU;
        static_assert(I_DN == I_GU, "item counts");
        (void)NIT;
#define TR_JOB(CNT, ...) for (int r = gw; r < (CNT); r += NGW) tr_item(__VA_ARGS__, r, scr, lane);
        TR_JOB(I_GU, a.in[8], FF, nullptr, W1GU, 1024, 0, 1)
        TR_JOB(I_GU, a.in[9], FF, nullptr, W1GU, 1024, 0, 2)
        TR_JOB(I_IN, a.in[12], INW, a.in[11], WIN, 1024, 0, 3)
#undef TR_JOB
        for (int i = blk * 512 + tid; i < NPR; i += G * 512) { SQ1[i] = 0.f; SQ2[i] = 0.f; }
        for (int i = blk * 512 + tid; i < 384; i += G * 512) GQK[i] = i < 192 ? a.in[13][i] : a.in[14][i - 192];
        if (gw >= NGW - 32) { SSM_IN(SWT) ssm_build_tables(SWT, ws + WS_SSMT, gw - (NGW - 32), lane); }
        for (int m = gw; m < MT; m += 2 * NGW) { const int m1 = (m + NGW < MT) ? m + NGW : m;
            norm_rows2_bf16(m < NPR ? xp + (size_t)m * DM : xs + (size_t)(m - NPR) * DM, m1 < NPR ? xp + (size_t)m1 * DM : xs + (size_t)(m1 - NPR) * DM, a.in[7], XN + (size_t)m * DM, XN + (size_t)m1 * DM, lane); }
    }
    if (a.ws == nullptr) grid.sync();
    xcd_barrier(xb);
    {
        pg8::Gemm g{XN, W1GU, NPR, 2 * FF, DM}; pg8::StaticOrder S; S.init(NPR, 2 * FF, G, blk);
        EpiAct<false> E{ACT, nullptr};
        pg8::gemm_phase<EpiAct<false>, pg8::StaticOrder, true, true>(lds, g, S, E);
        ProvBf16 P{XN + (size_t)NPR * DM, DM};
        skinny_gu_phase<DM>(lds, W1GU, P, acts1);
        { const int first = (64 * 22) % G; const int wk = blk - first;
          if (wk >= 0) { LAS float* scr = (LAS float*)(lds + wave * 16384); const int gw2 = wk * 8 + wave, NGW2 = (G - first) * 8;
#define TR_JOB2(CNT, ...) for (int r = gw2; r < (CNT); r += NGW2) tr_item(__VA_ARGS__, r, scr, lane);
            TR_JOB2(I_DN, a.in[10], DM, nullptr, W1D, FF, 0, 0)
            TR_JOB2(I_GL, a.in[23], 512, nullptr, WGLU, 512, 0, 0)
            TR_JOB2(I_SP, a.in[25], DM, nullptr, WSP, 512, 0, 0)
            TR_JOB2(I_AP, a.in[26], DM, nullptr, WAP, 256, 0, 0)
            TR_JOB2(I_WO, a.in[27], DM, nullptr, WO, 1024, 0, 0)
            TR_JOB2(I_GU, a.in[29], FF, a.in[28], W2GU, 1024, 0, 1)
            TR_JOB2(I_GU, a.in[30], FF, a.in[28], W2GU, 1024, 0, 2)
            TR_JOB2(I_DN, a.in[31], DM, nullptr, W2D, FF, 0, 0)
#undef TR_JOB2
          } }
    }
    xcd_barrier(xb);
    {
        pg8::Gemm g{ACT, W1D, NPR, DM, FF}; pg8::StaticOrder S; S.init(NPR, DM, G, blk);
        EpiRes<false> E{xp, nullptr, X1B, SQ1, 0.5f};
        pg8::gemm_phase<EpiRes<false>, pg8::StaticOrder, true, true, -1>(lds, g, S, E);
        ProvBf16 P{acts1, FF}; SEpiRaw SE{rawd, DM};
        skinny_phase<DM, FF>(lds, W1D, P, SE);
    }
    xcd_barrier(xb);
    {
        pg8::Gemm g{X1B, WIN, NPR, INW, DM}; pg8::StaticOrder S; S.init(NPR, INW, G, blk);
        EpiWin E{SQ1, ACT, GT, GQK, out};
        pg8::gemm_phase<EpiWin, pg8::StaticOrder, true, true>(lds, g, S, E);
        ProvX<false> P{xs, rawd, nullptr}; SEpiRawScaled SE{raw3, INW};
        skinny_phase<INW, DM>(lds, WIN, P, SE);
        kvshift_tail(a.in[2], a.in[3], a.in[4], out, 64 * 19, KV_TAIL_P10, KV_TAIL_ROWS, wave, lane);
    }
    xcd_barrier(xb);
    if (blk < HG) {
        SSM_IN(SW)
        { const KvSrc KS{a.in[2], a.in[3], a.in[4], out, KV_TAIL_ROWS}; ssm_pass<false>(lds, SW, ws + WS_SSMT, Ub, SEND, nullptr, nullptr, KS, blk, HG); }
        xcd_barrier(xbh);
        ssm_carry(SW, SEND, SIN, out + O_SREP, out + O_SIMP, blk, HG);
        xcd_barrier(xbh);
        { const KvSrc KS{a.in[2], a.in[3], a.in[4], out, KV_TAIL_ROWS + 40960}; ssm_pass<true>(lds, SW, ws + WS_SSMT, Ub, nullptr, SIN, YG, KS, blk, HG); }
    } else {
        const int vblk = blk - HG, vG = G - HG, vgw = vblk * 8 + wave, vNGW = vG * 8;
        { const KvSrc KS{a.in[2], a.in[3], a.in[4], out, KV_TAIL_ROWS + 16384}; attn_prompt_phase(lds, Qb, Kb, Vb, OG, ML, KS, vblk, vG); }
        LAS float* sl = (LAS float*)(lds + 110592 + wave * 2560);
        for (int it = vgw; it < 384; it += vNGW) { const int g = it % 3, sh = it / 3;
            sample_attn_item(sh >> 2, sh & 3, g, raw3, GQK, g == 0 ? a.in[2] : (g == 1 ? a.in[3] : a.in[4]), out + (g == 0 ? O_KVS0 : (g == 1 ? O_KVS1 : O_KVS2)), OG, ML, sl, lane); }
        { SSM_IN(SW)
          for (int it = vNGW - 1 - vgw; it < 1024; it += vNGW) sample_ssm_item(it >> 5, it & 31, SW, raw3, a.in[5], a.in[6], out + O_SRES, out + O_SIMS, YG, lane); }
        xcd_barrier(xbh);
        attn_combine(OG, ML, YY, vblk, vG);
    }
    xcd_barrier(xb);
    {
        { pg8::Gemm g{YG, WGLU, NPR, 512, 512}; pg8::StaticOrder S; S.init(NPR, 512, G, blk);
          EpiGlu E{YG, a.in[24], YY};
          pg8::gemm_phase<EpiGlu, pg8::StaticOrder, true, true>(lds, g, S, E); }
        { pg8::Gemm g{YY + 512, WAP, NPR, DM, 256}; pg8::StaticOrder S; S.init(NPR, DM, G, blk);
          EpiGateScale E{GT, TBUF};
          pg8::gemm_phase<EpiGateScale, pg8::StaticOrder, true, true, 768>(lds, g, S, E); }
        { ProvBf16 P{YG + (size_t)NPR * 512, 512}; SEpiRaw SE{rawglu, 512};
          skinny_phase<512, 512>(lds, WGLU, P, SE); }
        { ProvBf16 P{YY + (size_t)NPR * 768 + 512, 768}; SEpiRaw SE{rawma, DM};
          skinny_phase<DM, 256>(lds, WAP, P, SE); }
    }
    xcd_barrier(xb);
    {
        pg8::Gemm g{YY, WSP, NPR, DM, 512}; pg8::StaticOrder S; S.init(NPR, DM, G, blk);
        EpiMix2 E{GT, TBUF, MIXED};
        pg8::gemm_phase<EpiMix2, pg8::StaticOrder, true, true, 768>(lds, g, S, E);
        ProvYY P{YG, rawglu, a.in[24], YY}; SEpiRaw SE{rawms, DM};
        skinny_phase<DM, 512>(lds, WSP, P, SE);
    }
    xcd_barrier(xb);
    {
        pg8::Gemm g{MIXED, WO, NPR, DM, DM}; pg8::StaticOrder S; S.init(NPR, DM, G, blk);
        EpiRes<true> E{X1B, nullptr, X2B, SQ2, 1.0f};
        pg8::gemm_phase<EpiRes<true>, pg8::StaticOrder, true, true>(lds, g, S, E);
        ProvMixed P{raw3, rawms, rawma}; SEpiRaw SE{rawo, DM};
        skinny_phase<DM, DM>(lds, WO, P, SE);
    }
    xcd_barrier(xb);
    {
        pg8::Gemm g{X2B, W2GU, NPR, 2 * FF, DM}; pg8::StaticOrder S; S.init(NPR, 2 * FF, G, blk);
        EpiAct<true> E{ACT, SQ2};
        pg8::gemm_phase<EpiAct<true>, pg8::StaticOrder, true, true>(lds, g, S, E);
        ProvX<true> P{xs, rawd, rawo};
        skinny_gu_phase<DM>(lds, W2GU, P, acts2);
        kvshift_tail(a.in[2], a.in[3], a.in[4], out, 64 * 22, 0, KV_TAIL_P10, wave, lane);
    }
    xcd_barrier(xb);
    {
        pg8::Gemm g{ACT, W2D, NPR, DM, FF}; pg8::StaticOrder S; S.init(NPR, DM, G, blk);
        EpiRes<true> E{X2B, out + O_YP, nullptr, nullptr, 0.5f};
        pg8::gemm_phase<EpiRes<true>, pg8::StaticOrder, true, true, -1>(lds, g, S, E);
        ProvBf16 P{acts2, FF}; SEpiFinal SE{xs, rawd, rawo, out + O_YS};
        skinny_phase<DM, FF>(lds, W2D, P, SE);
    }
}

extern "C" void kernel_launch(void* const* d_in, const int* in_sizes, int n_in, void* d_out, int out_size, void* d_ws, size_t ws_size, hipStream_t stream) {
    static int grid = 0;
    if (grid == 0) {
        if (n_in != 32 || ws_size < WS_END) { fprintf(stderr, "kernel_launch: unexpected inputs (n_in %d, ws %zu)\n", n_in, ws_size); grid = -1; return; }
        int dev = 0, cus = 0, per_cu = 0;
        hipGetDevice(&dev); hipDeviceGetAttribute(&cus, hipDeviceAttributeMultiprocessorCount, dev);
        hipFuncSetAttribute((const void*)mega_fwd, hipFuncAttributeMaxDynamicSharedMemorySize, LDS_BYTES);
        hipOccupancyMaxActiveBlocksPerMultiprocessor(&per_cu, (const void*)mega_fwd, 512, LDS_BYTES);
        if (per_cu < 1) { fprintf(stderr, "kernel_launch: occupancy query says %d blocks/CU\n", per_cu); per_cu = 1; }
        if (per_cu > 1) per_cu = 1;
        grid = cus * per_cu;
        (void)hipGetLastError();
    }
    if (grid < 0) return;
    if (hipMemsetAsync((char*)d_ws + 512 * 1024, 0, 3 * 4096 * 4, stream) != hipSuccess) { fprintf(stderr, "kernel_launch: memset of barrier words failed\n"); return; }
    Args a{};
    for (int i = 0; i < 32; ++i) a.in[i] = (const float*)d_in[i];
    a.out = (float*)d_out; a.ws = (unsigned char*)d_ws;
    void* args[] = {&a};
    hipError_t e = hipLaunchCooperativeKernel((const void*)mega_fwd, dim3(grid), dim3(512), args, LDS_BYTES, stream);
    if (e != hipSuccess) fprintf(stderr, "cooperative launch failed: %s (grid %d)\n", hipGetErrorString(e), grid);
}
```

```cpp
#include <hip/hip_runtime.h>
#include <hip/hip_cooperative_groups.h>
#include <cstdio>
#include <cstdint>
namespace cg = cooperative_groups;
namespace pg8 {
#define PG8_LAS __attribute__((address_space(3)))
typedef unsigned short bf16_t;
typedef short bf16x8 __attribute__((ext_vector_type(8)));
typedef float f32x4 __attribute__((ext_vector_type(4)));
typedef unsigned u32x4 __attribute__((ext_vector_type(4)));
constexpr int BM = 256, BK = 64, HALF = 128, HTB = HALF * BK * 2  , STAGE_BYTES = 8 * HTB, NXCD = 8, WGM = 8;

__host__ __device__ __forceinline__ int lds_byte(int r, int c) { const int st = (r >> 4) * 2 + (c >> 5), rr = r & 15, cc = c & 31, ob = rr * 64 + cc * 2; return st * 1024 + (ob ^ (((ob >> 9) & 1) << 5)); }
__host__ __device__ __forceinline__ void stage_rc(int b, int& R, int& C) { const int st = b / 1024, sb = b % 1024, swz = sb ^ (((sb >> 9) & 1) << 5); R = (st >> 1) * 16 + swz / 64; C = (st & 1) * 32 + (swz % 64) / 2; }
__host__ __device__ __forceinline__ int perm32(int rho) { const int n = rho >> 4, i = rho & 15; return 8 * (i >> 2) + 4 * n + (i & 3); }

struct Unit { int pm, pn; };
struct Gemm { const bf16_t* A; const bf16_t* Bt; int M, N, K; };

struct StaticOrder {
    int nM, nN, nwg, G, c;
    __host__ __device__ void init(int M, int N, int G_, int c_) { nM = M / BM; nN = N / BM; nwg = nM * nN; G = G_; c = c_; }
    __host__ __device__ bool next(int i, Unit& u) const {
        const long L = (long)i * G + c; if (L >= nwg) return false;
        int wgid = (int)L; { const int q = nwg / NXCD, r = nwg % NXCD, xcd = wgid % NXCD, off = wgid / NXCD; wgid = (xcd < r ? xcd * (q + 1) : r * (q + 1) + (xcd - r) * q) + off; }
        const int nig = WGM * nN, gid = wgid / nig, fm = gid * WGM, gsz = (nM - fm) < WGM ? (nM - fm) : WGM;
        u.pm = fm + ((wgid % nig) % gsz); u.pn = (wgid % nig) / gsz; return true;
    }
    __device__ __forceinline__ void a_ready(const Unit&) const {}
    __device__ __forceinline__ void done(const Unit&) const {}
};
template <class Epi, class Sched, bool ALIGN_EPI = false, bool SP2 = false, int LDA_T = 0>
__device__ __forceinline__ void gemm_phase(PG8_LAS unsigned char* lds, const Gemm g, const Sched& S, const Epi& E) {
    int tid_ = threadIdx.x; asm volatile("" : "+v"(tid_));
    const int tid = tid_, wid = __builtin_amdgcn_readfirstlane(tid >> 6), lane = tid & 63, wr = wid >> 2, wc = wid & 3, fr = lane & 15, fq = lane >> 4;
    constexpr bool ABLK = (LDA_T == -1);
    const int K = g.K, nt = K / BK, LDA = ABLK ? BK : (LDA_T ? LDA_T : g.K);
    unsigned voffA[2], voffB[2];
#pragma unroll
    for (int i = 0; i < 2; ++i) { int R, C; stage_rc(tid * 16 + i * 8192, R, C); const int Rb = Epi::PERM ? ((R & ~31) + perm32(R & 31)) : R;
        voffA[i] = (unsigned)(R * LDA + C) * 2u; voffB[i] = (unsigned)(Rb * K + C) * 2u; }
    const size_t kstepB = (size_t)(BK * 2), kstepA = ABLK ? (size_t)(BM * BK * 2) : kstepB;
    const size_t hstepB = (size_t)HALF * K * 2, hstepA = (size_t)HALF * LDA * 2;
    const size_t tstepB = 2 * hstepB, tstepA = ABLK ? (size_t)nt * kstepA : 2 * hstepA;
    const unsigned ldsw = (unsigned)wid * 1024u;
    const int aoff = lds_byte(wr * 64 + fr, fq * 8), boff = lds_byte(wc * 32 + fr, fq * 8);
#define PG8_SA(b, h) (((b) * 2 + (h)) * HTB)
#define PG8_SB(b, h) ((4 + (b) * 2 + (h)) * HTB)
#define PG8_STAGE(bufoff, gbase, voff) do { _Pragma("unroll") for (int _i = 0; _i < 2; ++_i) \
        __builtin_amdgcn_global_load_lds((const unsigned*)((const char*)(gbase) + (voff)[_i]), (PG8_LAS unsigned*)(lds + (bufoff) + ldsw + _i * 8192), 16, 0, 0); } while (0)
#define PG8_LDA(dst, b, h) do { _Pragma("unroll") for (int m = 0; m < 4; ++m) _Pragma("unroll") for (int k = 0; k < 2; ++k) dst[m][k] = *(const PG8_LAS bf16x8*)(lds + PG8_SA(b, h) + aoff + m * 2048 + k * 1024); } while (0)
#define PG8_LDB(dst, b, h) do { _Pragma("unroll") for (int n = 0; n < 2; ++n) _Pragma("unroll") for (int k = 0; k < 2; ++k) dst[n][k] = *(const PG8_LAS bf16x8*)(lds + PG8_SB(b, h) + boff + n * 2048 + k * 1024); } while (0)
#define PG8_MMA(ai, bj, At, Bt) do { __builtin_amdgcn_s_setprio(1); _Pragma("unroll") for (int m = 0; m < 4; ++m) _Pragma("unroll") for (int n = 0; n < 2; ++n) _Pragma("unroll") for (int k = 0; k < 2; ++k) \
        acc[ai][bj][m][n] = __builtin_amdgcn_mfma_f32_16x16x32_bf16(Bt[n][k], At[m][k], acc[ai][bj][m][n], 0, 0, 0); __builtin_amdgcn_s_setprio(0); } while (0)
#define PG8_WAIT_V(n) asm volatile("s_waitcnt vmcnt(" #n ")" ::: "memory")
#define PG8_WAIT_L(n) asm volatile("s_waitcnt lgkmcnt(" #n ")" ::: "memory")
#define PG8_BAR __builtin_amdgcn_s_barrier()
#define PG8_SCHED __builtin_amdgcn_sched_barrier(0)
    Unit cur, nxt; int ui = 0;
    if (!S.next(0, cur)) return;
    f32x4 acc[2][2][4][2];
#pragma unroll
    for (int a = 0; a < 2; ++a)
#pragma unroll
        for (int b = 0; b < 2; ++b)
#pragma unroll
            for (int m = 0; m < 4; ++m)
#pragma unroll
                for (int n = 0; n < 2; ++n) acc[a][b][m][n] = (f32x4){0.f, 0.f, 0.f, 0.f};
    bf16x8 At[4][2], B0[2][2], B1[2][2];
    const char* cA = (const char*)g.A + (size_t)cur.pm * tstepA; const char* cB = (const char*)g.Bt + (size_t)cur.pn * tstepB;
    S.a_ready(cur);
    if constexpr (SP2) {
        PG8_STAGE(PG8_SB(0, 0), cB, voffB); PG8_STAGE(PG8_SB(0, 1), cB + hstepB, voffB); PG8_STAGE(PG8_SA(0, 0), cA, voffA); PG8_STAGE(PG8_SA(0, 1), cA + hstepA, voffA);
        if (wr == 1) PG8_BAR;
        PG8_WAIT_V(2); PG8_BAR;
        PG8_STAGE(PG8_SB(1, 0), cB + kstepB, voffB); PG8_STAGE(PG8_SA(1, 0), cA + kstepA, voffA); PG8_STAGE(PG8_SB(1, 1), cB + hstepB + kstepB, voffB);
        PG8_WAIT_V(6); PG8_BAR;
    } else {
        PG8_STAGE(PG8_SB(0, 0), cB, voffB); PG8_STAGE(PG8_SA(0, 0), cA, voffA); PG8_STAGE(PG8_SB(0, 1), cB + hstepB, voffB); PG8_STAGE(PG8_SA(0, 1), cA + hstepA, voffA);
        if (wr == 1) PG8_BAR;
        PG8_WAIT_V(4); PG8_BAR;
        PG8_STAGE(PG8_SB(1, 0), cB + kstepB, voffB); PG8_STAGE(PG8_SA(1, 0), cA + kstepA, voffA); PG8_STAGE(PG8_SB(1, 1), cB + hstepB + kstepB, voffB);
        PG8_WAIT_V(6); PG8_BAR;
    }
    for (;;) {
        const bool has_next = S.next(ui + 1, nxt);
        const char* nA = has_next ? (const char*)g.A + (size_t)nxt.pm * tstepA : cA; const char* nB = has_next ? (const char*)g.Bt + (size_t)nxt.pn * tstepB : cB;
        for (int t = 0; t < nt; t += 2) {
            const bool last = (t == nt - 2);
            const char* a1 = cA + (size_t)(t + 1) * kstepA;
            const char* a2 = last ? nA : cA + (size_t)(t + 2) * kstepA; const char* b2 = last ? nB : cB + (size_t)(t + 2) * kstepB;
            const char* a3 = a2 + kstepA; const char* b3 = b2 + kstepB;
            if (last && has_next) S.a_ready(nxt);
            if constexpr (SP2) {
            PG8_LDB(B0, 0, 0); PG8_LDB(B1, 0, 1); PG8_SCHED; PG8_LDA(At, 0, 0); PG8_STAGE(PG8_SA(1, 1), a1 + hstepA, voffA);
            PG8_WAIT_V(8); PG8_WAIT_L(0); PG8_BAR; PG8_MMA(0, 0, At, B0); PG8_MMA(0, 1, At, B1); PG8_BAR; PG8_SCHED;
            PG8_LDA(At, 0, 1); PG8_STAGE(PG8_SB(0, 0), b2, voffB); PG8_STAGE(PG8_SB(0, 1), b2 + hstepB, voffB); PG8_STAGE(PG8_SA(0, 0), a2, voffA);
            PG8_WAIT_V(8); PG8_WAIT_L(0); PG8_BAR; PG8_MMA(1, 0, At, B0); PG8_MMA(1, 1, At, B1); PG8_BAR; PG8_SCHED;
            PG8_LDB(B0, 1, 0); PG8_LDB(B1, 1, 1); PG8_SCHED; PG8_LDA(At, 1, 0); PG8_STAGE(PG8_SA(0, 1), a2 + hstepA, voffA);
            PG8_WAIT_V(8); PG8_WAIT_L(0); PG8_BAR; PG8_MMA(0, 0, At, B0); PG8_MMA(0, 1, At, B1); PG8_BAR; PG8_SCHED;
            PG8_LDA(At, 1, 1); PG8_STAGE(PG8_SB(1, 0), b3, voffB); PG8_STAGE(PG8_SB(1, 1), b3 + hstepB, voffB); PG8_STAGE(PG8_SA(1, 0), a3, voffA);
            PG8_WAIT_V(8); PG8_WAIT_L(0); PG8_BAR; PG8_MMA(1, 0, At, B0); PG8_MMA(1, 1, At, B1); PG8_BAR; PG8_SCHED;
            } else {
            PG8_LDB(B0, 0, 0); PG8_SCHED; PG8_LDA(At, 0, 0); PG8_STAGE(PG8_SA(1, 1), a1 + hstepA, voffA);
            PG8_WAIT_L(8); PG8_BAR; PG8_WAIT_L(0); PG8_MMA(0, 0, At, B0); PG8_BAR; PG8_SCHED;
            PG8_LDB(B1, 0, 1); PG8_STAGE(PG8_SB(0, 0), b2, voffB);
            PG8_BAR; PG8_WAIT_L(0); PG8_MMA(0, 1, At, B1); PG8_BAR;
            PG8_LDA(At, 0, 1); PG8_STAGE(PG8_SA(0, 0), a2, voffA);
            PG8_BAR; PG8_WAIT_L(0); PG8_MMA(1, 0, At, B0); PG8_BAR; PG8_SCHED;
            PG8_STAGE(PG8_SB(0, 1), b2 + hstepB, voffB);
            PG8_WAIT_V(6); PG8_BAR; PG8_MMA(1, 1, At, B1); PG8_BAR;
            PG8_LDB(B0, 1, 0); PG8_SCHED; PG8_LDA(At, 1, 0); PG8_STAGE(PG8_SA(0, 1), a2 + hstepA, voffA);
            PG8_WAIT_L(8); PG8_BAR; PG8_WAIT_L(0); PG8_MMA(0, 0, At, B0); PG8_BAR; PG8_SCHED;
            PG8_LDB(B1, 1, 1); PG8_STAGE(PG8_SB(1, 0), b3, voffB);
            PG8_BAR; PG8_WAIT_L(0); PG8_MMA(0, 1, At, B1); PG8_BAR;
            PG8_LDA(At, 1, 1); PG8_STAGE(PG8_SA(1, 0), a3, voffA);
            PG8_BAR; PG8_WAIT_L(0); PG8_MMA(1, 0, At, B0); PG8_BAR; PG8_SCHED;
            PG8_STAGE(PG8_SB(1, 1), b3 + hstepB, voffB);
            PG8_WAIT_V(6); PG8_BAR; PG8_MMA(1, 1, At, B1); PG8_BAR;
            }
        }
        if constexpr (ALIGN_EPI) { if (wr == 0) PG8_BAR; }
        if constexpr (!Epi::AFTER_DRAIN) { E(acc, cur, wr, wc, fr, fq); S.done(cur); }
        if (!has_next) break;
#pragma unroll
        for (int a = 0; a < 2; ++a)
#pragma unroll
            for (int b = 0; b < 2; ++b)
#pragma unroll
                for (int m = 0; m < 4; ++m)
#pragma unroll
                    for (int n = 0; n < 2; ++n) acc[a][b][m][n] = (f32x4){0.f, 0.f, 0.f, 0.f};
        cur = nxt; cA = nA; cB = nB; ++ui;
        if constexpr (ALIGN_EPI) { if (wr == 1) PG8_BAR; }
    }
    PG8_WAIT_V(0);
    if constexpr (!ALIGN_EPI) { if (wr == 0) PG8_BAR; }
    PG8_BAR;
    if constexpr (Epi::AFTER_DRAIN) { E.fused(acc, cur, wr, wc, fr, fq, lds, wid, lane); S.done(cur); }
#undef PG8_SA
#undef PG8_SB
#undef PG8_STAGE
#undef PG8_LDA
#undef PG8_LDB
#undef PG8_MMA
#undef PG8_WAIT_V
#undef PG8_WAIT_L
#undef PG8_BAR
#undef PG8_SCHED
}
}

#define LAS __attribute__((address_space(3)))
#define DI __device__ __forceinline__
typedef unsigned short bf16_t;
typedef short bf16x8 __attribute__((ext_vector_type(8)));
typedef float f32x4 __attribute__((ext_vector_type(4)));
typedef float f32x2 __attribute__((ext_vector_type(2)));
typedef float f32x16 __attribute__((ext_vector_type(16)));
typedef unsigned u32x4 __attribute__((ext_vector_type(4)));
typedef unsigned u32x2 __attribute__((ext_vector_type(2)));
typedef __bf16 bf16x2n __attribute__((ext_vector_type(2)));

constexpr int DM = 1024, FF = 2816, NPR = 16384, NSM = 32, MT = NPR + NSM, SEQ = 8192, INW = 4864;
constexpr float EPS = 1e-6f;
constexpr float QSCALE = 0.125f * 1.4426950408889634f;
constexpr int NCH = 128, TCH = 64;

constexpr size_t MiB = 1u << 20;
constexpr size_t WS_W1GU = 1 * MiB, WS_W1D = 12 * MiB, WS_WIN = 18 * MiB, WS_WGLU = 28 * MiB, WS_WMIX = 29 * MiB, WS_WO = 32 * MiB, WS_W2GU = 34 * MiB, WS_W2D = 45 * MiB;
constexpr size_t WS_SEND = 51 * MiB, WS_SIN = 55 * MiB, WS_ML = 59 * MiB, WS_SQ1 = 61 * MiB, WS_SQ2 = 63 * MiB, WS_SRAW = 65 * MiB;
constexpr size_t WS_XN = 70 * MiB, WS_X1B = 103 * MiB, WS_X1 = 136 * MiB, WS_ACT = 201 * MiB, WS_G = 290 * MiB, WS_OG = 355 * MiB, WS_YG = 380 * MiB, WS_YY = 397 * MiB, WS_END = 422 * MiB;
constexpr size_t SR_RAW1 = 0, SR_RAWD = SR_RAW1 + 32 * 5632, SR_RAW3 = SR_RAWD + 32 * 1024, SR_RAWGLU = SR_RAW3 + 32 * 4864, SR_RAWMIX = SR_RAWGLU + 32 * 512, SR_RAWO = SR_RAWMIX + 32 * 2048,
                 SR_RAW10 = SR_RAWO + 32 * 1024, SR_END = SR_RAW10 + 32 * 5632;
static_assert(SR_END * 4 <= 5 * MiB, "sample raw region");
constexpr size_t O_YP = 0, O_YS = 16777216, O_KVP0 = 16809984, O_KVP1 = 16941056, O_KVP2 = 17465344, O_SREP = 19562496, O_SIMP = 19566592,
                 O_KVS0 = 19570688, O_KVS1 = 21667840, O_KVS2 = 30056448, O_SRES = 63610880, O_SIMS = 63676416;

constexpr int LDS_BYTES = 147456;

DI int otid() { int t = threadIdx.x; asm volatile("" : "+v"(t)); return t; }
DI unsigned pk2(float a, float b) { f32x2 v = {a, b}; bf16x2n r = __builtin_convertvector(v, bf16x2n); return __builtin_bit_cast(unsigned, r); }
DI bf16_t f2bf(float a) { return (bf16_t)(pk2(a, a) & 0xffffu); }
DI float bflo(unsigned w) { return __uint_as_float(w << 16); }
DI float bfhi(unsigned w) { return __uint_as_float(w & 0xffff0000u); }
DI float bf2f(bf16_t b) { return __uint_as_float(((unsigned)b) << 16); }
DI float sigm(float x) { return __builtin_amdgcn_rcpf(1.f + __expf(-x)); }
DI float silu(float x) { return x * sigm(x); }
DI float gelu_tanh(float x) { const float z = 0.7978845608028654f * (x + 0.044715f * x * x * x); const float t = 1.f - 2.f * __builtin_amdgcn_rcpf(1.f + __expf(2.f * z)); return 0.5f * x * (1.f + t); }
DI u32x4 pack8(f32x4 a, f32x4 b) { u32x4 w; w.x = pk2(a[0], a[1]); w.y = pk2(a[2], a[3]); w.z = pk2(b[0], b[1]); w.w = pk2(b[2], b[3]); return w; }
DI void unpack8(u32x4 w, f32x4& a, f32x4& b) { a = (f32x4){bflo(w.x), bfhi(w.x), bflo(w.y), bfhi(w.y)}; b = (f32x4){bflo(w.z), bfhi(w.z), bflo(w.w), bfhi(w.w)}; }
DI float wave_sum(float v) {
#pragma unroll
    for (int o = 1; o < 64; o <<= 1) v += __shfl_xor(v, o);
    return v;
}
DI float wave_max(float v) {
#pragma unroll
    for (int o = 1; o < 64; o <<= 1) v = fmaxf(v, __shfl_xor(v, o));
    return v;
}
DI float rstd16(const float* sq, int row) { return rsqrtf(sq[row] * (1.f / 1024.f) + EPS); }
DI int l2p(int c) { return (c & ~255) | (((c >> 5) & 1) << 7) | (((c >> 6) & 3) << 5) | (c & 31); }
#define LDS_WAIT() asm volatile("s_waitcnt lgkmcnt(0)" ::: "memory")
#define SCHED_FENCE() __builtin_amdgcn_sched_barrier(0)


typedef __attribute__((address_space(1))) unsigned gu32;
#define XB_TMO      128
#define XB_XCNT(j)  (256  + 64 * (j))
#define XB_XSUB(j)  (1280 + 64 * (j))
#define XB_XGEN(j)  (2304 + 64 * (j))
#define XB_TOP      3328
#define XB_TOPGEN   3392
#define XCD_BAR_WORDS 3456
#define XB_SPIN_CAP (1u << 18)

__device__ __forceinline__ unsigned xb_ld(unsigned* p)              { return __hip_atomic_load(p, __ATOMIC_RELAXED, __HIP_MEMORY_SCOPE_AGENT); }
__device__ __forceinline__ unsigned xb_add(unsigned* p, unsigned v) { return __hip_atomic_fetch_add(p, v, __ATOMIC_RELAXED, __HIP_MEMORY_SCOPE_AGENT); }
__device__ __forceinline__ unsigned xb_xcc_id() { return (unsigned)__builtin_amdgcn_s_getreg((3 << 11) | 20) & 0xFu; }
#define XB_SPIN(cond, bar) do { unsigned _sp = 0; while (cond) { __builtin_amdgcn_s_sleep(1); \
    if ((++_sp & 255u) == 0u) { if (xb_ld(&(bar)[XB_TMO])) break; if (_sp > XB_SPIN_CAP) { atomicAdd(&(bar)[XB_TMO], 1u); break; } } } } while (0)

struct XcdBarrier {
    unsigned* bar; unsigned x; unsigned G;
    volatile LAS unsigned* st;
};

__device__ __forceinline__ XcdBarrier xcd_barrier_post(unsigned* bar, volatile LAS unsigned* st, unsigned G) {
    XcdBarrier b; b.bar = bar; b.x = xb_xcc_id(); b.st = st; b.G = G;
    if (threadIdx.x == 0) (void)xb_add(&bar[XB_XCNT(b.x)], 1u);
    return b;
}
__device__ __forceinline__ void xcd_barrier_complete(unsigned* bar, unsigned x, unsigned G, unsigned& nloc, unsigned& nx) {
    unsigned sum, cnt, mine, sp = 0u;
    for (;;) {
        sum = 0u; cnt = 0u; mine = 0u;
#pragma unroll
        for (unsigned j = 0; j < 16; ++j) { const unsigned c = xb_ld(&bar[XB_XCNT(j)]); sum += c; cnt += (c > 0u) ? 1u : 0u; mine = (j == x) ? c : mine; }
        if (sum == G) break;
        __builtin_amdgcn_s_sleep(1);
        if ((++sp & 255u) == 0u) { if (xb_ld(&bar[XB_TMO])) break; if (sp > XB_SPIN_CAP) { atomicAdd(&bar[XB_TMO], 1u); break; } }
    }
    nloc = mine > 0u ? mine : 1u; nx = cnt > 0u ? cnt : 1u;
}

__device__ __forceinline__ void xcd_barrier(const XcdBarrier& b) {
    asm volatile("s_waitcnt vmcnt(0)" ::: "memory");
    __syncthreads();
    if (threadIdx.x == 0) {
        unsigned* bar = b.bar; unsigned bx = b.x; asm volatile("" : "+s"(bx));
        __builtin_amdgcn_s_waitcnt(0);
        unsigned nloc = b.st[0], nx = b.st[1];
        if (nloc == 0u) { xcd_barrier_complete(bar, bx, b.G, nloc, nx); b.st[0] = nloc; b.st[1] = nx; }
        const unsigned old = xb_add(&bar[XB_XSUB(bx)], 1u);
        const unsigned gen = old / nloc;
        if (old + 1u == (gen + 1u) * nloc) {
            __builtin_amdgcn_fence(__ATOMIC_RELEASE, "agent");
            asm volatile("s_waitcnt vmcnt(0)" ::: "memory");
            const unsigned og = xb_add(&bar[XB_TOP], 1u);
            const unsigned tg = og / nx;
            if (og + 1u == (tg + 1u) * nx) xb_add(&bar[XB_TOPGEN], 1u);
            else XB_SPIN(xb_ld(&bar[XB_TOPGEN]) == tg, bar);
            __builtin_amdgcn_fence(__ATOMIC_ACQUIRE, "agent");
            xb_add(&bar[XB_XGEN(bx)], 1u);
            asm volatile("s_waitcnt vmcnt(0)" ::: "memory");
        } else {
            XB_SPIN(xb_ld(&bar[XB_XGEN(bx)]) == gen, bar);
            __builtin_amdgcn_fence(__ATOMIC_ACQUIRE, "agent");
            asm volatile("s_waitcnt vmcnt(0)" ::: "memory");
        }
    }
    __syncthreads();
}

using pg8::Unit;
template <bool RS> struct EpiAct {
    static constexpr bool PERM = true, AFTER_DRAIN = false;
    bf16_t* O; const float* sq;
    DI void operator()(const f32x4 (&acc)[2][2][4][2], const Unit& u, int wr, int wc, int fr, int fq) const {
        const int row0 = u.pm * 256 + wr * 64 + fr, col = u.pn * 128 + wc * 32 + 8 * fq;
        float rs[2][4];
#pragma unroll
        for (int ai = 0; ai < 2; ++ai)
#pragma unroll
            for (int m = 0; m < 4; ++m) rs[ai][m] = RS ? sq[row0 + ai * 128 + m * 16] : 1.f;
        SCHED_FENCE();
#pragma unroll
        for (int ai = 0; ai < 2; ++ai)
#pragma unroll
            for (int m = 0; m < 4; ++m) {
                const int row = row0 + ai * 128 + m * 16; float r1 = 1.f; if (RS) r1 = rsqrtf(rs[ai][m] * (1.f / 1024.f) + EPS);
                f32x4 o[2];
#pragma unroll
                for (int n = 0; n < 2; ++n)
#pragma unroll
                    for (int e = 0; e < 4; ++e) o[n][e] = silu(acc[ai][0][m][n][e] * r1) * (acc[ai][1][m][n][e] * r1);
                *(u32x4*)(O + (((size_t)(row >> 8) * (FF / 64) + (col >> 6)) * 256 + (row & 255)) * 64 + (col & 63)) = pack8(o[0], o[1]);
            }
    }
};
template <bool BF> struct EpiRes {
    static constexpr bool PERM = true, AFTER_DRAIN = false;
    const void* base; float* out; bf16_t* ob; float* sq; float scale;
    DI void operator()(const f32x4 (&acc)[2][2][4][2], const Unit& u, int wr, int wc, int fr, int fq) const {
        const int row0 = u.pm * 256 + wr * 64 + fr;
        constexpr int MB = BF ? 4 : 2;
#pragma unroll
        for (int ai = 0; ai < 2; ++ai)
#pragma unroll
        for (int m0 = 0; m0 < 4; m0 += MB) {
            f32x4 b0[MB][2], b1[MB][2]; u32x4 bw[MB][2];
            SCHED_FENCE();
#pragma unroll
            for (int mm = 0; mm < MB; ++mm)
#pragma unroll
                for (int bj = 0; bj < 2; ++bj) { const size_t off = (size_t)(row0 + ai * 128 + (m0 + mm) * 16) * DM + u.pn * 256 + bj * 128 + wc * 32 + 8 * fq;
                    if (BF) bw[mm][bj] = *(const u32x4*)((const bf16_t*)base + off);
                    else { b0[mm][bj] = *(const f32x4*)((const float*)base + off); b1[mm][bj] = *(const f32x4*)((const float*)base + off + 4); } }
            SCHED_FENCE();
#pragma unroll
            for (int mm = 0; mm < MB; ++mm) {
                const int m = m0 + mm; const int row = row0 + ai * 128 + m * 16; float ss = 0.f;
#pragma unroll
                for (int bj = 0; bj < 2; ++bj) {
                    const size_t off = (size_t)row * DM + u.pn * 256 + bj * 128 + wc * 32 + 8 * fq;
                    f32x4 c0, c1; if (BF) unpack8(bw[mm][bj], c0, c1); else { c0 = b0[mm][bj]; c1 = b1[mm][bj]; }
                    const f32x4 v0 = c0 + acc[ai][bj][m][0] * scale, v1 = c1 + acc[ai][bj][m][1] * scale;
                    if (out) { *(f32x4*)(out + off) = v0; *(f32x4*)(out + off + 4) = v1; }
                    if (ob) *(u32x4*)(ob + off) = pack8(v0, v1);
                    ss += (v0[0] * v0[0] + v0[1] * v0[1]) + (v0[2] * v0[2] + v0[3] * v0[3]) + (v1[0] * v1[0] + v1[1] * v1[1]) + (v1[2] * v1[2] + v1[3] * v1[3]);
                }
                if (sq) { ss += __shfl_xor(ss, 16); ss += __shfl_xor(ss, 32); if (fq == 0) atomicAdd(sq + row, ss); }
            }
        }
    }
};
struct EpiWin {
    static constexpr bool PERM = true, AFTER_DRAIN = false;
    const float* sq; bf16_t* UQKV; bf16_t* G; const float* gqk; float* out;
    DI void operator()(const f32x4 (&acc)[2][2][4][2], const Unit& u, int wr, int wc, int fr, int fq) const {
        const int row0 = u.pm * 256 + wr * 64 + fr, pn = u.pn;
        const int kind = (pn - 2) / 3, g = (pn - 2) % 3;
        float rsq[2][4]; f32x4 gn[2][2];
#pragma unroll
        for (int ai = 0; ai < 2; ++ai)
#pragma unroll
            for (int m = 0; m < 4; ++m) rsq[ai][m] = sq[row0 + ai * 128 + m * 16];
        if (pn >= 2 && pn < 8) { const float* gp = gqk + kind * 192 + g * 64 + 8 * fq;
#pragma unroll
            for (int bj = 0; bj < 2; ++bj) { gn[bj][0] = *(const f32x4*)(gp + bj * 32); gn[bj][1] = *(const f32x4*)(gp + bj * 32 + 4); } }
        else { const f32x4 one = {1.f, 1.f, 1.f, 1.f}; gn[0][0] = one; gn[0][1] = one; gn[1][0] = one; gn[1][1] = one; }
        SCHED_FENCE();
#pragma unroll
        for (int ai = 0; ai < 2; ++ai)
#pragma unroll
            for (int m = 0; m < 4; ++m) {
                const int row = row0 + ai * 128 + m * 16; const float rs = rsqrtf(rsq[ai][m] * (1.f / 1024.f) + EPS);
                f32x4 v[2][2];
#pragma unroll
                for (int bj = 0; bj < 2; ++bj)
#pragma unroll
                    for (int n = 0; n < 2; ++n) v[bj][n] = acc[ai][bj][m][n] * rs;
                if (pn < 2) {
#pragma unroll
                    for (int bj = 0; bj < 2; ++bj) *(u32x4*)(UQKV + (size_t)row * 512 + pn * 256 + wc * 64 + bj * 32 + 8 * fq) = pack8(v[bj][0], v[bj][1]);
                } else if (pn < 11) {
                    float rn = 1.f;
                    if (kind < 2) {
                        float ss = 0.f;
#pragma unroll
                        for (int bj = 0; bj < 2; ++bj)
#pragma unroll
                            for (int n = 0; n < 2; ++n) ss += (v[bj][n][0] * v[bj][n][0] + v[bj][n][1] * v[bj][n][1]) + (v[bj][n][2] * v[bj][n][2] + v[bj][n][3] * v[bj][n][3]);
                        ss += __shfl_xor(ss, 16); ss += __shfl_xor(ss, 32);
                        rn = rsqrtf(ss * (1.f / 64.f) + EPS) * (kind == 0 ? QSCALE : 1.f);
                    }
                    const int t = row & (SEQ - 1), b = row >> 13; const int w = g == 0 ? 128 : (g == 1 ? 512 : 2048);
                    const size_t kvo = g == 0 ? O_KVP0 : (g == 1 ? O_KVP1 : O_KVP2);
                    bf16_t* dstb = UQKV + (size_t)MT * 512 + (size_t)kind * ((size_t)MT * 768) + (size_t)row * 768 + g * 256 + wc * 64 + 8 * fq;
#pragma unroll
                    for (int bj = 0; bj < 2; ++bj) {
                        const f32x4 a0 = v[bj][0] * rn * gn[bj][0], a1 = v[bj][1] * rn * gn[bj][1];
                        *(u32x4*)(dstb + bj * 32) = pack8(a0, a1);
                        if (kind >= 1 && t >= SEQ - w) { float* o = out + kvo + ((size_t)(b * w + (t - (SEQ - w))) * 2 + (kind - 1)) * 256 + wc * 64 + bj * 32 + 8 * fq; *(f32x4*)o = a0; *(f32x4*)(o + 4) = a1; }
                    }
                } else {
#pragma unroll
                    for (int bj = 0; bj < 2; ++bj) {
                        f32x4 a0, a1;
#pragma unroll
                        for (int e = 0; e < 4; ++e) { a0[e] = sigm(v[bj][0][e]); a1[e] = sigm(v[bj][1][e]); }
                        *(u32x4*)(G + (size_t)row * 2048 + (pn - 11) * 256 + wc * 64 + bj * 32 + 8 * fq) = pack8(a0, a1);
                    }
                }
            }
    }
};
struct EpiGlu {
    static constexpr bool PERM = true, AFTER_DRAIN = false;
    const bf16_t* YG; const float* bias; bf16_t* YY;
    DI void operator()(const f32x4 (&acc)[2][2][4][2], const Unit& u, int wr, int wc, int fr, int fq) const {
        const int row0 = u.pm * 256 + wr * 64 + fr;
        f32x4 bb[2][2];
#pragma unroll
        for (int bj = 0; bj < 2; ++bj) { const int col = u.pn * 256 + bj * 128 + wc * 32 + 8 * fq; bb[bj][0] = *(const f32x4*)(bias + col); bb[bj][1] = *(const f32x4*)(bias + col + 4); }
#pragma unroll
        for (int ai = 0; ai < 2; ++ai) {
            u32x4 yw[2][4][2];
            SCHED_FENCE();
#pragma unroll
            for (int bj = 0; bj < 2; ++bj)
#pragma unroll
                for (int m = 0; m < 4; ++m) yw[ai][m][bj] = *(const u32x4*)(YG + (size_t)(row0 + ai * 128 + m * 16) * 512 + u.pn * 256 + bj * 128 + wc * 32 + 8 * fq);
            SCHED_FENCE();
#pragma unroll
            for (int m = 0; m < 4; ++m) {
                const int row = row0 + ai * 128 + m * 16;
#pragma unroll
                for (int bj = 0; bj < 2; ++bj) {
                    const int col = u.pn * 256 + bj * 128 + wc * 32 + 8 * fq;
                    f32x4 y0, y1; unpack8(yw[ai][m][bj], y0, y1);
                    f32x4 o0, o1;
#pragma unroll
                    for (int e = 0; e < 4; ++e) { o0[e] = y0[e] * sigm(acc[ai][bj][m][0][e] + bb[bj][0][e]); o1[e] = y1[e] * sigm(acc[ai][bj][m][1][e] + bb[bj][1][e]); }
                    *(u32x4*)(YY + (size_t)row * 768 + col) = pack8(o0, o1);
                }
            }
        }
    }
};
struct EpiGateScale {
    static constexpr bool PERM = true, AFTER_DRAIN = false;
    const bf16_t* G; bf16_t* T;
    DI void operator()(const f32x4 (&acc)[2][2][4][2], const Unit& u, int wr, int wc, int fr, int fq) const {
        const int row0 = u.pm * 256 + wr * 64 + fr;
#pragma unroll
        for (int ai = 0; ai < 2; ++ai) {
            u32x4 gw[2][4][2];
            SCHED_FENCE();
#pragma unroll
            for (int m = 0; m < 4; ++m)
#pragma unroll
                for (int bj = 0; bj < 2; ++bj) gw[ai][m][bj] = *(const u32x4*)(G + (size_t)(row0 + ai * 128 + m * 16) * 2048 + 1024 + u.pn * 256 + bj * 128 + wc * 32 + 8 * fq);
            SCHED_FENCE();
#pragma unroll
            for (int m = 0; m < 4; ++m) {
                const int row = row0 + ai * 128 + m * 16;
#pragma unroll
                for (int bj = 0; bj < 2; ++bj) { const int col = u.pn * 256 + bj * 128 + wc * 32 + 8 * fq;
                    f32x4 a0, a1; unpack8(gw[ai][m][bj], a0, a1);
                    *(u32x4*)(T + (size_t)row * DM + col) = pack8(a0 * acc[ai][bj][m][0], a1 * acc[ai][bj][m][1]); }
            }
        }
    }
};
struct EpiMix2 {
    static constexpr bool PERM = true, AFTER_DRAIN = false;
    const bf16_t* G; const bf16_t* T; bf16_t* O;
    DI void operator()(const f32x4 (&acc)[2][2][4][2], const Unit& u, int wr, int wc, int fr, int fq) const {
        const int row0 = u.pm * 256 + wr * 64 + fr;
#pragma unroll
        for (int ai = 0; ai < 2; ++ai)
#pragma unroll
        for (int mh = 0; mh < 4; mh += 2) {
            u32x4 gw[4][2], tw[4][2];
            SCHED_FENCE();
#pragma unroll
            for (int m = mh; m < mh + 2; ++m)
#pragma unroll
                for (int bj = 0; bj < 2; ++bj) { const int row = row0 + ai * 128 + m * 16, col = u.pn * 256 + bj * 128 + wc * 32 + 8 * fq;
                    gw[m][bj] = *(const u32x4*)(G + (size_t)row * 2048 + col); tw[m][bj] = *(const u32x4*)(T + (size_t)row * DM + col); }
            SCHED_FENCE();
#pragma unroll
            for (int m = mh; m < mh + 2; ++m) {
                const int row = row0 + ai * 128 + m * 16;
#pragma unroll
                for (int bj = 0; bj < 2; ++bj) { const int col = u.pn * 256 + bj * 128 + wc * 32 + 8 * fq;
                    f32x4 s0, s1, t0, t1; unpack8(gw[m][bj], s0, s1); unpack8(tw[m][bj], t0, t1);
                    *(u32x4*)(O + (size_t)row * DM + col) = pack8(s0 * acc[ai][bj][m][0] + t0, s1 * acc[ai][bj][m][1] + t1); }
            }
        }
    }
};

#define MFMA32(a, b, c) __builtin_amdgcn_mfma_f32_32x32x16_bf16((a), (b), (c), 0, 0, 0)
#define MFMA16(a, b, c) __builtin_amdgcn_mfma_f32_16x16x32_bf16((a), (b), (c), 0, 0, 0)
DI bf16x8 frag_from_f32(f32x4 a, f32x4 b) { return __builtin_bit_cast(bf16x8, pack8(a, b)); }

struct ProvBf16 { const bf16_t* A; int ld; static constexpr bool SQ = false; static constexpr int BATCH = 11;
    struct Raw { bf16x8 v; };
    DI Raw load(int r, int k) const { Raw w; w.v = *(const bf16x8*)(A + (size_t)r * ld + k); return w; }
    DI bf16x8 cvt(const Raw& w, float&) const { return w.v; } };
struct ProvAct { const float* raw; static constexpr bool SQ = false; static constexpr int BATCH = 4;
    struct Raw { f32x4 g0, g1, u0, u1; };
    DI Raw load(int r, int k) const { const float* p = raw + (size_t)r * 5632 + 256 * (k >> 7) + (k & 127); Raw w; w.g0 = *(const f32x4*)p; w.g1 = *(const f32x4*)(p + 4); w.u0 = *(const f32x4*)(p + 128); w.u1 = *(const f32x4*)(p + 132); return w; }
    DI bf16x8 cvt(const Raw& w, float&) const { f32x4 a, b;
#pragma unroll
        for (int e = 0; e < 4; ++e) { a[e] = silu(w.g0[e]) * w.u0[e]; b[e] = silu(w.g1[e]) * w.u1[e]; }
        return frag_from_f32(a, b); } };
template <bool HASO> struct ProvX { const float* xs; const float* rawd; const float* rawo; static constexpr bool SQ = true; static constexpr int BATCH = 2;
    struct Raw { f32x4 x0, x1, d0, d1, o0, o1; };
    DI Raw load(int r, int k) const { const size_t o = (size_t)r * DM + k; Raw w; w.x0 = *(const f32x4*)(xs + o); w.x1 = *(const f32x4*)(xs + o + 4); w.d0 = *(const f32x4*)(rawd + o); w.d1 = *(const f32x4*)(rawd + o + 4);
        if (HASO) { w.o0 = *(const f32x4*)(rawo + o); w.o1 = *(const f32x4*)(rawo + o + 4); } return w; }
    DI bf16x8 cvt(const Raw& w, float& ss) const { f32x4 a = w.x0 + w.d0 * 0.5f, b = w.x1 + w.d1 * 0.5f; if (HASO) { a += w.o0; b += w.o1; }
        ss += (a[0] * a[0] + a[1] * a[1]) + (a[2] * a[2] + a[3] * a[3]) + (b[0] * b[0] + b[1] * b[1]) + (b[2] * b[2] + b[3] * b[3]);
        return frag_from_f32(a, b); } };
struct ProvYY { const bf16_t* YG; const float* rawglu; const float* bias; const bf16_t* YY; static constexpr bool SQ = false; static constexpr int BATCH = 3;
    struct Raw { u32x4 y; f32x4 z0, z1, b0, b1; };
    DI Raw load(int r, int k) const { Raw w; const f32x4 z = {0.f, 0.f, 0.f, 0.f}; w.z0 = z; w.z1 = z; w.b0 = z; w.b1 = z;
        if (k >= 512) { w.y = *(const u32x4*)(YY + (size_t)(NPR + r) * 768 + k); }
        else { w.y = *(const u32x4*)(YG + (size_t)(NPR + r) * 512 + k); w.z0 = *(const f32x4*)(rawglu + r * 512 + k); w.z1 = *(const f32x4*)(rawglu + r * 512 + k + 4); w.b0 = *(const f32x4*)(bias + k); w.b1 = *(const f32x4*)(bias + k + 4); }
        return w; }
    DI bf16x8 cvt(const Raw& w, float&, int k) const { return __builtin_bit_cast(bf16x8, w.y); }
    DI bf16x8 cvt(const Raw& w, float&) const { return __builtin_bit_cast(bf16x8, w.y); }
    DI bf16x8 cvtk(const Raw& w, int k) const {
        if (k >= 512) return __builtin_bit_cast(bf16x8, w.y);
        f32x4 y0, y1; unpack8(w.y, y0, y1); f32x4 a, b;
#pragma unroll
        for (int e = 0; e < 4; ++e) { a[e] = y0[e] * sigm(w.z0[e] + w.b0[e]); b[e] = y1[e] * sigm(w.z1[e] + w.b1[e]); }
        return frag_from_f32(a, b); } };
struct ProvMixed { const float* raw3; const float* rawms; const float* rawma; static constexpr bool SQ = false; static constexpr int BATCH = 2;
    struct Raw { f32x4 s0, s1, a0, a1, m0, m1, n0, n1; };
    DI Raw load(int r, int k) const { const float* gs = raw3 + (size_t)r * INW + l2p(2816 + k); const float* ga = raw3 + (size_t)r * INW + l2p(3840 + k);
        Raw w; w.s0 = *(const f32x4*)gs; w.s1 = *(const f32x4*)(gs + 4); w.a0 = *(const f32x4*)ga; w.a1 = *(const f32x4*)(ga + 4);
        w.m0 = *(const f32x4*)(rawms + r * DM + k); w.m1 = *(const f32x4*)(rawms + r * DM + k + 4); w.n0 = *(const f32x4*)(rawma + r * DM + k); w.n1 = *(const f32x4*)(rawma + r * DM + k + 4); return w; }
    DI bf16x8 cvt(const Raw& w, float&) const { f32x4 a, b;
#pragma unroll
        for (int e = 0; e < 4; ++e) { a[e] = sigm(w.s0[e]) * w.m0[e] + sigm(w.a0[e]) * w.n0[e]; b[e] = sigm(w.s1[e]) * w.m1[e] + sigm(w.a1[e]) * w.n1[e]; }
        return frag_from_f32(a, b); } };
template <class P> struct ProvTraits { static constexpr bool NEEDK = false; };
template <> struct ProvTraits<ProvYY> { static constexpr bool NEEDK = true; };
struct SEpiRaw { float* dst; int ld; DI void operator()(int row, int col, float v, float) const { dst[(size_t)row * ld + col] = v; } };
struct SEpiRawScaled { float* dst; int ld; DI void operator()(int row, int col, float v, float rs) const { dst[(size_t)row * ld + col] = v * rs; } };
struct SEpiGluS { const bf16_t* YG; const float* bias; bf16_t* dst; DI void operator()(int row, int col, float v, float) const { dst[row * 512 + col] = f2bf(bf2f(YG[(size_t)(NPR + row) * 512 + col]) * sigm(v + bias[col])); } };
struct SEpiMixS { const float* raw3; const float* rawma; bf16_t* dst; DI void operator()(int row, int col, float v, float) const {
    const float gs = sigm(raw3[(size_t)row * INW + l2p(2816 + col)]), ga = sigm(raw3[(size_t)row * INW + l2p(3840 + col)]); dst[row * DM + col] = f2bf(gs * v + ga * rawma[row * DM + col]); } };
struct SEpiFinal { const float* xs; const float* rawd; const float* rawo; float* out; DI void operator()(int row, int col, float v, float) const { const size_t o = (size_t)row * DM + col; out[o] = xs[o] + 0.5f * rawd[o] + rawo[o] + 0.5f * v; } };

template <int N, int K, class Prov, class SEpi>
DI void skinny_phase(LAS unsigned char* lds, const bf16_t* Bt, const Prov& P, const SEpi& E) {
    const int tid = otid(), wave = tid >> 6, lane = tid & 63, r = lane & 31, hh = lane >> 5, G = gridDim.x;
    LAS float* red = (LAS float*)lds;
    LAS float* sqp = (LAS float*)(lds + 32768);
    LAS float* rsd = (LAS float*)(lds + 32768 + 2048);
    constexpr int ntiles = N / 32, kper = K / 8, NIT = kper / 32, BATCH = Prov::BATCH;
    for (int tile = G - 1 - (int)blockIdx.x; tile < ntiles; tile += G) {
        const int n0 = tile * 32;
        f32x16 acc = {};
        float ss = 0.f;
        const bf16_t* bp = Bt + (size_t)(n0 + r) * K + wave * kper + 16 * hh;
        const int kbase = wave * kper + 16 * hh;
#pragma unroll
        for (int i0 = 0; i0 < NIT; i0 += BATCH) {
            typename Prov::Raw ra[BATCH][2]; bf16x8 rb[BATCH][2];
            SCHED_FENCE();
#pragma unroll
            for (int u = 0; u < BATCH; ++u) if (i0 + u < NIT) { const int k = kbase + 32 * (i0 + u);
                ra[u][0] = P.load(r, k); ra[u][1] = P.load(r, k + 8); rb[u][0] = *(const bf16x8*)(bp + 32 * (i0 + u)); rb[u][1] = *(const bf16x8*)(bp + 32 * (i0 + u) + 8); }
            SCHED_FENCE();
#pragma unroll
            for (int u = 0; u < BATCH; ++u) if (i0 + u < NIT) { const int k = kbase + 32 * (i0 + u);
                bf16x8 a0, a1;
                if constexpr (ProvTraits<Prov>::NEEDK) { a0 = P.cvtk(ra[u][0], k); a1 = P.cvtk(ra[u][1], k + 8); } else { a0 = P.cvt(ra[u][0], ss); a1 = P.cvt(ra[u][1], ss); }
                acc = MFMA32(a0, rb[u][0], acc); acc = MFMA32(a1, rb[u][1], acc); }
        }
#pragma unroll
        for (int i = 0; i < 16; ++i) red[wave * 1024 + ((i & 3) + 8 * (i >> 2) + 4 * hh) * 32 + r] = acc[i];
        if (Prov::SQ) sqp[(wave * 2 + hh) * 32 + r] = ss;
        __syncthreads();
        if (Prov::SQ) { if (tid < 32) { float sm = 0.f; for (int j = 0; j < 16; ++j) sm += sqp[j * 32 + tid]; rsd[tid] = rsqrtf(sm * (1.f / 1024.f) + EPS); } __syncthreads(); }
#pragma unroll
        for (int h2 = 0; h2 < 2; ++h2) { const int e = tid + 512 * h2; float sm = 0.f;
#pragma unroll
            for (int w = 0; w < 8; ++w) sm += red[w * 1024 + e];
            E(e >> 5, n0 + (e & 31), sm, Prov::SQ ? rsd[e >> 5] : 1.f); }
        __syncthreads();
    }
}

template <int K, class Prov>
DI void skinny_gu_phase(LAS unsigned char* lds, const bf16_t* Bt, const Prov& P, bf16_t* act) {
    const int tid = otid(), wave = tid >> 6, lane = tid & 63, r = lane & 31, hh = lane >> 5, G = gridDim.x;
    LAS float* red = (LAS float*)lds;
    LAS float* sqp = (LAS float*)(lds + 32768);
    LAS float* rsd = (LAS float*)(lds + 32768 + 2048);
    constexpr int ntiles = FF / 16, kper = K / 8, NIT = kper / 32, BATCH = Prov::BATCH;
    for (int tile = G - 1 - (int)blockIdx.x; tile < ntiles; tile += G) {
        f32x16 acc = {};
        float ss = 0.f;
        const int brow = 256 * (tile >> 3) + 16 * (tile & 7) + (r < 16 ? r : 112 + r);
        const bf16_t* bp = Bt + (size_t)brow * K + wave * kper + 16 * hh;
        const int kbase = wave * kper + 16 * hh;
#pragma unroll
        for (int i0 = 0; i0 < NIT; i0 += BATCH) {
            typename Prov::Raw ra[BATCH][2]; bf16x8 rb[BATCH][2];
            SCHED_FENCE();
#pragma unroll
            for (int u = 0; u < BATCH; ++u) if (i0 + u < NIT) { const int k = kbase + 32 * (i0 + u);
                ra[u][0] = P.load(r, k); ra[u][1] = P.load(r, k + 8); rb[u][0] = *(const bf16x8*)(bp + 32 * (i0 + u)); rb[u][1] = *(const bf16x8*)(bp + 32 * (i0 + u) + 8); }
            SCHED_FENCE();
#pragma unroll
            for (int u = 0; u < BATCH; ++u) if (i0 + u < NIT) {
                const bf16x8 a0 = P.cvt(ra[u][0], ss), a1 = P.cvt(ra[u][1], ss);
                acc = MFMA32(a0, rb[u][0], acc); acc = MFMA32(a1, rb[u][1], acc); }
        }
#pragma unroll
        for (int i = 0; i < 16; ++i) red[wave * 1024 + ((i & 3) + 8 * (i >> 2) + 4 * hh) * 32 + r] = acc[i];
        if (Prov::SQ) sqp[(wave * 2 + hh) * 32 + r] = ss;
        __syncthreads();
        if (Prov::SQ) { if (tid < 32) { float sm = 0.f; for (int j = 0; j < 16; ++j) sm += sqp[j * 32 + tid]; rsd[tid] = rsqrtf(sm * (1.f / 1024.f) + EPS); } __syncthreads(); }
        { const int row = tid >> 4, c = tid & 15; float sg = 0.f, su = 0.f;
#pragma unroll
          for (int w = 0; w < 8; ++w) { sg += red[w * 1024 + row * 32 + c]; su += red[w * 1024 + row * 32 + 16 + c]; }
          const float rs = Prov::SQ ? rsd[row] : 1.f;
          act[(size_t)row * FF + 16 * tile + c] = f2bf(silu(sg * rs) * (su * rs)); }
        __syncthreads();
    }
}

DI int maprow(int mode, int c0) {
    if (mode == 0) return c0;
    if (mode == 1) return 256 * (c0 >> 7) + (c0 & 127);
    if (mode == 2) return 256 * (c0 >> 7) + 128 + (c0 & 127);
    return (c0 & ~255) | (((c0 >> 5) & 1) << 7) | (((c0 >> 6) & 3) << 5);
}
DI void tr_item(const float* W, int N, const float* g, bf16_t* dst, int ldd, int kofs, int mode, int item, LAS float* scr, int lane) {
    const int nblk = N / 32, kb = item / nblk, nb = item % nblk, k0 = 64 * kb, c0 = 32 * nb, p0 = maprow(mode, c0);
    const int kr = lane >> 3, c4 = lane & 7;
    f32x4 v[8];
#pragma unroll
    for (int i = 0; i < 8; ++i) v[i] = *(const f32x4*)(W + (size_t)(k0 + 8 * i + kr) * N + c0 + 4 * c4);
    if (g) {
#pragma unroll
        for (int i = 0; i < 8; ++i) v[i] = v[i] * g[k0 + 8 * i + kr];
    }
#pragma unroll
    for (int i = 0; i < 8; ++i) { LAS float* sp = scr + (8 * i + kr) * 33 + 4 * c4; sp[0] = v[i][0]; sp[1] = v[i][1]; sp[2] = v[i][2]; sp[3] = v[i][3]; }
    LDS_WAIT();
    const int c = lane & 7;
#pragma unroll
    for (int j = 0; j < 4; ++j) { const int n = (lane >> 3) + 8 * j; const LAS float* sq = scr + (8 * c) * 33 + n;
        u32x4 o; o.x = pk2(sq[0 * 33], sq[1 * 33]); o.y = pk2(sq[2 * 33], sq[3 * 33]); o.z = pk2(sq[4 * 33], sq[5 * 33]); o.w = pk2(sq[6 * 33], sq[7 * 33]);
        *(u32x4*)(dst + (size_t)(p0 + n) * ldd + kofs + k0 + 8 * c) = o; }
    LDS_WAIT();
}
DI void norm_rows2_bf16(const float* x0, const float* x1, const float* g, bf16_t* o0, bf16_t* o1, int lane) {
    const f32x4* xr0 = (const f32x4*)x0 + lane; const f32x4* xr1 = (const f32x4*)x1 + lane; const f32x4* gr = (const f32x4*)g + lane;
    f32x4 v[2][4]; float s0 = 0.f, s1 = 0.f;
#pragma unroll
    for (int j = 0; j < 4; ++j) { v[0][j] = xr0[64 * j]; v[1][j] = xr1[64 * j]; }
    SCHED_FENCE();
#pragma unroll
    for (int j = 0; j < 4; ++j) { s0 += (v[0][j][0] * v[0][j][0] + v[0][j][1] * v[0][j][1]) + (v[0][j][2] * v[0][j][2] + v[0][j][3] * v[0][j][3]); s1 += (v[1][j][0] * v[1][j][0] + v[1][j][1] * v[1][j][1]) + (v[1][j][2] * v[1][j][2] + v[1][j][3] * v[1][j][3]); }
    const float r0 = rsqrtf(wave_sum(s0) * (1.f / 1024.f) + EPS), r1 = rsqrtf(wave_sum(s1) * (1.f / 1024.f) + EPS);
    u32x2* p0 = (u32x2*)o0 + lane; u32x2* p1 = (u32x2*)o1 + lane;
#pragma unroll
    for (int j = 0; j < 4; ++j) { const f32x4 gg = gr[64 * j]; const f32x4 w0 = v[0][j] * r0 * gg, w1 = v[1][j] * r1 * gg; u32x2 a, b; a.x = pk2(w0[0], w0[1]); a.y = pk2(w0[2], w0[3]); b.x = pk2(w1[0], w1[1]); b.y = pk2(w1[2], w1[3]); p0[64 * j] = a; p1[64 * j] = b; }
}

constexpr int KVR0 = 32 * 127, KVR1 = KVR0 + 32 * 511, KVR_ALL = KVR1 + 32 * 2047;
constexpr int KVQ = 4;
constexpr int KV_TAIL_P10 = 19984, KV_TAIL_P3 = 8592, KV_TAIL_ROWS = KV_TAIL_P10 + KV_TAIL_P3;
struct KvCopy { f32x4 t[KVQ][2]; f32x4* dp[KVQ]; };
template <int NQ> DI void kv_issue(KvCopy& k, const float* c0, const float* c1, const float* c2, float* out, int rowbase, int slot, int lane) {
#pragma unroll
    for (int q = 0; q < NQ; ++q) {
        const int R0 = rowbase + NQ * slot + q; const int R = R0 < KVR_ALL ? R0 : KVR_ALL - 1;
        const int g = R < KVR0 ? 0 : (R < KVR1 ? 1 : 2); const int Rl = R - (g == 0 ? 0 : (g == 1 ? KVR0 : KVR1));
        const int w = g == 0 ? 128 : (g == 1 ? 512 : 2048), wm1 = w - 1; const int b = g == 0 ? Rl / 127 : (g == 1 ? Rl / 511 : Rl / 2047), r = Rl - b * wm1;
        const f32x4* sp = (const f32x4*)(g == 0 ? c0 : (g == 1 ? c1 : c2)) + ((size_t)b * w + r + 1) * 128 + lane;
        f32x4* d = (f32x4*)(out + (g == 0 ? O_KVS0 : (g == 1 ? O_KVS1 : O_KVS2))) + ((size_t)b * w + r) * 128 + lane;
        k.dp[q] = R0 < KVR_ALL ? d : nullptr;
        k.t[q][0] = __builtin_nontemporal_load(sp); k.t[q][1] = __builtin_nontemporal_load(sp + 64);
    }
}
template <int NQ> DI void kv_commit(const KvCopy& k) {
#pragma unroll
    for (int q = 0; q < NQ; ++q) if (k.dp[q]) { __builtin_nontemporal_store(k.t[q][0], k.dp[q]); __builtin_nontemporal_store(k.t[q][1], k.dp[q] + 64); }
}

struct SsmPar { float abr, abi, fr, fi; };
DI SsmPar ssm_par(const float* a_re, const float* a_im, const float* log_dt, int g, int p) {
    const float ar = a_re[g * 64 + p], ai = a_im[g * 64 + p], dt = expf(log_dt[g]);
    const float mag = expf(ar * dt); SsmPar o; o.abr = mag * cosf(ai * dt); o.abi = mag * sinf(ai * dt);
    const float inv = 1.0f / (ar * ar + ai * ai);
    o.fr = ((o.abr - 1.0f) * ar + o.abi * ai) * inv; o.fi = (o.abi * ar - (o.abr - 1.0f) * ai) * inv; return o;
}
struct SsmIn { const float *a_re, *a_im, *log_dt, *b_re, *b_im, *c_re, *c_im, *dsk; };

constexpr size_t WS_SSMT = 576 * 1024, SSMT_TC = 32 * 8 * 64 * 16, SSMT_TA = SSMT_TC + 32 * 4 * 64 * 16;
DI void ssm_build_tables(const SsmIn& W, unsigned char* tb, int g, int lane) {
    const int l15 = lane & 15, quad = lane >> 4;
    { const SsmPar sp = ssm_par(W.a_re, W.a_im, W.log_dt, g, lane); f32x2 ab = {sp.abr, sp.abi}; ((f32x2*)(tb + SSMT_TA))[g * 64 + lane] = ab; }
#pragma unroll
    for (int nt = 0; nt < 8; ++nt) {
        const int p = 8 * nt + (l15 >> 1), ri = l15 & 1; const SsmPar sp = ssm_par(W.a_re, W.a_im, W.log_dt, g, p);
        f32x4 v0 = {0, 0, 0, 0}, v1 = v0;
        if (quad < 2) { const float* br = W.b_re + ((size_t)(g * 64 + p)) * 16 + 8 * quad; const float* bi = W.b_im + ((size_t)(g * 64 + p)) * 16 + 8 * quad;
            const f32x4 r0 = *(const f32x4*)br, r1 = *(const f32x4*)(br + 4), i0 = *(const f32x4*)bi, i1 = *(const f32x4*)(bi + 4);
            if (ri == 0) { v0 = r0 * sp.fr - i0 * sp.fi; v1 = r1 * sp.fr - i1 * sp.fi; } else { v0 = i0 * sp.fr + r0 * sp.fi; v1 = i1 * sp.fr + r1 * sp.fi; } }
        ((bf16x8*)tb)[(g * 8 + nt) * 64 + lane] = frag_from_f32(v0, v1);
    }
#pragma unroll
    for (int s2 = 0; s2 < 4; ++s2) { const int p0 = 16 * s2 + 4 * quad; const float* cr = W.c_re + ((size_t)(g * 16 + l15)) * 64 + p0; const float* ci = W.c_im + ((size_t)(g * 16 + l15)) * 64 + p0;
        const f32x4 r = *(const f32x4*)cr, i = *(const f32x4*)ci;
        const f32x4 c0 = {r[0], -i[0], r[1], -i[1]}, c1 = {r[2], -i[2], r[3], -i[3]};
        ((bf16x8*)(tb + SSMT_TC))[(g * 4 + s2) * 64 + lane] = frag_from_f32(c0, c1); }
}
struct KvSrc { const float *c0, *c1, *c2; float* out; int slotbase; };

DI void kvshift_rows(const float* c0, const float* c1, const float* c2, float* out, int r_lo, int r_hi, int wk, int nwk, int wave, int lane) {
    const int stride = nwk * 8;
    for (int R0 = r_lo + wk * 8 + wave; R0 < r_hi; R0 += 8 * stride) {
        f32x4 t[8][2]; f32x4* dp[8];
#pragma unroll
        for (int q = 0; q < 8; ++q) {
            int R = R0 + q * stride; R = R < r_hi ? R : r_hi - 1;
            const int g = R < KVR0 ? 0 : (R < KVR1 ? 1 : 2); const int Rl = R - (g == 0 ? 0 : (g == 1 ? KVR0 : KVR1));
            const int w = g == 0 ? 128 : (g == 1 ? 512 : 2048), wm1 = w - 1; const int b = g == 0 ? Rl / 127 : (g == 1 ? Rl / 511 : Rl / 2047), r = Rl - b * wm1;
            const f32x4* sp = (const f32x4*)(g == 0 ? c0 : (g == 1 ? c1 : c2)) + ((size_t)b * w + r + 1) * 128 + lane;
            dp[q] = (f32x4*)(out + (g == 0 ? O_KVS0 : (g == 1 ? O_KVS1 : O_KVS2))) + ((size_t)b * w + r) * 128 + lane;
            t[q][0] = __builtin_nontemporal_load(sp); t[q][1] = __builtin_nontemporal_load(sp + 64);
        }
        SCHED_FENCE();
#pragma unroll
        for (int q = 0; q < 8; ++q) if (R0 + q * stride < r_hi) { __builtin_nontemporal_store(t[q][0], dp[q]); __builtin_nontemporal_store(t[q][1], dp[q] + 64); }
    }
}
DI void kvshift_tail(const float* c0, const float* c1, const float* c2, float* out, int nwg, int r_lo, int r_hi, int wave, int lane) {
    const int G = gridDim.x; const int first = nwg % G; const int wk = (int)blockIdx.x - first;
    if (wk >= 0) kvshift_rows(c0, c1, c2, out, r_lo, r_hi, wk, G - first, wave, lane);
}
template <bool PASS2>
DI void ssm_pass(LAS unsigned char* lds, const SsmIn& W, const unsigned char* TBL, const bf16_t* U, float* SEND, const float* SIN, bf16_t* YG, const KvSrc& KS, int vblk, int vG) {
    const int tid = otid(), wave = tid >> 6, lane = tid & 63, l15 = lane & 15, quad = lane >> 4;
    LAS float* Xs = (LAS float*)(lds + wave * 13312);
    LAS bf16_t* Ss = (LAS bf16_t*)(lds + wave * 13312 + 8448);
    LAS bf16_t* Us = (LAS bf16_t*)(lds + wave * 13312 + 12800);
    const int NGW = vG * 8, gw = vblk * 8 + wave;
    int gcur = -1; bf16x8 bfr[8]; bf16x8 cfr[4]; float abr = 0.f, abi = 0.f, dk = 0.f;
    for (int it = gw; it < 2 * NCH * 32; it += NGW) {
        const int g = it & 31, bc = it >> 5, b = bc >> 7, ch = bc & 127;
        KvCopy kc; kv_issue<2>(kc, KS.c0, KS.c1, KS.c2, KS.out, KS.slotbase, it, lane);
        const int rowc = b * SEQ + ch * TCH;
        bf16x8 uf[4];
#pragma unroll
        for (int sub = 0; sub < 4; ++sub) { uf[sub] = (bf16x8){0, 0, 0, 0, 0, 0, 0, 0}; if (quad < 2) uf[sub] = *(const bf16x8*)(U + (size_t)(rowc + 16 * sub + l15) * 512 + 16 * g + 8 * quad); }
        float sr = 0.f, si = 0.f;
        const size_t sbase = ((size_t)(b * NCH + ch) * 32 + g) * 128;
        if (PASS2) { sr = SIN[sbase + lane]; si = SIN[sbase + 64 + lane]; }
        __builtin_amdgcn_sched_barrier(0);
        if (g != gcur) {
            gcur = g;
            { const f32x2 ab = ((const f32x2*)(TBL + SSMT_TA))[g * 64 + lane]; abr = ab[0]; abi = ab[1]; }
#pragma unroll
            for (int q = 0; q < 8; ++q) bfr[q] = ((const bf16x8*)TBL)[(g * 8 + q) * 64 + lane];
            if (PASS2) {
#pragma unroll
                for (int s2 = 0; s2 < 4; ++s2) cfr[s2] = ((const bf16x8*)(TBL + SSMT_TC))[(g * 4 + s2) * 64 + lane];
                dk = W.dsk[g * 16 + l15];
            }
        }
#pragma unroll
        for (int sub = 0; sub < 4; ++sub) {
            const int row0 = rowc + 16 * sub;
            if (PASS2) { if (quad < 2) *(LAS bf16x8*)(Us + l15 * 16 + 8 * quad) = uf[sub]; }
#pragma unroll
            for (int nt = 0; nt < 8; ++nt) { f32x4 x = {0.f, 0.f, 0.f, 0.f}; x = MFMA16(uf[sub], bfr[nt], x);
#pragma unroll
                for (int j = 0; j < 4; ++j) Xs[(4 * quad + j) * 132 + 16 * nt + l15] = x[j]; }
            LDS_WAIT();
#pragma unroll
            for (int tok = 0; tok < 16; ++tok) {
                const f32x2 xx = *(const LAS f32x2*)(Xs + tok * 132 + 2 * lane);
                const float nr = abr * sr - abi * si + xx[0], ni = abr * si + abi * sr + xx[1]; sr = nr; si = ni;
                if (PASS2) *(LAS unsigned*)(Ss + tok * 136 + 2 * lane) = pk2(sr, si);
            }
            LDS_WAIT();
            if (PASS2) {
                f32x4 y = {0.f, 0.f, 0.f, 0.f};
#pragma unroll
                for (int s2 = 0; s2 < 4; ++s2) { const bf16x8 af = *(const LAS bf16x8*)(Ss + l15 * 136 + 32 * s2 + 8 * quad); y = MFMA16(af, cfr[s2], y); }
#pragma unroll
                for (int j = 0; j < 4; ++j) { const float uv = bf2f(Us[(4 * quad + j) * 16 + l15]); YG[(size_t)(row0 + 4 * quad + j) * 512 + 16 * g + l15] = f2bf(gelu_tanh(y[j] + dk * uv)); }
                LDS_WAIT();
            }
        }
        if (!PASS2) { SEND[sbase + lane] = sr; SEND[sbase + 64 + lane] = si; }
        kv_commit<2>(kc);
    }
}

DI void ssm_carry(const SsmIn& W, const float* SEND, float* SIN, float* out_re, float* out_im, int vblk, int vG) {
    for (int gt = vblk * 512 + otid(); gt < 2 * 32 * 64; gt += vG * 512) {
        const int b = gt >> 11, g = (gt >> 6) & 31, p = gt & 63;
        const SsmPar sp = ssm_par(W.a_re, W.a_im, W.log_dt, g, p);
        float tr = sp.abr, ti = sp.abi;
#pragma unroll
        for (int i = 0; i < 6; ++i) { const float nr = tr * tr - ti * ti, ni = 2.f * tr * ti; tr = nr; ti = ni; }
        float sr = 0.f, si = 0.f;
        for (int c0 = 0; c0 < NCH; c0 += 32) {
            float er[32], ei[32];
#pragma unroll
            for (int j = 0; j < 32; ++j) { const size_t o = ((size_t)(b * NCH + c0 + j) * 32 + g) * 128; er[j] = SEND[o + p]; ei[j] = SEND[o + 64 + p]; }
            SCHED_FENCE();
#pragma unroll
            for (int j = 0; j < 32; ++j) { const size_t o = ((size_t)(b * NCH + c0 + j) * 32 + g) * 128; SIN[o + p] = sr; SIN[o + 64 + p] = si;
                const float nr = tr * sr - ti * si + er[j], ni = tr * si + ti * sr + ei[j]; sr = nr; si = ni; }
        }
        out_re[gt] = sr; out_im[gt] = si;
    }
}

DI void attn_unit(int b, int g, int h, int dl, int rho, int m0, const bf16_t* Q, const bf16_t* K, const bf16_t* V, bf16_t* OG, float* ML, LAS bf16_t* Vs, int lane) {
    const int r = lane & 31, hh = lane >> 5; const int rowb = b * SEQ; const int co = g * 256 + h * 64;
    const int rowq = rowb + rho + ((m0 + r) << dl);
    bf16x8 qf[4]; bf16x8 kf[5][4];
    { const bf16x8* qp = (const bf16x8*)(Q + (size_t)rowq * 768 + co + 32 * hh);
#pragma unroll
      for (int s = 0; s < 4; ++s) qf[s] = qp[s]; }
#pragma unroll
    for (int kb = 0; kb < 5; ++kb) {
        int mk = m0 - 128 + 32 * kb + r; mk = mk < 0 ? 0 : mk;
        const bf16x8* kp = (const bf16x8*)(K + (size_t)(rowb + rho + (mk << dl)) * 768 + co + 32 * hh);
#pragma unroll
        for (int s = 0; s < 4; ++s) kf[kb][s] = kp[s];
    }
    const bf16_t* vbase = V + (size_t)(rowb + rho) * 768 + co + 8 * (lane & 7);
    u32x4 vreg[4];
#define ATT_VLOAD(kb_) do { _Pragma("unroll") for (int i_ = 0; i_ < 4; ++i_) { int kidx_ = m0 - 128 + 32 * (kb_) + 8 * i_ + (lane >> 3); kidx_ = kidx_ < 0 ? 0 : kidx_; \
        vreg[i_] = *(const u32x4*)(vbase + (size_t)(kidx_ << dl) * 768); } } while (0)
#define ATT_VSTORE(buf_) do { _Pragma("unroll") for (int i_ = 0; i_ < 4; ++i_) *(LAS u32x4*)(Vs + (buf_) * 2304 + (8 * i_ + (lane >> 3)) * 72 + 8 * (lane & 7)) = vreg[i_]; } while (0)
    SCHED_FENCE();
    f32x16 st[5];
#pragma unroll
    for (int kb = 0; kb < 5; ++kb) {
        f32x16 a = {};
#pragma unroll
        for (int s = 0; s < 4; ++s) a = MFMA32(kf[kb][s], qf[s], a);
        st[kb] = a;
    }
    SCHED_FENCE();
    ATT_VLOAD(0);
    SCHED_FENCE();
    float mx = -INFINITY; const bool early = m0 < 128;
#pragma unroll
    for (int kb = 0; kb < 5; ++kb)
#pragma unroll
        for (int i = 0; i < 16; ++i) {
            const int c = (i & 3) + 8 * (i >> 2) + 4 * hh; const int kidx = m0 - 128 + 32 * kb + c; const int j = r + 128 - 32 * kb - c;
            float v = st[kb][i];
            if (kb == 0) v = (j <= 128) ? v : -INFINITY;
            if (kb == 4) v = (j >= 0) ? v : -INFINITY;
            if (early) v = (kidx >= 0) ? v : -INFINITY;
            st[kb][i] = v; mx = fmaxf(mx, v);
        }
    mx = fmaxf(mx, __shfl_xor(mx, 32));
    float den = 0.f;
#pragma unroll
    for (int kb = 0; kb < 5; ++kb)
#pragma unroll
        for (int i = 0; i < 16; ++i) { const float p = __builtin_amdgcn_exp2f(st[kb][i] - mx); st[kb][i] = p; den += p; }
    den += __shfl_xor(den, 32);
    SCHED_FENCE();
    ATT_VSTORE(0);
    ATT_VLOAD(1);
    SCHED_FENCE();
    f32x16 ot[2] = {{}, {}};
#pragma unroll
    for (int kb = 0; kb < 5; ++kb) {
        LDS_WAIT();
#pragma unroll
        for (int c = 0; c < 2; ++c) {
            f32x4 p0, p1;
#pragma unroll
            for (int e = 0; e < 4; ++e) { p0[e] = st[kb][8 * c + e]; p1[e] = st[kb][8 * c + 4 + e]; }
            const bf16x8 pf = frag_from_f32(p0, p1);
#pragma unroll
            for (int db = 0; db < 2; ++db) {
                bf16x8 vf;
#pragma unroll
                for (int jj = 0; jj < 8; ++jj) vf[jj] = (short)Vs[(kb & 1) * 2304 + (16 * c + 8 * (jj >> 2) + 4 * hh + (jj & 3)) * 72 + 32 * db + r];
                ot[db] = MFMA32(vf, pf, ot[db]);
            }
        }
        SCHED_FENCE();
        if (kb < 4) { ATT_VSTORE((kb + 1) & 1); if (kb < 3) ATT_VLOAD(kb + 2); }
        SCHED_FENCE();
    }
    LDS_WAIT();
#undef ATT_VLOAD
#undef ATT_VSTORE
    const float inv = 1.0f / den;
    bf16_t* op = OG + ((size_t)g * MT + rowq) * 256 + h * 64;
#pragma unroll
    for (int db = 0; db < 2; ++db)
#pragma unroll
        for (int ig = 0; ig < 4; ++ig) { u32x2 w; w.x = pk2(ot[db][4 * ig] * inv, ot[db][4 * ig + 1] * inv); w.y = pk2(ot[db][4 * ig + 2] * inv, ot[db][4 * ig + 3] * inv);
            *(u32x2*)(op + 32 * db + 8 * ig + 4 * hh) = w; }
    if (hh == 0) { f32x2 ml = {mx, den}; *(f32x2*)(ML + (((size_t)g * MT + rowq) * 4 + h) * 2) = ml; }
}
DI void attn_prompt_phase(LAS unsigned char* lds, const bf16_t* Q, const bf16_t* K, const bf16_t* V, bf16_t* OG, float* ML, const KvSrc& KS, int vblk, int vG) {
    const int tid = otid(); const int wave = tid >> 6, lane = tid & 63; const int NGW = vG * 8, gw = vblk * 8 + wave;
    for (int it = gw; it < 2 * 3 * 4 * 256; it += NGW) {
        const int tile = it & 255, h = (it >> 8) & 3, gb = it >> 10, g = gb % 3, b = gb / 3;
        const int dl = 2 * g;
        const int tpc = 256 >> dl;
        KvCopy kc; kv_issue<4>(kc, KS.c0, KS.c1, KS.c2, KS.out, KS.slotbase, it, lane);
        SCHED_FENCE();
        attn_unit(b, g, h, dl, tile / tpc, 32 * (tile % tpc), Q, K, V, OG, ML, (LAS bf16_t*)(lds + wave * 9216), lane);
        SCHED_FENCE();
        kv_commit<4>(kc);
    }
}
DI void attn_combine(const bf16_t* OG, const float* ML, bf16_t* YY, int vblk, int vG) {
    for (int it = vblk * 512 + otid(); it < MT * 32; it += vG * 512) {
        const int row = it >> 5, h = (it >> 3) & 3, dc = it & 7;
        float m[3], dn[3];
#pragma unroll
        for (int g = 0; g < 3; ++g) { const f32x2 v = *(const f32x2*)(ML + (((size_t)g * MT + row) * 4 + h) * 2); m[g] = v[0]; dn[g] = v[1]; }
        const float mt = fmaxf(m[0], fmaxf(m[1], m[2]));
        f32x4 a0 = {0, 0, 0, 0}, a1 = a0; float wsum = 0.f;
#pragma unroll
        for (int g = 0; g < 3; ++g) { const float w = dn[g] * __builtin_amdgcn_exp2f(m[g] - mt); wsum += w; f32x4 o0, o1; unpack8(*(const u32x4*)(OG + ((size_t)g * MT + row) * 256 + h * 64 + 8 * dc), o0, o1); a0 += o0 * w; a1 += o1 * w; }
        const float inv = 1.0f / wsum;
        *(u32x4*)(YY + (size_t)row * 768 + 512 + h * 64 + 8 * dc) = pack8(a0 * inv, a1 * inv);
    }
}

DI void sample_attn_item(int s, int h, int g, const float* raw3, const float* gqk, const float* cp, float* ko, bf16_t* OG, float* ML, LAS float* sl, int lane) {
    const float* r3 = raw3 + (size_t)s * INW;
    const int w = g == 0 ? 128 : (g == 1 ? 512 : 2048), dl = 2 * g;
    const float q = r3[l2p(512 + 256 * g + 64 * h + lane)], k = r3[l2p(1280 + 256 * g + 64 * h + lane)], v = r3[l2p(2048 + 256 * g + 64 * h + lane)];
    const float qs = wave_sum(q * q), ks = wave_sum(k * k);
    const float qv = q * rsqrtf(qs * (1.f / 64.f) + EPS) * gqk[g * 64 + lane] * QSCALE, kn = k * rsqrtf(ks * (1.f / 64.f) + EPS) * gqk[192 + g * 64 + lane];
    sl[lane] = qv; sl[192 + lane] = v;
    ko[((size_t)(s * w + (w - 1)) * 2 + 0) * 256 + h * 64 + lane] = kn; ko[((size_t)(s * w + (w - 1)) * 2 + 1) * 256 + h * 64 + lane] = v;
    const float s0 = wave_sum(qv * kn);
    LDS_WAIT();
    float sc[2];
#pragma unroll
    for (int half = 0; half < 2; ++half) {
        const int j = 1 + lane + 64 * half; const int rr = w - (j << dl);
        const float* kp = cp + ((size_t)(s * w + rr) * 2 + 0) * 256 + h * 64; float a = 0.f;
#pragma unroll
        for (int d4 = 0; d4 < 16; ++d4) { const f32x4 kk = *(const f32x4*)(kp + 4 * d4); const f32x4 qq = *(const LAS f32x4*)(sl + 4 * d4); a += (kk[0] * qq[0] + kk[1] * qq[1]) + (kk[2] * qq[2] + kk[3] * qq[3]); }
        sc[half] = a;
    }
    const float mx = wave_max(fmaxf(s0, fmaxf(sc[0], sc[1])));
    const float e0 = __builtin_amdgcn_exp2f(s0 - mx), p0 = __builtin_amdgcn_exp2f(sc[0] - mx), p1 = __builtin_amdgcn_exp2f(sc[1] - mx);
    const float den = wave_sum(p0 + p1) + e0;
    sl[64 + lane] = p0; sl[128 + lane] = p1;
    LDS_WAIT();
    const int d4 = lane & 15, kq = lane >> 4;
    f32x4 o = {0.f, 0.f, 0.f, 0.f};
#pragma unroll 8
    for (int i = 0; i < 32; ++i) { const int j = 1 + kq + 4 * i; const int rr = w - (j << dl);
        const f32x4 vv = *(const f32x4*)(cp + ((size_t)(s * w + rr) * 2 + 1) * 256 + h * 64 + 4 * d4); o += vv * sl[64 + j - 1]; }
#pragma unroll
    for (int e = 0; e < 4; ++e) { o[e] += __shfl_xor(o[e], 16); o[e] += __shfl_xor(o[e], 32); }
    if (lane < 16) {
        const f32x4 vn = *(const LAS f32x4*)(sl + 192 + 4 * d4); const float inv = 1.0f / den;
        o = (o + vn * e0) * inv;
        u32x2 wv; wv.x = pk2(o[0], o[1]); wv.y = pk2(o[2], o[3]);
        *(u32x2*)(OG + ((size_t)g * MT + NPR + s) * 256 + h * 64 + 4 * d4) = wv;
    }
    if (lane == 0) { f32x2 ml = {mx, den}; *(f32x2*)(ML + (((size_t)g * MT + NPR + s) * 4 + h) * 2) = ml; }
    LDS_WAIT();
}
DI void sample_ssm_item(int s, int g, const SsmIn& W, const float* raw3, const float* st_re, const float* st_im, float* out_re, float* out_im, bf16_t* YG, int lane) {
    const SsmPar sp = ssm_par(W.a_re, W.a_im, W.log_dt, g, lane);
    const float* r3 = raw3 + (size_t)s * INW;
    float xr = 0.f, xi = 0.f;
    const float* br = W.b_re + (size_t)(g * 64 + lane) * 16; const float* bi = W.b_im + (size_t)(g * 64 + lane) * 16;
#pragma unroll
    for (int c = 0; c < 16; ++c) { const float u = r3[l2p(16 * g + c)]; const float bbr = sp.fr * br[c] - sp.fi * bi[c], bbi = sp.fr * bi[c] + sp.fi * br[c]; xr += bbr * u; xi += bbi * u; }
    const size_t so = (size_t)(s * 32 + g) * 64 + lane;
    const float s0r = st_re[so], s0i = st_im[so];
    const float nr = sp.abr * s0r - sp.abi * s0i + xr, ni = sp.abr * s0i + sp.abi * s0r + xi;
    out_re[so] = nr; out_im[so] = ni;
    float ysel = 0.f;
#pragma unroll
    for (int c = 0; c < 16; ++c) { const float y = wave_sum(W.c_re[(size_t)(g * 16 + c) * 64 + lane] * nr - W.c_im[(size_t)(g * 16 + c) * 64 + lane] * ni); if (lane == c) ysel = y; }
    if (lane < 16) { const float u = r3[l2p(16 * g + lane)]; YG[(size_t)(NPR + s) * 512 + 16 * g + lane] = f2bf(gelu_tanh(ysel + W.dsk[16 * g + lane] * u)); }
}

struct Args { const float* in[32]; float* out; unsigned char* ws; };

__global__ void __launch_bounds__(512, 2) mega_fwd(Args a) {
    extern __shared__ __attribute__((aligned(16))) unsigned char lds_raw[];
    LAS unsigned char* lds = (LAS unsigned char*)lds_raw;
    cg::grid_group grid = cg::this_grid();
    const int tid = threadIdx.x, lane = tid & 63, wave = __builtin_amdgcn_readfirstlane(tid >> 6);
    const int G = gridDim.x, blk = blockIdx.x, gw = blk * 8 + wave, NGW = G * 8;
    unsigned char* const ws = a.ws;
    if (tid < 16) ((LAS unsigned*)(lds + 131072))[tid] = 0u;
    __syncthreads();
    unsigned* const barw = (unsigned*)(ws + 512 * 1024);
    const XcdBarrier xb = xcd_barrier_post(barw, (volatile LAS unsigned*)(lds + 131072 + 32), (unsigned)G);
    const int HG = G / 2;
    const XcdBarrier xbh = xcd_barrier_post(barw + (blk < HG ? 4096 : 8192), (volatile LAS unsigned*)(lds + 131072 + 48), (unsigned)(blk < HG ? HG : G - HG));
#define W1GU ((bf16_t*)(ws + WS_W1GU))
#define W1D ((bf16_t*)(ws + WS_W1D))
#define WIN ((bf16_t*)(ws + WS_WIN))
#define WGLU ((bf16_t*)(ws + WS_WGLU))
#define WSP ((bf16_t*)(ws + WS_WMIX))
#define WAP ((bf16_t*)(ws + WS_WMIX + MiB))
#define TBUF ((bf16_t*)(ws + WS_X1 + 33 * MiB))
#define WO ((bf16_t*)(ws + WS_WO))
#define W2GU ((bf16_t*)(ws + WS_W2GU))
#define W2D ((bf16_t*)(ws + WS_W2D))
#define SEND ((float*)(ws + WS_SEND))
#define SIN ((float*)(ws + WS_SIN))
#define ML ((float*)(ws + WS_ML))
#define SQ1 ((float*)(ws + WS_SQ1))
#define SQ2 ((float*)(ws + WS_SQ2))
#define SR ((float*)(ws + WS_SRAW))
#define XN ((bf16_t*)(ws + WS_XN))
#define X1B ((bf16_t*)(ws + WS_X1B))
#define ACT ((bf16_t*)(ws + WS_ACT))
#define GT ((bf16_t*)(ws + WS_G))
#define OG ((bf16_t*)(ws + WS_OG))
#define YG ((bf16_t*)(ws + WS_YG))
#define YY ((bf16_t*)(ws + WS_YY))
#define X1 ((float*)(ws + WS_X1))
#define GQK ((float*)ws)
#define X2B XN
#define MIXED ((bf16_t*)(ws + WS_X1))
#define Ub ACT
#define Qb (ACT + (size_t)MT * 512)
#define Kb (ACT + (size_t)MT * 512 + (size_t)MT * 768)
#define Vb (ACT + (size_t)MT * 512 + (size_t)MT * 1536)
#define acts1 ((bf16_t*)(SR + SR_RAW1))
#define rawd (SR + SR_RAWD)
#define raw3 (SR + SR_RAW3)
#define yssms ((bf16_t*)(SR + SR_RAWGLU))
#define mixeds ((bf16_t*)(SR + SR_RAWMIX))
#define rawma (SR + SR_RAWMIX + 32 * 1024)
#define rawo (SR + SR_RAWO)
#define acts2 ((bf16_t*)(SR + SR_RAW10))
#define xp (a.in[0])
#define xs (a.in[1])
    float* const out = a.out;
#define SSM_IN(SW) SsmIn SW; SW.a_re = a.in[15]; SW.a_im = a.in[16]; SW.log_dt = a.in[17]; SW.b_re = a.in[18]; SW.b_im = a.in[19]; SW.c_re = a.in[20]; SW.c_im = a.in[21]; SW.dsk = a.in[22];

    constexpr int I_GU = 16 * 88, I_DN = 44 * 32, I_IN = 16 * 152, I_GL = 8 * 16, I_SP = 8 * 32, I_AP = 4 * 32, I_WO = 16 * 32;
#ifndef REP_P0
#define REP_P0 1
#endif
    for (int rep0 = 0; rep0 < REP_P0; ++rep0) {
        LAS float* scr = (LAS float*)(lds + wave * 16384);
        constexpr int NIT = 3 * I_GU + I_IN + I_GL + I_SP + I_AP + I_WO + 3 * I_GU;
        static_assert(I_DN == I_GU, "item counts");
        (void)NIT;
#define TR_JOB(CNT, ...) for (int r = gw; r < (CNT); r += NGW) tr_item(__VA_ARGS__, r, scr, lane);
        TR_JOB(I_GU, a.in[8], FF, nullptr, W1GU, 1024, 0, 1)
        TR_JOB(I_GU, a.in[9], FF, nullptr, W1GU, 1024, 0, 2)
        TR_JOB(I_IN, a.in[12], INW, a.in[11], WIN, 1024, 0, 3)
#undef TR_JOB
        for (int i = blk * 512 + tid; i < NPR; i += G * 512) { SQ1[i] = 0.f; SQ2[i] = 0.f; }
        for (int i = blk * 512 + tid; i < 384; i += G * 512) GQK[i] = i < 192 ? a.in[13][i] : a.in[14][i - 192];
        if (gw >= NGW - 32) { SSM_IN(SWT) ssm_build_tables(SWT, ws + WS_SSMT, gw - (NGW - 32), lane); }
        for (int m = gw; m < MT; m += 2 * NGW) { const int m1 = (m + NGW < MT) ? m + NGW : m;
            norm_rows2_bf16(m < NPR ? xp + (size_t)m * DM : xs + (size_t)(m - NPR) * DM, m1 < NPR ? xp + (size_t)m1 * DM : xs + (size_t)(m1 - NPR) * DM, a.in[7], XN + (size_t)m * DM, XN + (size_t)m1 * DM, lane); }
    }
    if (a.ws == nullptr) grid.sync();
    xcd_barrier(xb);
    {
        pg8::Gemm g{XN, W1GU, NPR, 2 * FF, DM}; pg8::StaticOrder S; S.init(NPR, 2 * FF, G, blk);
        EpiAct<false> E{ACT, nullptr};
        pg8::gemm_phase<EpiAct<false>, pg8::StaticOrder, true, true>(lds, g, S, E);
        ProvBf16 P{XN + (size_t)NPR * DM, DM};
        skinny_gu_phase<DM>(lds, W1GU, P, acts1);
        { const int first = (64 * 22) % G; const int wk = blk - first;
          if (wk >= 0) { LAS float* scr = (LAS float*)(lds + wave * 16384); const int gw2 = wk * 8 + wave, NGW2 = (G - first) * 8;
#define TR_JOB2(CNT, ...) for (int r = gw2; r < (CNT); r += NGW2) tr_item(__VA_ARGS__, r, scr, lane);
            TR_JOB2(I_DN, a.in[10], DM, nullptr, W1D, FF, 0, 0)
            TR_JOB2(I_GL, a.in[23], 512, nullptr, WGLU, 512, 0, 0)
            TR_JOB2(I_SP, a.in[25], DM, nullptr, WSP, 512, 0, 0)
            TR_JOB2(I_AP, a.in[26], DM, nullptr, WAP, 256, 0, 0)
            TR_JOB2(I_WO, a.in[27], DM, nullptr, WO, 1024, 0, 0)
            TR_JOB2(I_GU, a.in[29], FF, a.in[28], W2GU, 1024, 0, 1)
            TR_JOB2(I_GU, a.in[30], FF, a.in[28], W2GU, 1024, 0, 2)
            TR_JOB2(I_DN, a.in[31], DM, nullptr, W2D, FF, 0, 0)
#undef TR_JOB2
          } }
    }
    xcd_barrier(xb);
    {
        pg8::Gemm g{ACT, W1D, NPR, DM, FF}; pg8::StaticOrder S; S.init(NPR, DM, G, blk);
        EpiRes<false> E{xp, nullptr, X1B, SQ1, 0.5f};
        pg8::gemm_phase<EpiRes<false>, pg8::StaticOrder, true, true, -1>(lds, g, S, E);
        ProvBf16 P{acts1, FF}; SEpiRaw SE{rawd, DM};
        skinny_phase<DM, FF>(lds, W1D, P, SE);
    }
    xcd_barrier(xb);
    {
        pg8::Gemm g{X1B, WIN, NPR, INW, DM}; pg8::StaticOrder S; S.init(NPR, INW, G, blk);
        EpiWin E{SQ1, ACT, GT, GQK, out};
        pg8::gemm_phase<EpiWin, pg8::StaticOrder, true, true>(lds, g, S, E);
        ProvX<false> P{xs, rawd, nullptr}; SEpiRawScaled SE{raw3, INW};
        skinny_phase<INW, DM>(lds, WIN, P, SE);
        kvshift_tail(a.in[2], a.in[3], a.in[4], out, 64 * 19, KV_TAIL_P10, KV_TAIL_ROWS, wave, lane);
    }
    xcd_barrier(xb);
    if (blk < HG) {
        SSM_IN(SW)
        { const KvSrc KS{a.in[2], a.in[3], a.in[4], out, KV_TAIL_ROWS}; ssm_pass<false>(lds, SW, ws + WS_SSMT, Ub, SEND, nullptr, nullptr, KS, blk, HG); }
        xcd_barrier(xbh);
        ssm_carry(SW, SEND, SIN, out + O_SREP, out + O_SIMP, blk, HG);
        xcd_barrier(xbh);
        { const KvSrc KS{a.in[2], a.in[3], a.in[4], out, KV_TAIL_ROWS + 40960}; ssm_pass<true>(lds, SW, ws + WS_SSMT, Ub, nullptr, SIN, YG, KS, blk, HG); }
    } else {
        const int vblk = blk - HG, vG = G - HG, vgw = vblk * 8 + wave, vNGW = vG * 8;
        { const KvSrc KS{a.in[2], a.in[3], a.in[4], out, KV_TAIL_ROWS + 16384}; attn_prompt_phase(lds, Qb, Kb, Vb, OG, ML, KS, vblk, vG); }
        LAS float* sl = (LAS float*)(lds + 110592 + wave * 2560);
        for (int it = vgw; it < 384; it += vNGW) { const int g = it % 3, sh = it / 3;
            sample_attn_item(sh >> 2, sh & 3, g, raw3, GQK, g == 0 ? a.in[2] : (g == 1 ? a.in[3] : a.in[4]), out + (g == 0 ? O_KVS0 : (g == 1 ? O_KVS1 : O_KVS2)), OG, ML, sl, lane); }
        { SSM_IN(SW)
          for (int it = vNGW - 1 - vgw; it < 1024; it += vNGW) sample_ssm_item(it >> 5, it & 31, SW, raw3, a.in[5], a.in[6], out + O_SRES, out + O_SIMS, YG, lane); }
        xcd_barrier(xbh);
        attn_combine(OG, ML, YY, vblk, vG);
    }
    xcd_barrier(xb);
    {
        { pg8::Gemm g{YG, WGLU, NPR, 512, 512}; pg8::StaticOrder S; S.init(NPR, 512, G, blk);
          EpiGlu E{YG, a.in[24], YY};
          pg8::gemm_phase<EpiGlu, pg8::StaticOrder, true, true>(lds, g, S, E); }
        { pg8::Gemm g{YY + 512, WAP, NPR, DM, 256}; pg8::StaticOrder S; S.init(NPR, DM, G, blk);
          EpiGateScale E{GT, TBUF};
          pg8::gemm_phase<EpiGateScale, pg8::StaticOrder, true, true, 768>(lds, g, S, E); }
        { ProvBf16 P{YG + (size_t)NPR * 512, 512}; SEpiGluS SE{YG, a.in[24], yssms};
          skinny_phase<512, 512>(lds, WGLU, P, SE); }
        { ProvBf16 P{YY + (size_t)NPR * 768 + 512, 768}; SEpiRaw SE{rawma, DM};
          skinny_phase<DM, 256>(lds, WAP, P, SE); }
    }
    xcd_barrier(xb);
    {
        pg8::Gemm g{YY, WSP, NPR, DM, 512}; pg8::StaticOrder S; S.init(NPR, DM, G, blk);
        EpiMix2 E{GT, TBUF, MIXED};
        pg8::gemm_phase<EpiMix2, pg8::StaticOrder, true, true, 768>(lds, g, S, E);
        ProvBf16 P{yssms, 512}; SEpiMixS SE{raw3, rawma, mixeds};
        skinny_phase<DM, 512>(lds, WSP, P, SE);
    }
    xcd_barrier(xb);
    {
        pg8::Gemm g{MIXED, WO, NPR, DM, DM}; pg8::StaticOrder S; S.init(NPR, DM, G, blk);
        EpiRes<true> E{X1B, nullptr, X2B, SQ2, 1.0f};
        pg8::gemm_phase<EpiRes<true>, pg8::StaticOrder, true, true>(lds, g, S, E);
        ProvBf16 P{mixeds, DM}; SEpiRaw SE{rawo, DM};
        skinny_phase<DM, DM>(lds, WO, P, SE);
    }
    xcd_barrier(xb);
    {
        pg8::Gemm g{X2B, W2GU, NPR, 2 * FF, DM}; pg8::StaticOrder S; S.init(NPR, 2 * FF, G, blk);
        EpiAct<true> E{ACT, SQ2};
        pg8::gemm_phase<EpiAct<true>, pg8::StaticOrder, true, true>(lds, g, S, E);
        ProvX<true> P{xs, rawd, rawo};
        skinny_gu_phase<DM>(lds, W2GU, P, acts2);
        kvshift_tail(a.in[2], a.in[3], a.in[4], out, 64 * 22, 0, KV_TAIL_P10, wave, lane);
    }
    xcd_barrier(xb);
    {
        pg8::Gemm g{ACT, W2D, NPR, DM, FF}; pg8::StaticOrder S; S.init(NPR, DM, G, blk);
        EpiRes<true> E{X2B, out + O_YP, nullptr, nullptr, 0.5f};
        pg8::gemm_phase<EpiRes<true>, pg8::StaticOrder, true, true, -1>(lds, g, S, E);
        ProvBf16 P{acts2, FF}; SEpiFinal SE{xs, rawd, rawo, out + O_YS};
        skinny_phase<DM, FF>(lds, W2D, P, SE);
    }
}

extern "C" void kernel_launch(void* const* d_in, const int* in_sizes, int n_in, void* d_out, int out_size, void* d_ws, size_t ws_size, hipStream_t stream) {
    static int grid = 0;
    if (grid == 0) {
        if (n_in != 32 || ws_size < WS_END) { fprintf(stderr, "kernel_launch: unexpected inputs (n_in %d, ws %zu)\n", n_in, ws_size); grid = -1; return; }
        int dev = 0, cus = 0, per_cu = 0;
        hipGetDevice(&dev); hipDeviceGetAttribute(&cus, hipDeviceAttributeMultiprocessorCount, dev);
        hipFuncSetAttribute((const void*)mega_fwd, hipFuncAttributeMaxDynamicSharedMemorySize, LDS_BYTES);
        hipOccupancyMaxActiveBlocksPerMultiprocessor(&per_cu, (const void*)mega_fwd, 512, LDS_BYTES);
        if (per_cu < 1) { fprintf(stderr, "kernel_launch: occupancy query says %d blocks/CU\n", per_cu); per_cu = 1; }
        if (per_cu > 1) per_cu = 1;
        grid = cus * per_cu;
        (void)hipGetLastError();
    }
    if (grid < 0) return;
    if (hipMemsetAsync((char*)d_ws + 512 * 1024, 0, 3 * 4096 * 4, stream) != hipSuccess) { fprintf(stderr, "kernel_launch: memset of barrier words failed\n"); return; }
    Args a{};
    for (int i = 0; i < 32; ++i) a.in[i] = (const float*)d_in[i];
    a.out = (float*)d_out; a.ws = (unsigned char*)d_ws;
    void* args[] = {&a};
    hipError_t e = hipLaunchCooperativeKernel((const void*)mega_fwd, dim3(grid), dim3(512), args, LDS_BYTES, stream);
    if (e != hipSuccess) fprintf(stderr, "cooperative launch failed: %s (grid %d)\n", hipGetErrorString(e), grid);
}
```

```cpp
#include <hip/hip_runtime.h>
#include <hip/hip_cooperative_groups.h>
#include <cstdio>
#include <cstdint>
namespace cg = cooperative_groups;
namespace pg8 {
#define PG8_LAS __attribute__((address_space(3)))
typedef unsigned short bf16_t;
typedef short bf16x8 __attribute__((ext_vector_type(8)));
typedef float f32x4 __attribute__((ext_vector_type(4)));
typedef unsigned u32x4 __attribute__((ext_vector_type(4)));
constexpr int BM = 256, BK = 64, HALF = 128, HTB = HALF * BK * 2  , STAGE_BYTES = 8 * HTB, NXCD = 8, WGM = 8;

__host__ __device__ __forceinline__ int lds_byte(int r, int c) { const int st = (r >> 4) * 2 + (c >> 5), rr = r & 15, cc = c & 31, ob = rr * 64 + cc * 2; return st * 1024 + (ob ^ (((ob >> 9) & 1) << 5)); }
__host__ __device__ __forceinline__ void stage_rc(int b, int& R, int& C) { const int st = b / 1024, sb = b % 1024, swz = sb ^ (((sb >> 9) & 1) << 5); R = (st >> 1) * 16 + swz / 64; C = (st & 1) * 32 + (swz % 64) / 2; }
__host__ __device__ __forceinline__ int perm32(int rho) { const int n = rho >> 4, i = rho & 15; return 8 * (i >> 2) + 4 * n + (i & 3); }

struct Unit { int pm, pn; };
struct Gemm { const bf16_t* A; const bf16_t* Bt; int M, N, K; };

struct StaticOrder {
    int nM, nN, nwg, G, c;
    __host__ __device__ void init(int M, int N, int G_, int c_) { nM = M / BM; nN = N / BM; nwg = nM * nN; G = G_; c = c_; }
    __host__ __device__ bool next(int i, Unit& u) const {
        const long L = (long)i * G + c; if (L >= nwg) return false;
        int wgid = (int)L; { const int q = nwg / NXCD, r = nwg % NXCD, xcd = wgid % NXCD, off = wgid / NXCD; wgid = (xcd < r ? xcd * (q + 1) : r * (q + 1) + (xcd - r) * q) + off; }
        const int nig = WGM * nN, gid = wgid / nig, fm = gid * WGM, gsz = (nM - fm) < WGM ? (nM - fm) : WGM;
        u.pm = fm + ((wgid % nig) % gsz); u.pn = (wgid % nig) / gsz; return true;
    }
    __device__ __forceinline__ void a_ready(const Unit&) const {}
    __device__ __forceinline__ void done(const Unit&) const {}
};
template <class Epi, class Sched, bool ALIGN_EPI = false, bool SP2 = false, int LDA_T = 0>
__device__ __forceinline__ void gemm_phase(PG8_LAS unsigned char* lds, const Gemm g, const Sched& S, const Epi& E) {
    int tid_ = threadIdx.x; asm volatile("" : "+v"(tid_));
    const int tid = tid_, wid = __builtin_amdgcn_readfirstlane(tid >> 6), lane = tid & 63, wr = wid >> 2, wc = wid & 3, fr = lane & 15, fq = lane >> 4;
    constexpr bool ABLK = (LDA_T == -1);
    const int K = g.K, nt = K / BK, LDA = ABLK ? BK : (LDA_T ? LDA_T : g.K);
    unsigned voffA[2], voffB[2];
#pragma unroll
    for (int i = 0; i < 2; ++i) { int R, C; stage_rc(tid * 16 + i * 8192, R, C); const int Rb = Epi::PERM ? ((R & ~31) + perm32(R & 31)) : R;
        voffA[i] = (unsigned)(R * LDA + C) * 2u; voffB[i] = (unsigned)(Rb * K + C) * 2u; }
    const size_t kstepB = (size_t)(BK * 2), kstepA = ABLK ? (size_t)(BM * BK * 2) : kstepB;
    const size_t hstepB = (size_t)HALF * K * 2, hstepA = (size_t)HALF * LDA * 2;
    const size_t tstepB = 2 * hstepB, tstepA = ABLK ? (size_t)nt * kstepA : 2 * hstepA;
    const unsigned ldsw = (unsigned)wid * 1024u;
    const int aoff = lds_byte(wr * 64 + fr, fq * 8), boff = lds_byte(wc * 32 + fr, fq * 8);
#define PG8_SA(b, h) (((b) * 2 + (h)) * HTB)
#define PG8_SB(b, h) ((4 + (b) * 2 + (h)) * HTB)
#define PG8_STAGE(bufoff, gbase, voff) do { _Pragma("unroll") for (int _i = 0; _i < 2; ++_i) \
        __builtin_amdgcn_global_load_lds((const unsigned*)((const char*)(gbase) + (voff)[_i]), (PG8_LAS unsigned*)(lds + (bufoff) + ldsw + _i * 8192), 16, 0, 0); } while (0)
#define PG8_LDA(dst, b, h) do { _Pragma("unroll") for (int m = 0; m < 4; ++m) _Pragma("unroll") for (int k = 0; k < 2; ++k) dst[m][k] = *(const PG8_LAS bf16x8*)(lds + PG8_SA(b, h) + aoff + m * 2048 + k * 1024); } while (0)
#define PG8_LDB(dst, b, h) do { _Pragma("unroll") for (int n = 0; n < 2; ++n) _Pragma("unroll") for (int k = 0; k < 2; ++k) dst[n][k] = *(const PG8_LAS bf16x8*)(lds + PG8_SB(b, h) + boff + n * 2048 + k * 1024); } while (0)
#define PG8_MMA(ai, bj, At, Bt) do { __builtin_amdgcn_s_setprio(1); _Pragma("unroll") for (int m = 0; m < 4; ++m) _Pragma("unroll") for (int n = 0; n < 2; ++n) _Pragma("unroll") for (int k = 0; k < 2; ++k) \
        acc[ai][bj][m][n] = __builtin_amdgcn_mfma_f32_16x16x32_bf16(Bt[n][k], At[m][k], acc[ai][bj][m][n], 0, 0, 0); __builtin_amdgcn_s_setprio(0); } while (0)
#define PG8_WAIT_V(n) asm volatile("s_waitcnt vmcnt(" #n ")" ::: "memory")
#define PG8_WAIT_L(n) asm volatile("s_waitcnt lgkmcnt(" #n ")" ::: "memory")
#define PG8_BAR __builtin_amdgcn_s_barrier()
#define PG8_SCHED __builtin_amdgcn_sched_barrier(0)
    Unit cur, nxt; int ui = 0;
    if (!S.next(0, cur)) return;
    f32x4 acc[2][2][4][2];
#pragma unroll
    for (int a = 0; a < 2; ++a)
#pragma unroll
        for (int b = 0; b < 2; ++b)
#pragma unroll
            for (int m = 0; m < 4; ++m)
#pragma unroll
                for (int n = 0; n < 2; ++n) acc[a][b][m][n] = (f32x4){0.f, 0.f, 0.f, 0.f};
    bf16x8 At[4][2], B0[2][2], B1[2][2];
    const char* cA = (const char*)g.A + (size_t)cur.pm * tstepA; const char* cB = (const char*)g.Bt + (size_t)cur.pn * tstepB;
    S.a_ready(cur);
    if constexpr (SP2) {
        PG8_STAGE(PG8_SB(0, 0), cB, voffB); PG8_STAGE(PG8_SB(0, 1), cB + hstepB, voffB); PG8_STAGE(PG8_SA(0, 0), cA, voffA); PG8_STAGE(PG8_SA(0, 1), cA + hstepA, voffA);
        if (wr == 1) PG8_BAR;
        PG8_WAIT_V(2); PG8_BAR;
        PG8_STAGE(PG8_SB(1, 0), cB + kstepB, voffB); PG8_STAGE(PG8_SA(1, 0), cA + kstepA, voffA); PG8_STAGE(PG8_SB(1, 1), cB + hstepB + kstepB, voffB);
        PG8_WAIT_V(6); PG8_BAR;
    } else {
        PG8_STAGE(PG8_SB(0, 0), cB, voffB); PG8_STAGE(PG8_SA(0, 0), cA, voffA); PG8_STAGE(PG8_SB(0, 1), cB + hstepB, voffB); PG8_STAGE(PG8_SA(0, 1), cA + hstepA, voffA);
        if (wr == 1) PG8_BAR;
        PG8_WAIT_V(4); PG8_BAR;
        PG8_STAGE(PG8_SB(1, 0), cB + kstepB, voffB); PG8_STAGE(PG8_SA(1, 0), cA + kstepA, voffA); PG8_STAGE(PG8_SB(1, 1), cB + hstepB + kstepB, voffB);
        PG8_WAIT_V(6); PG8_BAR;
    }
    for (;;) {
        const bool has_next = S.next(ui + 1, nxt);
        const char* nA = has_next ? (const char*)g.A + (size_t)nxt.pm * tstepA : cA; const char* nB = has_next ? (const char*)g.Bt + (size_t)nxt.pn * tstepB : cB;
        for (int t = 0; t < nt; t += 2) {
            const bool last = (t == nt - 2);
            const char* a1 = cA + (size_t)(t + 1) * kstepA;
            const char* a2 = last ? nA : cA + (size_t)(t + 2) * kstepA; const char* b2 = last ? nB : cB + (size_t)(t + 2) * kstepB;
            const char* a3 = a2 + kstepA; const char* b3 = b2 + kstepB;
            if (last && has_next) S.a_ready(nxt);
            if constexpr (SP2) {
            PG8_LDB(B0, 0, 0); PG8_LDB(B1, 0, 1); PG8_SCHED; PG8_LDA(At, 0, 0); PG8_STAGE(PG8_SA(1, 1), a1 + hstepA, voffA);
            PG8_WAIT_V(8); PG8_WAIT_L(0); PG8_BAR; PG8_MMA(0, 0, At, B0); PG8_MMA(0, 1, At, B1); PG8_BAR; PG8_SCHED;
            PG8_LDA(At, 0, 1); PG8_STAGE(PG8_SB(0, 0), b2, voffB); PG8_STAGE(PG8_SB(0, 1), b2 + hstepB, voffB); PG8_STAGE(PG8_SA(0, 0), a2, voffA);
            PG8_WAIT_V(8); PG8_WAIT_L(0); PG8_BAR; PG8_MMA(1, 0, At, B0); PG8_MMA(1, 1, At, B1); PG8_BAR; PG8_SCHED;
            PG8_LDB(B0, 1, 0); PG8_LDB(B1, 1, 1); PG8_SCHED; PG8_LDA(At, 1, 0); PG8_STAGE(PG8_SA(0, 1), a2 + hstepA, voffA);
            PG8_WAIT_V(8); PG8_WAIT_L(0); PG8_BAR; PG8_MMA(0, 0, At, B0); PG8_MMA(0, 1, At, B1); PG8_BAR; PG8_SCHED;
            PG8_LDA(At, 1, 1); PG8_STAGE(PG8_SB(1, 0), b3, voffB); PG8_STAGE(PG8_SB(1, 1), b3 + hstepB, voffB); PG8_STAGE(PG8_SA(1, 0), a3, voffA);
            PG8_WAIT_V(8); PG8_WAIT_L(0); PG8_BAR; PG8_MMA(1, 0, At, B0); PG8_MMA(1, 1, At, B1); PG8_BAR; PG8_SCHED;
            } else {
            PG8_LDB(B0, 0, 0); PG8_SCHED; PG8_LDA(At, 0, 0); PG8_STAGE(PG8_SA(1, 1), a1 + hstepA, voffA);
            PG8_WAIT_L(8); PG8_BAR; PG8_WAIT_L(0); PG8_MMA(0, 0, At, B0); PG8_BAR; PG8_SCHED;
            PG8_LDB(B1, 0, 1); PG8_STAGE(PG8_SB(0, 0), b2, voffB);
            PG8_BAR; PG8_WAIT_L(0); PG8_MMA(0, 1, At, B1); PG8_BAR;
            PG8_LDA(At, 0, 1); PG8_STAGE(PG8_SA(0, 0), a2, voffA);
            PG8_BAR; PG8_WAIT_L(0); PG8_MMA(1, 0, At, B0); PG8_BAR; PG8_SCHED;
            PG8_STAGE(PG8_SB(0, 1), b2 + hstepB, voffB);
            PG8_WAIT_V(6); PG8_BAR; PG8_MMA(1, 1, At, B1); PG8_BAR;
            PG8_LDB(B0, 1, 0); PG8_SCHED; PG8_LDA(At, 1, 0); PG8_STAGE(PG8_SA(0, 1), a2 + hstepA, voffA);
            PG8_WAIT_L(8); PG8_BAR; PG8_WAIT_L(0); PG8_MMA(0, 0, At, B0); PG8_BAR; PG8_SCHED;
            PG8_LDB(B1, 1, 1); PG8_STAGE(PG8_SB(1, 0), b3, voffB);
            PG8_BAR; PG8_WAIT_L(0); PG8_MMA(0, 1, At, B1); PG8_BAR;
            PG8_LDA(At, 1, 1); PG8_STAGE(PG8_SA(1, 0), a3, voffA);
            PG8_BAR; PG8_WAIT_L(0); PG8_MMA(1, 0, At, B0); PG8_BAR; PG8_SCHED;
            PG8_STAGE(PG8_SB(1, 1), b3 + hstepB, voffB);
            PG8_WAIT_V(6); PG8_BAR; PG8_MMA(1, 1, At, B1); PG8_BAR;
            }
        }
        if constexpr (ALIGN_EPI) { if (wr == 0) PG8_BAR; }
        if constexpr (!Epi::AFTER_DRAIN) { E(acc, cur, wr, wc, fr, fq); S.done(cur); }
        if (!has_next) break;
#pragma unroll
        for (int a = 0; a < 2; ++a)
#pragma unroll
            for (int b = 0; b < 2; ++b)
#pragma unroll
                for (int m = 0; m < 4; ++m)
#pragma unroll
                    for (int n = 0; n < 2; ++n) acc[a][b][m][n] = (f32x4){0.f, 0.f, 0.f, 0.f};
        cur = nxt; cA = nA; cB = nB; ++ui;
        if constexpr (ALIGN_EPI) { if (wr == 1) PG8_BAR; }
    }
    PG8_WAIT_V(0);
    if constexpr (!ALIGN_EPI) { if (wr == 0) PG8_BAR; }
    PG8_BAR;
    if constexpr (Epi::AFTER_DRAIN) { E.fused(acc, cur, wr, wc, fr, fq, lds, wid, lane); S.done(cur); }
#undef PG8_SA
#undef PG8_SB
#undef PG8_STAGE
#undef PG8_LDA
#undef PG8_LDB
#undef PG8_MMA
#undef PG8_WAIT_V
#undef PG8_WAIT_L
#undef PG8_BAR
#undef PG8_SCHED
}
}

#define LAS __attribute__((address_space(3)))
#define DI __device__ __forceinline__
typedef unsigned short bf16_t;
typedef short bf16x8 __attribute__((ext_vector_type(8)));
typedef float f32x4 __attribute__((ext_vector_type(4)));
typedef float f32x2 __attribute__((ext_vector_type(2)));
typedef float f32x16 __attribute__((ext_vector_type(16)));
typedef unsigned u32x4 __attribute__((ext_vector_type(4)));
typedef unsigned u32x2 __attribute__((ext_vector_type(2)));
typedef __bf16 bf16x2n __attribute__((ext_vector_type(2)));

constexpr int DM = 1024, FF = 2816, NPR = 16384, NSM = 32, MT = NPR + NSM, SEQ = 8192, INW = 4864;
constexpr float EPS = 1e-6f;
constexpr float QSCALE = 0.125f * 1.4426950408889634f;
constexpr int NCH = 128, TCH = 64;

constexpr size_t MiB = 1u << 20;
constexpr size_t WS_W1GU = 1 * MiB, WS_W1D = 12 * MiB, WS_WIN = 18 * MiB, WS_WGLU = 28 * MiB, WS_WMIX = 29 * MiB, WS_WO = 32 * MiB, WS_W2GU = 34 * MiB, WS_W2D = 45 * MiB;
constexpr size_t WS_SEND = 51 * MiB, WS_SIN = 55 * MiB, WS_ML = 59 * MiB, WS_SQ1 = 61 * MiB, WS_SQ2 = 63 * MiB, WS_SRAW = 65 * MiB;
constexpr size_t WS_XN = 70 * MiB, WS_X1B = 103 * MiB, WS_X1 = 136 * MiB, WS_ACT = 201 * MiB, WS_G = 290 * MiB, WS_OG = 355 * MiB, WS_YG = 380 * MiB, WS_YY = 397 * MiB, WS_END = 422 * MiB;
constexpr size_t SR_RAW1 = 0, SR_RAWD = SR_RAW1 + 32 * 5632, SR_RAW3 = SR_RAWD + 32 * 1024, SR_RAWGLU = SR_RAW3 + 32 * 4864, SR_RAWMIX = SR_RAWGLU + 32 * 512, SR_RAWO = SR_RAWMIX + 32 * 2048,
                 SR_RAW10 = SR_RAWO + 32 * 1024, SR_END = SR_RAW10 + 32 * 5632;
static_assert(SR_END * 4 <= 5 * MiB, "sample raw region");
constexpr size_t O_YP = 0, O_YS = 16777216, O_KVP0 = 16809984, O_KVP1 = 16941056, O_KVP2 = 17465344, O_SREP = 19562496, O_SIMP = 19566592,
                 O_KVS0 = 19570688, O_KVS1 = 21667840, O_KVS2 = 30056448, O_SRES = 63610880, O_SIMS = 63676416;

constexpr int LDS_BYTES = 147456;

DI int otid() { int t = threadIdx.x; asm volatile("" : "+v"(t)); return t; }
DI unsigned pk2(float a, float b) { f32x2 v = {a, b}; bf16x2n r = __builtin_convertvector(v, bf16x2n); return __builtin_bit_cast(unsigned, r); }
DI bf16_t f2bf(float a) { return (bf16_t)(pk2(a, a) & 0xffffu); }
DI float bflo(unsigned w) { return __uint_as_float(w << 16); }
DI float bfhi(unsigned w) { return __uint_as_float(w & 0xffff0000u); }
DI float bf2f(bf16_t b) { return __uint_as_float(((unsigned)b) << 16); }
DI float sigm(float x) { return __builtin_amdgcn_rcpf(1.f + __expf(-x)); }
DI float silu(float x) { return x * sigm(x); }
DI float gelu_tanh(float x) { const float z = 0.7978845608028654f * (x + 0.044715f * x * x * x); const float t = 1.f - 2.f * __builtin_amdgcn_rcpf(1.f + __expf(2.f * z)); return 0.5f * x * (1.f + t); }
DI u32x4 pack8(f32x4 a, f32x4 b) { u32x4 w; w.x = pk2(a[0], a[1]); w.y = pk2(a[2], a[3]); w.z = pk2(b[0], b[1]); w.w = pk2(b[2], b[3]); return w; }
DI void unpack8(u32x4 w, f32x4& a, f32x4& b) { a = (f32x4){bflo(w.x), bfhi(w.x), bflo(w.y), bfhi(w.y)}; b = (f32x4){bflo(w.z), bfhi(w.z), bflo(w.w), bfhi(w.w)}; }
DI float wave_sum(float v) {
#pragma unroll
    for (int o = 1; o < 64; o <<= 1) v += __shfl_xor(v, o);
    return v;
}
DI float wave_max(float v) {
#pragma unroll
    for (int o = 1; o < 64; o <<= 1) v = fmaxf(v, __shfl_xor(v, o));
    return v;
}
DI float rstd16(const float* sq, int row) { return rsqrtf(sq[row] * (1.f / 1024.f) + EPS); }
DI int l2p(int c) { return (c & ~255) | (((c >> 5) & 1) << 7) | (((c >> 6) & 3) << 5) | (c & 31); }
#define LDS_WAIT() asm volatile("s_waitcnt lgkmcnt(0)" ::: "memory")
#define SCHED_FENCE() __builtin_amdgcn_sched_barrier(0)


typedef __attribute__((address_space(1))) unsigned gu32;
#define XB_TMO      128
#define XB_XCNT(j)  (256  + 64 * (j))
#define XB_XSUB(j)  (1280 + 64 * (j))
#define XB_XGEN(j)  (2304 + 64 * (j))
#define XB_TOP      3328
#define XB_TOPGEN   3392
#define XCD_BAR_WORDS 3456
#define XB_SPIN_CAP (1u << 18)

__device__ __forceinline__ unsigned xb_ld(unsigned* p)              { return __hip_atomic_load(p, __ATOMIC_RELAXED, __HIP_MEMORY_SCOPE_AGENT); }
__device__ __forceinline__ unsigned xb_add(unsigned* p, unsigned v) { return __hip_atomic_fetch_add(p, v, __ATOMIC_RELAXED, __HIP_MEMORY_SCOPE_AGENT); }
__device__ __forceinline__ unsigned xb_xcc_id() { return (unsigned)__builtin_amdgcn_s_getreg((3 << 11) | 20) & 0xFu; }
#define XB_SPIN(cond, bar) do { unsigned _sp = 0; while (cond) { __builtin_amdgcn_s_sleep(1); \
    if ((++_sp & 255u) == 0u) { if (xb_ld(&(bar)[XB_TMO])) break; if (_sp > XB_SPIN_CAP) { atomicAdd(&(bar)[XB_TMO], 1u); break; } } } } while (0)

struct XcdBarrier {
    unsigned* bar; unsigned x; unsigned G;
    volatile LAS unsigned* st;
};

__device__ __forceinline__ XcdBarrier xcd_barrier_post(unsigned* bar, volatile LAS unsigned* st, unsigned G) {
    XcdBarrier b; b.bar = bar; b.x = xb_xcc_id(); b.st = st; b.G = G;
    if (threadIdx.x == 0) (void)xb_add(&bar[XB_XCNT(b.x)], 1u);
    return b;
}
__device__ __forceinline__ void xcd_barrier_complete(unsigned* bar, unsigned x, unsigned G, unsigned& nloc, unsigned& nx) {
    unsigned sum, cnt, mine, sp = 0u;
    for (;;) {
        sum = 0u; cnt = 0u; mine = 0u;
#pragma unroll
        for (unsigned j = 0; j < 16; ++j) { const unsigned c = xb_ld(&bar[XB_XCNT(j)]); sum += c; cnt += (c > 0u) ? 1u : 0u; mine = (j == x) ? c : mine; }
        if (sum == G) break;
        __builtin_amdgcn_s_sleep(1);
        if ((++sp & 255u) == 0u) { if (xb_ld(&bar[XB_TMO])) break; if (sp > XB_SPIN_CAP) { atomicAdd(&bar[XB_TMO], 1u); break; } }
    }
    nloc = mine > 0u ? mine : 1u; nx = cnt > 0u ? cnt : 1u;
}

__device__ __forceinline__ void xcd_barrier(const XcdBarrier& b) {
    asm volatile("s_waitcnt vmcnt(0)" ::: "memory");
    __syncthreads();
    if (threadIdx.x == 0) {
        unsigned* bar = b.bar; unsigned bx = b.x; asm volatile("" : "+s"(bx));
        __builtin_amdgcn_s_waitcnt(0);
        unsigned nloc = b.st[0], nx = b.st[1];
        if (nloc == 0u) { xcd_barrier_complete(bar, bx, b.G, nloc, nx); b.st[0] = nloc; b.st[1] = nx; }
        const unsigned old = xb_add(&bar[XB_XSUB(bx)], 1u);
        const unsigned gen = old / nloc;
        if (old + 1u == (gen + 1u) * nloc) {
            __builtin_amdgcn_fence(__ATOMIC_RELEASE, "agent");
            asm volatile("s_waitcnt vmcnt(0)" ::: "memory");
            const unsigned og = xb_add(&bar[XB_TOP], 1u);
            const unsigned tg = og / nx;
            if (og + 1u == (tg + 1u) * nx) xb_add(&bar[XB_TOPGEN], 1u);
            else XB_SPIN(xb_ld(&bar[XB_TOPGEN]) == tg, bar);
            __builtin_amdgcn_fence(__ATOMIC_ACQUIRE, "agent");
            xb_add(&bar[XB_XGEN(bx)], 1u);
            asm volatile("s_waitcnt vmcnt(0)" ::: "memory");
        } else {
            XB_SPIN(xb_ld(&bar[XB_XGEN(bx)]) == gen, bar);
            __builtin_amdgcn_fence(__ATOMIC_ACQUIRE, "agent");
            asm volatile("s_waitcnt vmcnt(0)" ::: "memory");
        }
    }
    __syncthreads();
}

using pg8::Unit;
template <bool RS> struct EpiAct {
    static constexpr bool PERM = true, AFTER_DRAIN = false;
    bf16_t* O; const float* sq;
    DI void operator()(const f32x4 (&acc)[2][2][4][2], const Unit& u, int wr, int wc, int fr, int fq) const {
        const int row0 = u.pm * 256 + wr * 64 + fr, col = u.pn * 128 + wc * 32 + 8 * fq;
        float rs[2][4];
#pragma unroll
        for (int ai = 0; ai < 2; ++ai)
#pragma unroll
            for (int m = 0; m < 4; ++m) rs[ai][m] = RS ? sq[row0 + ai * 128 + m * 16] : 1.f;
        SCHED_FENCE();
#pragma unroll
        for (int ai = 0; ai < 2; ++ai)
#pragma unroll
            for (int m = 0; m < 4; ++m) {
                const int row = row0 + ai * 128 + m * 16; float r1 = 1.f; if (RS) r1 = rsqrtf(rs[ai][m] * (1.f / 1024.f) + EPS);
                f32x4 o[2];
#pragma unroll
                for (int n = 0; n < 2; ++n)
#pragma unroll
                    for (int e = 0; e < 4; ++e) o[n][e] = silu(acc[ai][0][m][n][e] * r1) * (acc[ai][1][m][n][e] * r1);
                *(u32x4*)(O + (((size_t)(row >> 8) * (FF / 64) + (col >> 6)) * 256 + (row & 255)) * 64 + (col & 63)) = pack8(o[0], o[1]);
            }
    }
};
template <bool BF> struct EpiRes {
    static constexpr bool PERM = true, AFTER_DRAIN = false;
    const void* base; float* out; bf16_t* ob; float* sq; float scale;
    DI void operator()(const f32x4 (&acc)[2][2][4][2], const Unit& u, int wr, int wc, int fr, int fq) const {
        const int row0 = u.pm * 256 + wr * 64 + fr;
        constexpr int MB = BF ? 4 : 2;
#pragma unroll
        for (int ai = 0; ai < 2; ++ai)
#pragma unroll
        for (int m0 = 0; m0 < 4; m0 += MB) {
            f32x4 b0[MB][2], b1[MB][2]; u32x4 bw[MB][2];
            SCHED_FENCE();
#pragma unroll
            for (int mm = 0; mm < MB; ++mm)
#pragma unroll
                for (int bj = 0; bj < 2; ++bj) { const size_t off = (size_t)(row0 + ai * 128 + (m0 + mm) * 16) * DM + u.pn * 256 + bj * 128 + wc * 32 + 8 * fq;
                    if (BF) bw[mm][bj] = *(const u32x4*)((const bf16_t*)base + off);
                    else { b0[mm][bj] = *(const f32x4*)((const float*)base + off); b1[mm][bj] = *(const f32x4*)((const float*)base + off + 4); } }
            SCHED_FENCE();
#pragma unroll
            for (int mm = 0; mm < MB; ++mm) {
                const int m = m0 + mm; const int row = row0 + ai * 128 + m * 16; float ss = 0.f;
#pragma unroll
                for (int bj = 0; bj < 2; ++bj) {
                    const size_t off = (size_t)row * DM + u.pn * 256 + bj * 128 + wc * 32 + 8 * fq;
                    f32x4 c0, c1; if (BF) unpack8(bw[mm][bj], c0, c1); else { c0 = b0[mm][bj]; c1 = b1[mm][bj]; }
                    const f32x4 v0 = c0 + acc[ai][bj][m][0] * scale, v1 = c1 + acc[ai][bj][m][1] * scale;
                    if (out) { *(f32x4*)(out + off) = v0; *(f32x4*)(out + off + 4) = v1; }
                    if (ob) *(u32x4*)(ob + off) = pack8(v0, v1);
                    ss += (v0[0] * v0[0] + v0[1] * v0[1]) + (v0[2] * v0[2] + v0[3] * v0[3]) + (v1[0] * v1[0] + v1[1] * v1[1]) + (v1[2] * v1[2] + v1[3] * v1[3]);
                }
                if (sq) { ss += __shfl_xor(ss, 16); ss += __shfl_xor(ss, 32); if (fq == 0) atomicAdd(sq + row, ss); }
            }
        }
    }
};
struct EpiWin {
    static constexpr bool PERM = true, AFTER_DRAIN = false;
    const float* sq; bf16_t* UQKV; bf16_t* G; const float* gqk; float* out;
    DI void operator()(const f32x4 (&acc)[2][2][4][2], const Unit& u, int wr, int wc, int fr, int fq) const {
        const int row0 = u.pm * 256 + wr * 64 + fr, pn = u.pn;
        const int kind = (pn - 2) / 3, g = (pn - 2) % 3;
        float rsq[2][4]; f32x4 gn[2][2];
#pragma unroll
        for (int ai = 0; ai < 2; ++ai)
#pragma unroll
            for (int m = 0; m < 4; ++m) rsq[ai][m] = sq[row0 + ai * 128 + m * 16];
        if (pn >= 2 && pn < 8) { const float* gp = gqk + kind * 192 + g * 64 + 8 * fq;
#pragma unroll
            for (int bj = 0; bj < 2; ++bj) { gn[bj][0] = *(const f32x4*)(gp + bj * 32); gn[bj][1] = *(const f32x4*)(gp + bj * 32 + 4); } }
        else { const f32x4 one = {1.f, 1.f, 1.f, 1.f}; gn[0][0] = one; gn[0][1] = one; gn[1][0] = one; gn[1][1] = one; }
        SCHED_FENCE();
#pragma unroll
        for (int ai = 0; ai < 2; ++ai)
#pragma unroll
            for (int m = 0; m < 4; ++m) {
                const int row = row0 + ai * 128 + m * 16; const float rs = rsqrtf(rsq[ai][m] * (1.f / 1024.f) + EPS);
                f32x4 v[2][2];
#pragma unroll
                for (int bj = 0; bj < 2; ++bj)
#pragma unroll
                    for (int n = 0; n < 2; ++n) v[bj][n] = acc[ai][bj][m][n] * rs;
                if (pn < 2) {
#pragma unroll
                    for (int bj = 0; bj < 2; ++bj) *(u32x4*)(UQKV + (size_t)row * 512 + pn * 256 + wc * 64 + bj * 32 + 8 * fq) = pack8(v[bj][0], v[bj][1]);
                } else if (pn < 11) {
                    float rn = 1.f;
                    if (kind < 2) {
                        float ss = 0.f;
#pragma unroll
                        for (int bj = 0; bj < 2; ++bj)
#pragma unroll
                            for (int n = 0; n < 2; ++n) ss += (v[bj][n][0] * v[bj][n][0] + v[bj][n][1] * v[bj][n][1]) + (v[bj][n][2] * v[bj][n][2] + v[bj][n][3] * v[bj][n][3]);
                        ss += __shfl_xor(ss, 16); ss += __shfl_xor(ss, 32);
                        rn = rsqrtf(ss * (1.f / 64.f) + EPS) * (kind == 0 ? QSCALE : 1.f);
                    }
                    const int t = row & (SEQ - 1), b = row >> 13; const int w = g == 0 ? 128 : (g == 1 ? 512 : 2048);
                    const size_t kvo = g == 0 ? O_KVP0 : (g == 1 ? O_KVP1 : O_KVP2);
                    bf16_t* dstb = UQKV + (size_t)MT * 512 + (size_t)kind * ((size_t)MT * 768) + (size_t)row * 768 + g * 256 + wc * 64 + 8 * fq;
#pragma unroll
                    for (int bj = 0; bj < 2; ++bj) {
                        const f32x4 a0 = v[bj][0] * rn * gn[bj][0], a1 = v[bj][1] * rn * gn[bj][1];
                        *(u32x4*)(dstb + bj * 32) = pack8(a0, a1);
                        if (kind >= 1 && t >= SEQ - w) { float* o = out + kvo + ((size_t)(b * w + (t - (SEQ - w))) * 2 + (kind - 1)) * 256 + wc * 64 + bj * 32 + 8 * fq; *(f32x4*)o = a0; *(f32x4*)(o + 4) = a1; }
                    }
                } else {
#pragma unroll
                    for (int bj = 0; bj < 2; ++bj) {
                        f32x4 a0, a1;
#pragma unroll
                        for (int e = 0; e < 4; ++e) { a0[e] = sigm(v[bj][0][e]); a1[e] = sigm(v[bj][1][e]); }
                        *(u32x4*)(G + (size_t)row * 2048 + (pn - 11) * 256 + wc * 64 + bj * 32 + 8 * fq) = pack8(a0, a1);
                    }
                }
            }
    }
};
struct EpiGlu {
    static constexpr bool PERM = true, AFTER_DRAIN = false;
    const bf16_t* YG; const float* bias; bf16_t* YY;
    DI void operator()(const f32x4 (&acc)[2][2][4][2], const Unit& u, int wr, int wc, int fr, int fq) const {
        const int row0 = u.pm * 256 + wr * 64 + fr;
        f32x4 bb[2][2];
#pragma unroll
        for (int bj = 0; bj < 2; ++bj) { const int col = u.pn * 256 + bj * 128 + wc * 32 + 8 * fq; bb[bj][0] = *(const f32x4*)(bias + col); bb[bj][1] = *(const f32x4*)(bias + col + 4); }
#pragma unroll
        for (int ai = 0; ai < 2; ++ai) {
            u32x4 yw[2][4][2];
            SCHED_FENCE();
#pragma unroll
            for (int bj = 0; bj < 2; ++bj)
#pragma unroll
                for (int m = 0; m < 4; ++m) yw[ai][m][bj] = *(const u32x4*)(YG + (size_t)(row0 + ai * 128 + m * 16) * 512 + u.pn * 256 + bj * 128 + wc * 32 + 8 * fq);
            SCHED_FENCE();
#pragma unroll
            for (int m = 0; m < 4; ++m) {
                const int row = row0 + ai * 128 + m * 16;
#pragma unroll
                for (int bj = 0; bj < 2; ++bj) {
                    const int col = u.pn * 256 + bj * 128 + wc * 32 + 8 * fq;
                    f32x4 y0, y1; unpack8(yw[ai][m][bj], y0, y1);
                    f32x4 o0, o1;
#pragma unroll
                    for (int e = 0; e < 4; ++e) { o0[e] = y0[e] * sigm(acc[ai][bj][m][0][e] + bb[bj][0][e]); o1[e] = y1[e] * sigm(acc[ai][bj][m][1][e] + bb[bj][1][e]); }
                    *(u32x4*)(YY + (size_t)row * 768 + col) = pack8(o0, o1);
                }
            }
        }
    }
};
struct EpiGateScale {
    static constexpr bool PERM = true, AFTER_DRAIN = false;
    const bf16_t* G; bf16_t* T;
    DI void operator()(const f32x4 (&acc)[2][2][4][2], const Unit& u, int wr, int wc, int fr, int fq) const {
        const int row0 = u.pm * 256 + wr * 64 + fr;
#pragma unroll
        for (int ai = 0; ai < 2; ++ai) {
            u32x4 gw[2][4][2];
            SCHED_FENCE();
#pragma unroll
            for (int m = 0; m < 4; ++m)
#pragma unroll
                for (int bj = 0; bj < 2; ++bj) gw[ai][m][bj] = *(const u32x4*)(G + (size_t)(row0 + ai * 128 + m * 16) * 2048 + 1024 + u.pn * 256 + bj * 128 + wc * 32 + 8 * fq);
            SCHED_FENCE();
#pragma unroll
            for (int m = 0; m < 4; ++m) {
                const int row = row0 + ai * 128 + m * 16;
#pragma unroll
                for (int bj = 0; bj < 2; ++bj) { const int col = u.pn * 256 + bj * 128 + wc * 32 + 8 * fq;
                    f32x4 a0, a1; unpack8(gw[ai][m][bj], a0, a1);
                    *(u32x4*)(T + (size_t)row * DM + col) = pack8(a0 * acc[ai][bj][m][0], a1 * acc[ai][bj][m][1]); }
            }
        }
    }
};
struct EpiMix2 {
    static constexpr bool PERM = true, AFTER_DRAIN = false;
    const bf16_t* G; const bf16_t* T; bf16_t* O;
    DI void operator()(const f32x4 (&acc)[2][2][4][2], const Unit& u, int wr, int wc, int fr, int fq) const {
        const int row0 = u.pm * 256 + wr * 64 + fr;
#pragma unroll
        for (int ai = 0; ai < 2; ++ai)
#pragma unroll
        for (int mh = 0; mh < 4; mh += 2) {
            u32x4 gw[4][2], tw[4][2];
            SCHED_FENCE();
#pragma unroll
            for (int m = mh; m < mh + 2; ++m)
#pragma unroll
                for (int bj = 0; bj < 2; ++bj) { const int row = row0 + ai * 128 + m * 16, col = u.pn * 256 + bj * 128 + wc * 32 + 8 * fq;
                    gw[m][bj] = *(const u32x4*)(G + (size_t)row * 2048 + col); tw[m][bj] = *(const u32x4*)(T + (size_t)row * DM + col); }
            SCHED_FENCE();
#pragma unroll
            for (int m = mh; m < mh + 2; ++m) {
                const int row = row0 + ai * 128 + m * 16;
#pragma unroll
                for (int bj = 0; bj < 2; ++bj) { const int col = u.pn * 256 + bj * 128 + wc * 32 + 8 * fq;
                    f32x4 s0, s1, t0, t1; unpack8(gw[m][bj], s0, s1); unpack8(tw[m][bj], t0, t1);
                    *(u32x4*)(O + (size_t)row * DM + col) = pack8(s0 * acc[ai][bj][m][0] + t0, s1 * acc[ai][bj][m][1] + t1); }
            }
        }
    }
};

#define MFMA32(a, b, c) __builtin_amdgcn_mfma_f32_32x32x16_bf16((a), (b), (c), 0, 0, 0)
#define MFMA16(a, b, c) __builtin_amdgcn_mfma_f32_16x16x32_bf16((a), (b), (c), 0, 0, 0)
DI bf16x8 frag_from_f32(f32x4 a, f32x4 b) { return __builtin_bit_cast(bf16x8, pack8(a, b)); }

struct ProvBf16 { const bf16_t* A; int ld; static constexpr bool SQ = false; static constexpr int BATCH = 11;
    struct Raw { bf16x8 v; };
    DI Raw load(int r, int k) const { Raw w; w.v = *(const bf16x8*)(A + (size_t)r * ld + k); return w; }
    DI bf16x8 cvt(const Raw& w, float&) const { return w.v; } };
struct ProvAct { const float* raw; static constexpr bool SQ = false; static constexpr int BATCH = 4;
    struct Raw { f32x4 g0, g1, u0, u1; };
    DI Raw load(int r, int k) const { const float* p = raw + (size_t)r * 5632 + 256 * (k >> 7) + (k & 127); Raw w; w.g0 = *(const f32x4*)p; w.g1 = *(const f32x4*)(p + 4); w.u0 = *(const f32x4*)(p + 128); w.u1 = *(const f32x4*)(p + 132); return w; }
    DI bf16x8 cvt(const Raw& w, float&) const { f32x4 a, b;
#pragma unroll
        for (int e = 0; e < 4; ++e) { a[e] = silu(w.g0[e]) * w.u0[e]; b[e] = silu(w.g1[e]) * w.u1[e]; }
        return frag_from_f32(a, b); } };
template <bool HASO> struct ProvX { const float* xs; const float* rawd; const float* rawo; static constexpr bool SQ = true; static constexpr int BATCH = 2;
    struct Raw { f32x4 x0, x1, d0, d1, o0, o1; };
    DI Raw load(int r, int k) const { const size_t o = (size_t)r * DM + k; Raw w; w.x0 = *(const f32x4*)(xs + o); w.x1 = *(const f32x4*)(xs + o + 4); w.d0 = *(const f32x4*)(rawd + o); w.d1 = *(const f32x4*)(rawd + o + 4);
        if (HASO) { w.o0 = *(const f32x4*)(rawo + o); w.o1 = *(const f32x4*)(rawo + o + 4); } return w; }
    DI bf16x8 cvt(const Raw& w, float& ss) const { f32x4 a = w.x0 + w.d0 * 0.5f, b = w.x1 + w.d1 * 0.5f; if (HASO) { a += w.o0; b += w.o1; }
        ss += (a[0] * a[0] + a[1] * a[1]) + (a[2] * a[2] + a[3] * a[3]) + (b[0] * b[0] + b[1] * b[1]) + (b[2] * b[2] + b[3] * b[3]);
        return frag_from_f32(a, b); } };
struct ProvYY { const bf16_t* YG; const float* rawglu; const float* bias; const bf16_t* YY; static constexpr bool SQ = false; static constexpr int BATCH = 3;
    struct Raw { u32x4 y; f32x4 z0, z1, b0, b1; };
    DI Raw load(int r, int k) const { Raw w; const f32x4 z = {0.f, 0.f, 0.f, 0.f}; w.z0 = z; w.z1 = z; w.b0 = z; w.b1 = z;
        if (k >= 512) { w.y = *(const u32x4*)(YY + (size_t)(NPR + r) * 768 + k); }
        else { w.y = *(const u32x4*)(YG + (size_t)(NPR + r) * 512 + k); w.z0 = *(const f32x4*)(rawglu + r * 512 + k); w.z1 = *(const f32x4*)(rawglu + r * 512 + k + 4); w.b0 = *(const f32x4*)(bias + k); w.b1 = *(const f32x4*)(bias + k + 4); }
        return w; }
    DI bf16x8 cvt(const Raw& w, float&, int k) const { return __builtin_bit_cast(bf16x8, w.y); }
    DI bf16x8 cvt(const Raw& w, float&) const { return __builtin_bit_cast(bf16x8, w.y); }
    DI bf16x8 cvtk(const Raw& w, int k) const {
        if (k >= 512) return __builtin_bit_cast(bf16x8, w.y);
        f32x4 y0, y1; unpack8(w.y, y0, y1); f32x4 a, b;
#pragma unroll
        for (int e = 0; e < 4; ++e) { a[e] = y0[e] * sigm(w.z0[e] + w.b0[e]); b[e] = y1[e] * sigm(w.z1[e] + w.b1[e]); }
        return frag_from_f32(a, b); } };
struct ProvMixed { const float* raw3; const float* rawms; const float* rawma; static constexpr bool SQ = false; static constexpr int BATCH = 2;
    struct Raw { f32x4 s0, s1, a0, a1, m0, m1, n0, n1; };
    DI Raw load(int r, int k) const { const float* gs = raw3 + (size_t)r * INW + l2p(2816 + k); const float* ga = raw3 + (size_t)r * INW + l2p(3840 + k);
        Raw w; w.s0 = *(const f32x4*)gs; w.s1 = *(const f32x4*)(gs + 4); w.a0 = *(const f32x4*)ga; w.a1 = *(const f32x4*)(ga + 4);
        w.m0 = *(const f32x4*)(rawms + r * DM + k); w.m1 = *(const f32x4*)(rawms + r * DM + k + 4); w.n0 = *(const f32x4*)(rawma + r * DM + k); w.n1 = *(const f32x4*)(rawma + r * DM + k + 4); return w; }
    DI bf16x8 cvt(const Raw& w, float&) const { f32x4 a, b;
#pragma unroll
        for (int e = 0; e < 4; ++e) { a[e] = sigm(w.s0[e]) * w.m0[e] + sigm(w.a0[e]) * w.n0[e]; b[e] = sigm(w.s1[e]) * w.m1[e] + sigm(w.a1[e]) * w.n1[e]; }
        return frag_from_f32(a, b); } };
template <class P> struct ProvTraits { static constexpr bool NEEDK = false; };
template <> struct ProvTraits<ProvYY> { static constexpr bool NEEDK = true; };
struct SEpiRaw { float* dst; int ld; DI void operator()(int row, int col, float v, float) const { dst[(size_t)row * ld + col] = v; } };
struct SEpiRawScaled { float* dst; int ld; DI void operator()(int row, int col, float v, float rs) const { dst[(size_t)row * ld + col] = v * rs; } };
struct SEpiGluS { const bf16_t* YG; const float* bias; bf16_t* dst; DI void operator()(int row, int col, float v, float) const { dst[row * 512 + col] = f2bf(bf2f(YG[(size_t)(NPR + row) * 512 + col]) * sigm(v + bias[col])); } };
struct SEpiMixS { const float* raw3; const float* rawma; bf16_t* dst; DI void operator()(int row, int col, float v, float) const {
    const float gs = sigm(raw3[(size_t)row * INW + l2p(2816 + col)]), ga = sigm(raw3[(size_t)row * INW + l2p(3840 + col)]); dst[row * DM + col] = f2bf(gs * v + ga * rawma[row * DM + col]); } };
struct SEpiFinal { const float* xs; const float* rawd; const float* rawo; float* out; DI void operator()(int row, int col, float v, float) const { const size_t o = (size_t)row * DM + col; out[o] = xs[o] + 0.5f * rawd[o] + rawo[o] + 0.5f * v; } };

template <int N, int K, class Prov, class SEpi>
DI void skinny_phase(LAS unsigned char* lds, const bf16_t* Bt, const Prov& P, const SEpi& E) {
    const int tid = otid(), wave = tid >> 6, lane = tid & 63, r = lane & 31, hh = lane >> 5, G = gridDim.x;
    LAS float* red = (LAS float*)lds;
    LAS float* sqp = (LAS float*)(lds + 32768);
    LAS float* rsd = (LAS float*)(lds + 32768 + 2048);
    constexpr int ntiles = N / 32, kper = K / 8, NIT = kper / 32, BATCH = Prov::BATCH;
    for (int tile = G - 1 - (int)blockIdx.x; tile < ntiles; tile += G) {
        const int n0 = tile * 32;
        f32x16 acc = {};
        float ss = 0.f;
        const bf16_t* bp = Bt + (size_t)(n0 + r) * K + wave * kper + 16 * hh;
        const int kbase = wave * kper + 16 * hh;
#pragma unroll
        for (int i0 = 0; i0 < NIT; i0 += BATCH) {
            typename Prov::Raw ra[BATCH][2]; bf16x8 rb[BATCH][2];
            SCHED_FENCE();
#pragma unroll
            for (int u = 0; u < BATCH; ++u) if (i0 + u < NIT) { const int k = kbase + 32 * (i0 + u);
                ra[u][0] = P.load(r, k); ra[u][1] = P.load(r, k + 8); rb[u][0] = *(const bf16x8*)(bp + 32 * (i0 + u)); rb[u][1] = *(const bf16x8*)(bp + 32 * (i0 + u) + 8); }
            SCHED_FENCE();
#pragma unroll
            for (int u = 0; u < BATCH; ++u) if (i0 + u < NIT) { const int k = kbase + 32 * (i0 + u);
                bf16x8 a0, a1;
                if constexpr (ProvTraits<Prov>::NEEDK) { a0 = P.cvtk(ra[u][0], k); a1 = P.cvtk(ra[u][1], k + 8); } else { a0 = P.cvt(ra[u][0], ss); a1 = P.cvt(ra[u][1], ss); }
                acc = MFMA32(a0, rb[u][0], acc); acc = MFMA32(a1, rb[u][1], acc); }
        }
#pragma unroll
        for (int i = 0; i < 16; ++i) red[wave * 1024 + ((i & 3) + 8 * (i >> 2) + 4 * hh) * 32 + r] = acc[i];
        if (Prov::SQ) sqp[(wave * 2 + hh) * 32 + r] = ss;
        __syncthreads();
        if (Prov::SQ) { if (tid < 32) { float sm = 0.f; for (int j = 0; j < 16; ++j) sm += sqp[j * 32 + tid]; rsd[tid] = rsqrtf(sm * (1.f / 1024.f) + EPS); } __syncthreads(); }
#pragma unroll
        for (int h2 = 0; h2 < 2; ++h2) { const int e = tid + 512 * h2; float sm = 0.f;
#pragma unroll
            for (int w = 0; w < 8; ++w) sm += red[w * 1024 + e];
            E(e >> 5, n0 + (e & 31), sm, Prov::SQ ? rsd[e >> 5] : 1.f); }
        __syncthreads();
    }
}

template <int K, class Prov>
DI void skinny_gu_phase(LAS unsigned char* lds, const bf16_t* Bt, const Prov& P, bf16_t* act) {
    const int tid = otid(), wave = tid >> 6, lane = tid & 63, r = lane & 31, hh = lane >> 5, G = gridDim.x;
    LAS float* red = (LAS float*)lds;
    LAS float* sqp = (LAS float*)(lds + 32768);
    LAS float* rsd = (LAS float*)(lds + 32768 + 2048);
    constexpr int ntiles = FF / 16, kper = K / 8, NIT = kper / 32, BATCH = Prov::BATCH;
    for (int tile = G - 1 - (int)blockIdx.x; tile < ntiles; tile += G) {
        f32x16 acc = {};
        float ss = 0.f;
        const int brow = 256 * (tile >> 3) + 16 * (tile & 7) + (r < 16 ? r : 112 + r);
        const bf16_t* bp = Bt + (size_t)brow * K + wave * kper + 16 * hh;
        const int kbase = wave * kper + 16 * hh;
#pragma unroll
        for (int i0 = 0; i0 < NIT; i0 += BATCH) {
            typename Prov::Raw ra[BATCH][2]; bf16x8 rb[BATCH][2];
            SCHED_FENCE();
#pragma unroll
            for (int u = 0; u < BATCH; ++u) if (i0 + u < NIT) { const int k = kbase + 32 * (i0 + u);
                ra[u][0] = P.load(r, k); ra[u][1] = P.load(r, k + 8); rb[u][0] = *(const bf16x8*)(bp + 32 * (i0 + u)); rb[u][1] = *(const bf16x8*)(bp + 32 * (i0 + u) + 8); }
            SCHED_FENCE();
#pragma unroll
            for (int u = 0; u < BATCH; ++u) if (i0 + u < NIT) {
                const bf16x8 a0 = P.cvt(ra[u][0], ss), a1 = P.cvt(ra[u][1], ss);
                acc = MFMA32(a0, rb[u][0], acc); acc = MFMA32(a1, rb[u][1], acc); }
        }
#pragma unroll
        for (int i = 0; i < 16; ++i) red[wave * 1024 + ((i & 3) + 8 * (i >> 2) + 4 * hh) * 32 + r] = acc[i];
        if (Prov::SQ) sqp[(wave * 2 + hh) * 32 + r] = ss;
        __syncthreads();
        if (Prov::SQ) { if (tid < 32) { float sm = 0.f; for (int j = 0; j < 16; ++j) sm += sqp[j * 32 + tid]; rsd[tid] = rsqrtf(sm * (1.f / 1024.f) + EPS); } __syncthreads(); }
        { const int row = tid >> 4, c = tid & 15; float sg = 0.f, su = 0.f;
#pragma unroll
          for (int w = 0; w < 8; ++w) { sg += red[w * 1024 + row * 32 + c]; su += red[w * 1024 + row * 32 + 16 + c]; }
          const float rs = Prov::SQ ? rsd[row] : 1.f;
          act[(size_t)row * FF + 16 * tile + c] = f2bf(silu(sg * rs) * (su * rs)); }
        __syncthreads();
    }
}

DI int maprow(int mode, int c0) {
    if (mode == 0) return c0;
    if (mode == 1) return 256 * (c0 >> 7) + (c0 & 127);
    if (mode == 2) return 256 * (c0 >> 7) + 128 + (c0 & 127);
    return (c0 & ~255) | (((c0 >> 5) & 1) << 7) | (((c0 >> 6) & 3) << 5);
}
DI void tr_item(const float* W, int N, const float* g, bf16_t* dst, int ldd, int kofs, int mode, int item, LAS float* scr, int lane) {
    const int nblk = N / 32, kb = item / nblk, nb = item % nblk, k0 = 64 * kb, c0 = 32 * nb, p0 = maprow(mode, c0);
    const int kr = lane >> 3, c4 = lane & 7;
    f32x4 v[8];
#pragma unroll
    for (int i = 0; i < 8; ++i) v[i] = *(const f32x4*)(W + (size_t)(k0 + 8 * i + kr) * N + c0 + 4 * c4);
    if (g) {
#pragma unroll
        for (int i = 0; i < 8; ++i) v[i] = v[i] * g[k0 + 8 * i + kr];
    }
#pragma unroll
    for (int i = 0; i < 8; ++i) { LAS float* sp = scr + (8 * i + kr) * 33 + 4 * c4; sp[0] = v[i][0]; sp[1] = v[i][1]; sp[2] = v[i][2]; sp[3] = v[i][3]; }
    LDS_WAIT();
    const int c = lane & 7;
#pragma unroll
    for (int j = 0; j < 4; ++j) { const int n = (lane >> 3) + 8 * j; const LAS float* sq = scr + (8 * c) * 33 + n;
        u32x4 o; o.x = pk2(sq[0 * 33], sq[1 * 33]); o.y = pk2(sq[2 * 33], sq[3 * 33]); o.z = pk2(sq[4 * 33], sq[5 * 33]); o.w = pk2(sq[6 * 33], sq[7 * 33]);
        *(u32x4*)(dst + (size_t)(p0 + n) * ldd + kofs + k0 + 8 * c) = o; }
    LDS_WAIT();
}
DI void norm_rows2_bf16(const float* x0, const float* x1, const float* g, bf16_t* o0, bf16_t* o1, int lane) {
    const f32x4* xr0 = (const f32x4*)x0 + lane; const f32x4* xr1 = (const f32x4*)x1 + lane; const f32x4* gr = (const f32x4*)g + lane;
    f32x4 v[2][4]; float s0 = 0.f, s1 = 0.f;
#pragma unroll
    for (int j = 0; j < 4; ++j) { v[0][j] = xr0[64 * j]; v[1][j] = xr1[64 * j]; }
    SCHED_FENCE();
#pragma unroll
    for (int j = 0; j < 4; ++j) { s0 += (v[0][j][0] * v[0][j][0] + v[0][j][1] * v[0][j][1]) + (v[0][j][2] * v[0][j][2] + v[0][j][3] * v[0][j][3]); s1 += (v[1][j][0] * v[1][j][0] + v[1][j][1] * v[1][j][1]) + (v[1][j][2] * v[1][j][2] + v[1][j][3] * v[1][j][3]); }
    const float r0 = rsqrtf(wave_sum(s0) * (1.f / 1024.f) + EPS), r1 = rsqrtf(wave_sum(s1) * (1.f / 1024.f) + EPS);
    u32x2* p0 = (u32x2*)o0 + lane; u32x2* p1 = (u32x2*)o1 + lane;
#pragma unroll
    for (int j = 0; j < 4; ++j) { const f32x4 gg = gr[64 * j]; const f32x4 w0 = v[0][j] * r0 * gg, w1 = v[1][j] * r1 * gg; u32x2 a, b; a.x = pk2(w0[0], w0[1]); a.y = pk2(w0[2], w0[3]); b.x = pk2(w1[0], w1[1]); b.y = pk2(w1[2], w1[3]); p0[64 * j] = a; p1[64 * j] = b; }
}

constexpr int KVR0 = 32 * 127, KVR1 = KVR0 + 32 * 511, KVR_ALL = KVR1 + 32 * 2047;
constexpr int KVQ = 4;
constexpr int KV_TAIL_P10 = 19984, KV_TAIL_P3 = 8592, KV_TAIL_ROWS = KV_TAIL_P10 + KV_TAIL_P3;
struct KvCopy { f32x4 t[KVQ][2]; f32x4* dp[KVQ]; };
template <int NQ> DI void kv_issue(KvCopy& k, const float* c0, const float* c1, const float* c2, float* out, int rowbase, int slot, int lane) {
#pragma unroll
    for (int q = 0; q < NQ; ++q) {
        const int R0 = rowbase + NQ * slot + q; const int R = R0 < KVR_ALL ? R0 : KVR_ALL - 1;
        const int g = R < KVR0 ? 0 : (R < KVR1 ? 1 : 2); const int Rl = R - (g == 0 ? 0 : (g == 1 ? KVR0 : KVR1));
        const int w = g == 0 ? 128 : (g == 1 ? 512 : 2048), wm1 = w - 1; const int b = g == 0 ? Rl / 127 : (g == 1 ? Rl / 511 : Rl / 2047), r = Rl - b * wm1;
        const f32x4* sp = (const f32x4*)(g == 0 ? c0 : (g == 1 ? c1 : c2)) + ((size_t)b * w + r + 1) * 128 + lane;
        f32x4* d = (f32x4*)(out + (g == 0 ? O_KVS0 : (g == 1 ? O_KVS1 : O_KVS2))) + ((size_t)b * w + r) * 128 + lane;
        k.dp[q] = R0 < KVR_ALL ? d : nullptr;
        k.t[q][0] = __builtin_nontemporal_load(sp); k.t[q][1] = __builtin_nontemporal_load(sp + 64);
    }
}
template <int NQ> DI void kv_commit(const KvCopy& k) {
#pragma unroll
    for (int q = 0; q < NQ; ++q) if (k.dp[q]) { __builtin_nontemporal_store(k.t[q][0], k.dp[q]); __builtin_nontemporal_store(k.t[q][1], k.dp[q] + 64); }
}

struct SsmPar { float abr, abi, fr, fi; };
DI SsmPar ssm_par(const float* a_re, const float* a_im, const float* log_dt, int g, int p) {
    const float ar = a_re[g * 64 + p], ai = a_im[g * 64 + p], dt = expf(log_dt[g]);
    const float mag = expf(ar * dt); SsmPar o; o.abr = mag * cosf(ai * dt); o.abi = mag * sinf(ai * dt);
    const float inv = 1.0f / (ar * ar + ai * ai);
    o.fr = ((o.abr - 1.0f) * ar + o.abi * ai) * inv; o.fi = (o.abi * ar - (o.abr - 1.0f) * ai) * inv; return o;
}
struct SsmIn { const float *a_re, *a_im, *log_dt, *b_re, *b_im, *c_re, *c_im, *dsk; };

constexpr size_t WS_SSMT = 576 * 1024, SSMT_TC = 32 * 8 * 64 * 16, SSMT_TA = SSMT_TC + 32 * 4 * 64 * 16;
DI void ssm_build_tables(const SsmIn& W, unsigned char* tb, int g, int lane) {
    const int l15 = lane & 15, quad = lane >> 4;
    { const SsmPar sp = ssm_par(W.a_re, W.a_im, W.log_dt, g, lane); f32x2 ab = {sp.abr, sp.abi}; ((f32x2*)(tb + SSMT_TA))[g * 64 + lane] = ab; }
#pragma unroll
    for (int nt = 0; nt < 8; ++nt) {
        const int p = 8 * nt + (l15 >> 1), ri = l15 & 1; const SsmPar sp = ssm_par(W.a_re, W.a_im, W.log_dt, g, p);
        f32x4 v0 = {0, 0, 0, 0}, v1 = v0;
        if (quad < 2) { const float* br = W.b_re + ((size_t)(g * 64 + p)) * 16 + 8 * quad; const float* bi = W.b_im + ((size_t)(g * 64 + p)) * 16 + 8 * quad;
            const f32x4 r0 = *(const f32x4*)br, r1 = *(const f32x4*)(br + 4), i0 = *(const f32x4*)bi, i1 = *(const f32x4*)(bi + 4);
            if (ri == 0) { v0 = r0 * sp.fr - i0 * sp.fi; v1 = r1 * sp.fr - i1 * sp.fi; } else { v0 = i0 * sp.fr + r0 * sp.fi; v1 = i1 * sp.fr + r1 * sp.fi; } }
        ((bf16x8*)tb)[(g * 8 + nt) * 64 + lane] = frag_from_f32(v0, v1);
    }
#pragma unroll
    for (int s2 = 0; s2 < 4; ++s2) { const int p0 = 16 * s2 + 4 * quad; const float* cr = W.c_re + ((size_t)(g * 16 + l15)) * 64 + p0; const float* ci = W.c_im + ((size_t)(g * 16 + l15)) * 64 + p0;
        const f32x4 r = *(const f32x4*)cr, i = *(const f32x4*)ci;
        const f32x4 c0 = {r[0], -i[0], r[1], -i[1]}, c1 = {r[2], -i[2], r[3], -i[3]};
        ((bf16x8*)(tb + SSMT_TC))[(g * 4 + s2) * 64 + lane] = frag_from_f32(c0, c1); }
}
struct KvSrc { const float *c0, *c1, *c2; float* out; int slotbase; };

DI void kvshift_rows(const float* c0, const float* c1, const float* c2, float* out, int r_lo, int r_hi, int wk, int nwk, int wave, int lane) {
    const int stride = nwk * 8;
    for (int R0 = r_lo + wk * 8 + wave; R0 < r_hi; R0 += 8 * stride) {
        f32x4 t[8][2]; f32x4* dp[8];
#pragma unroll
        for (int q = 0; q < 8; ++q) {
            int R = R0 + q * stride; R = R < r_hi ? R : r_hi - 1;
            const int g = R < KVR0 ? 0 : (R < KVR1 ? 1 : 2); const int Rl = R - (g == 0 ? 0 : (g == 1 ? KVR0 : KVR1));
            const int w = g == 0 ? 128 : (g == 1 ? 512 : 2048), wm1 = w - 1; const int b = g == 0 ? Rl / 127 : (g == 1 ? Rl / 511 : Rl / 2047), r = Rl - b * wm1;
            const f32x4* sp = (const f32x4*)(g == 0 ? c0 : (g == 1 ? c1 : c2)) + ((size_t)b * w + r + 1) * 128 + lane;
            dp[q] = (f32x4*)(out + (g == 0 ? O_KVS0 : (g == 1 ? O_KVS1 : O_KVS2))) + ((size_t)b * w + r) * 128 + lane;
            t[q][0] = __builtin_nontemporal_load(sp); t[q][1] = __builtin_nontemporal_load(sp + 64);
        }
        SCHED_FENCE();
#pragma unroll
        for (int q = 0; q < 8; ++q) if (R0 + q * stride < r_hi) { __builtin_nontemporal_store(t[q][0], dp[q]); __builtin_nontemporal_store(t[q][1], dp[q] + 64); }
    }
}
DI void kvshift_tail(const float* c0, const float* c1, const float* c2, float* out, int nwg, int r_lo, int r_hi, int wave, int lane) {
    const int G = gridDim.x; const int first = nwg % G; const int wk = (int)blockIdx.x - first;
    if (wk >= 0) kvshift_rows(c0, c1, c2, out, r_lo, r_hi, wk, G - first, wave, lane);
}
template <bool PASS2>
DI void ssm_pass(LAS unsigned char* lds, const SsmIn& W, const unsigned char* TBL, const bf16_t* U, float* SEND, const float* SIN, bf16_t* YG, const KvSrc& KS, int vblk, int vG) {
    const int tid = otid(), wave = tid >> 6, lane = tid & 63, l15 = lane & 15, quad = lane >> 4;
    LAS float* Xs = (LAS float*)(lds + wave * 13312);
    LAS bf16_t* Ss = (LAS bf16_t*)(lds + wave * 13312 + 8448);
    LAS bf16_t* Us = (LAS bf16_t*)(lds + wave * 13312 + 12800);
    const int NGW = vG * 8, gw = vblk * 8 + wave;
    int gcur = -1; bf16x8 bfr[8]; bf16x8 cfr[4]; float abr = 0.f, abi = 0.f, dk = 0.f;
    for (int it = gw; it < 2 * NCH * 32; it += NGW) {
        const int g = it & 31, bc = it >> 5, b = bc >> 7, ch = bc & 127;
        KvCopy kc; kv_issue<2>(kc, KS.c0, KS.c1, KS.c2, KS.out, KS.slotbase, it, lane);
        const int rowc = b * SEQ + ch * TCH;
        bf16x8 uf[4];
#pragma unroll
        for (int sub = 0; sub < 4; ++sub) { uf[sub] = (bf16x8){0, 0, 0, 0, 0, 0, 0, 0}; if (quad < 2) uf[sub] = *(const bf16x8*)(U + (size_t)(rowc + 16 * sub + l15) * 512 + 16 * g + 8 * quad); }
        float sr = 0.f, si = 0.f;
        const size_t sbase = ((size_t)(b * NCH + ch) * 32 + g) * 128;
        if (PASS2) { sr = SIN[sbase + lane]; si = SIN[sbase + 64 + lane]; }
        __builtin_amdgcn_sched_barrier(0);
        if (g != gcur) {
            gcur = g;
            { const f32x2 ab = ((const f32x2*)(TBL + SSMT_TA))[g * 64 + lane]; abr = ab[0]; abi = ab[1]; }
#pragma unroll
            for (int q = 0; q < 8; ++q) bfr[q] = ((const bf16x8*)TBL)[(g * 8 + q) * 64 + lane];
            if (PASS2) {
#pragma unroll
                for (int s2 = 0; s2 < 4; ++s2) cfr[s2] = ((const bf16x8*)(TBL + SSMT_TC))[(g * 4 + s2) * 64 + lane];
                dk = W.dsk[g * 16 + l15];
            }
        }
#pragma unroll
        for (int sub = 0; sub < 4; ++sub) {
            const int row0 = rowc + 16 * sub;
            if (PASS2) { if (quad < 2) *(LAS bf16x8*)(Us + l15 * 16 + 8 * quad) = uf[sub]; }
#pragma unroll
            for (int nt = 0; nt < 8; ++nt) { f32x4 x = {0.f, 0.f, 0.f, 0.f}; x = MFMA16(uf[sub], bfr[nt], x);
#pragma unroll
                for (int j = 0; j < 4; ++j) Xs[(4 * quad + j) * 132 + 16 * nt + l15] = x[j]; }
            LDS_WAIT();
#pragma unroll
            for (int tok = 0; tok < 16; ++tok) {
                const f32x2 xx = *(const LAS f32x2*)(Xs + tok * 132 + 2 * lane);
                const float nr = abr * sr - abi * si + xx[0], ni = abr * si + abi * sr + xx[1]; sr = nr; si = ni;
                if (PASS2) *(LAS unsigned*)(Ss + tok * 136 + 2 * lane) = pk2(sr, si);
            }
            LDS_WAIT();
            if (PASS2) {
                f32x4 y = {0.f, 0.f, 0.f, 0.f};
#pragma unroll
                for (int s2 = 0; s2 < 4; ++s2) { const bf16x8 af = *(const LAS bf16x8*)(Ss + l15 * 136 + 32 * s2 + 8 * quad); y = MFMA16(af, cfr[s2], y); }
#pragma unroll
                for (int j = 0; j < 4; ++j) { const float uv = bf2f(Us[(4 * quad + j) * 16 + l15]); YG[(size_t)(row0 + 4 * quad + j) * 512 + 16 * g + l15] = f2bf(gelu_tanh(y[j] + dk * uv)); }
                LDS_WAIT();
            }
        }
        if (!PASS2) { SEND[sbase + lane] = sr; SEND[sbase + 64 + lane] = si; }
        kv_commit<2>(kc);
    }
}

DI void ssm_carry(const unsigned char* TBL, const float* SEND, float* SIN, float* out_re, float* out_im, int vblk, int vG) {
    for (int gt = vblk * 512 + otid(); gt < 2 * 32 * 64; gt += vG * 512) {
        const int b = gt >> 11, g = (gt >> 6) & 31, p = gt & 63;
        const f32x2 ab = ((const f32x2*)(TBL + SSMT_TA))[g * 64 + p];
        float tr = ab[0], ti = ab[1];
#pragma unroll
        for (int i = 0; i < 6; ++i) { const float nr = tr * tr - ti * ti, ni = 2.f * tr * ti; tr = nr; ti = ni; }
        float sr = 0.f, si = 0.f;
        for (int c0 = 0; c0 < NCH; c0 += 32) {
            float er[32], ei[32];
#pragma unroll
            for (int j = 0; j < 32; ++j) { const size_t o = ((size_t)(b * NCH + c0 + j) * 32 + g) * 128; er[j] = SEND[o + p]; ei[j] = SEND[o + 64 + p]; }
            SCHED_FENCE();
#pragma unroll
            for (int j = 0; j < 32; ++j) { const size_t o = ((size_t)(b * NCH + c0 + j) * 32 + g) * 128; SIN[o + p] = sr; SIN[o + 64 + p] = si;
                const float nr = tr * sr - ti * si + er[j], ni = tr * si + ti * sr + ei[j]; sr = nr; si = ni; }
        }
        out_re[gt] = sr; out_im[gt] = si;
    }
}

DI void attn_unit(int b, int g, int h, int dl, int rho, int m0, const bf16_t* Q, const bf16_t* K, const bf16_t* V, bf16_t* OG, float* ML, LAS bf16_t* Vs, int lane) {
    const int r = lane & 31, hh = lane >> 5; const int rowb = b * SEQ; const int co = g * 256 + h * 64;
    const int rowq = rowb + rho + ((m0 + r) << dl);
    bf16x8 qf[4]; bf16x8 kf[5][4];
    { const bf16x8* qp = (const bf16x8*)(Q + (size_t)rowq * 768 + co + 32 * hh);
#pragma unroll
      for (int s = 0; s < 4; ++s) qf[s] = qp[s]; }
#pragma unroll
    for (int kb = 0; kb < 5; ++kb) {
        int mk = m0 - 128 + 32 * kb + r; mk = mk < 0 ? 0 : mk;
        const bf16x8* kp = (const bf16x8*)(K + (size_t)(rowb + rho + (mk << dl)) * 768 + co + 32 * hh);
#pragma unroll
        for (int s = 0; s < 4; ++s) kf[kb][s] = kp[s];
    }
    const bf16_t* vbase = V + (size_t)(rowb + rho) * 768 + co + 8 * (lane & 7);
    u32x4 vreg[4];
#define ATT_VLOAD(kb_) do { _Pragma("unroll") for (int i_ = 0; i_ < 4; ++i_) { int kidx_ = m0 - 128 + 32 * (kb_) + 8 * i_ + (lane >> 3); kidx_ = kidx_ < 0 ? 0 : kidx_; \
        vreg[i_] = *(const u32x4*)(vbase + (size_t)(kidx_ << dl) * 768); } } while (0)
#define ATT_VSTORE(buf_) do { _Pragma("unroll") for (int i_ = 0; i_ < 4; ++i_) *(LAS u32x4*)(Vs + (buf_) * 2304 + (8 * i_ + (lane >> 3)) * 72 + 8 * (lane & 7)) = vreg[i_]; } while (0)
    SCHED_FENCE();
    f32x16 st[5];
#pragma unroll
    for (int kb = 0; kb < 5; ++kb) {
        f32x16 a = {};
#pragma unroll
        for (int s = 0; s < 4; ++s) a = MFMA32(kf[kb][s], qf[s], a);
        st[kb] = a;
    }
    SCHED_FENCE();
    ATT_VLOAD(0);
    SCHED_FENCE();
    float mx = -INFINITY; const bool early = m0 < 128;
#pragma unroll
    for (int kb = 0; kb < 5; ++kb)
#pragma unroll
        for (int i = 0; i < 16; ++i) {
            const int c = (i & 3) + 8 * (i >> 2) + 4 * hh; const int kidx = m0 - 128 + 32 * kb + c; const int j = r + 128 - 32 * kb - c;
            float v = st[kb][i];
            if (kb == 0) v = (j <= 128) ? v : -INFINITY;
            if (kb == 4) v = (j >= 0) ? v : -INFINITY;
            if (early) v = (kidx >= 0) ? v : -INFINITY;
            st[kb][i] = v; mx = fmaxf(mx, v);
        }
    mx = fmaxf(mx, __shfl_xor(mx, 32));
    float den = 0.f;
#pragma unroll
    for (int kb = 0; kb < 5; ++kb)
#pragma unroll
        for (int i = 0; i < 16; ++i) { const float p = __builtin_amdgcn_exp2f(st[kb][i] - mx); st[kb][i] = p; den += p; }
    den += __shfl_xor(den, 32);
    SCHED_FENCE();
    ATT_VSTORE(0);
    ATT_VLOAD(1);
    SCHED_FENCE();
    f32x16 ot[2] = {{}, {}};
#pragma unroll
    for (int kb = 0; kb < 5; ++kb) {
        LDS_WAIT();
#pragma unroll
        for (int c = 0; c < 2; ++c) {
            f32x4 p0, p1;
#pragma unroll
            for (int e = 0; e < 4; ++e) { p0[e] = st[kb][8 * c + e]; p1[e] = st[kb][8 * c + 4 + e]; }
            const bf16x8 pf = frag_from_f32(p0, p1);
#pragma unroll
            for (int db = 0; db < 2; ++db) {
                bf16x8 vf;
#pragma unroll
                for (int jj = 0; jj < 8; ++jj) vf[jj] = (short)Vs[(kb & 1) * 2304 + (16 * c + 8 * (jj >> 2) + 4 * hh + (jj & 3)) * 72 + 32 * db + r];
                ot[db] = MFMA32(vf, pf, ot[db]);
            }
        }
        SCHED_FENCE();
        if (kb < 4) { ATT_VSTORE((kb + 1) & 1); if (kb < 3) ATT_VLOAD(kb + 2); }
        SCHED_FENCE();
    }
    LDS_WAIT();
#undef ATT_VLOAD
#undef ATT_VSTORE
    const float inv = 1.0f / den;
    bf16_t* op = OG + ((size_t)g * MT + rowq) * 256 + h * 64;
#pragma unroll
    for (int db = 0; db < 2; ++db)
#pragma unroll
        for (int ig = 0; ig < 4; ++ig) { u32x2 w; w.x = pk2(ot[db][4 * ig] * inv, ot[db][4 * ig + 1] * inv); w.y = pk2(ot[db][4 * ig + 2] * inv, ot[db][4 * ig + 3] * inv);
            *(u32x2*)(op + 32 * db + 8 * ig + 4 * hh) = w; }
    if (hh == 0) { f32x2 ml = {mx, den}; *(f32x2*)(ML + (((size_t)g * MT + rowq) * 4 + h) * 2) = ml; }
}
DI void attn_prompt_phase(LAS unsigned char* lds, const bf16_t* Q, const bf16_t* K, const bf16_t* V, bf16_t* OG, float* ML, const KvSrc& KS, int vblk, int vG) {
    const int tid = otid(); const int wave = tid >> 6, lane = tid & 63; const int NGW = vG * 8, gw = vblk * 8 + wave;
    for (int it = gw; it < 2 * 3 * 4 * 256; it += NGW) {
        const int tile = it & 255, h = (it >> 8) & 3, gb = it >> 10, g = gb % 3, b = gb / 3;
        const int dl = 2 * g;
        const int tpc = 256 >> dl;
        KvCopy kc; kv_issue<4>(kc, KS.c0, KS.c1, KS.c2, KS.out, KS.slotbase, it, lane);
        SCHED_FENCE();
        attn_unit(b, g, h, dl, tile / tpc, 32 * (tile % tpc), Q, K, V, OG, ML, (LAS bf16_t*)(lds + wave * 9216), lane);
        SCHED_FENCE();
        kv_commit<4>(kc);
    }
}
DI void attn_combine(const bf16_t* OG, const float* ML, bf16_t* YY, int vblk, int vG) {
    for (int it = vblk * 512 + otid(); it < MT * 32; it += vG * 512) {
        const int row = it >> 5, h = (it >> 3) & 3, dc = it & 7;
        float m[3], dn[3];
#pragma unroll
        for (int g = 0; g < 3; ++g) { const f32x2 v = *(const f32x2*)(ML + (((size_t)g * MT + row) * 4 + h) * 2); m[g] = v[0]; dn[g] = v[1]; }
        const float mt = fmaxf(m[0], fmaxf(m[1], m[2]));
        f32x4 a0 = {0, 0, 0, 0}, a1 = a0; float wsum = 0.f;
#pragma unroll
        for (int g = 0; g < 3; ++g) { const float w = dn[g] * __builtin_amdgcn_exp2f(m[g] - mt); wsum += w; f32x4 o0, o1; unpack8(*(const u32x4*)(OG + ((size_t)g * MT + row) * 256 + h * 64 + 8 * dc), o0, o1); a0 += o0 * w; a1 += o1 * w; }
        const float inv = 1.0f / wsum;
        *(u32x4*)(YY + (size_t)row * 768 + 512 + h * 64 + 8 * dc) = pack8(a0 * inv, a1 * inv);
    }
}

DI void sample_attn_item(int s, int h, int g, const float* raw3, const float* gqk, const float* cp, float* ko, bf16_t* OG, float* ML, LAS float* sl, int lane) {
    const float* r3 = raw3 + (size_t)s * INW;
    const int w = g == 0 ? 128 : (g == 1 ? 512 : 2048), dl = 2 * g;
    const float q = r3[l2p(512 + 256 * g + 64 * h + lane)], k = r3[l2p(1280 + 256 * g + 64 * h + lane)], v = r3[l2p(2048 + 256 * g + 64 * h + lane)];
    const float qs = wave_sum(q * q), ks = wave_sum(k * k);
    const float qv = q * rsqrtf(qs * (1.f / 64.f) + EPS) * gqk[g * 64 + lane] * QSCALE, kn = k * rsqrtf(ks * (1.f / 64.f) + EPS) * gqk[192 + g * 64 + lane];
    sl[lane] = qv; sl[192 + lane] = v;
    ko[((size_t)(s * w + (w - 1)) * 2 + 0) * 256 + h * 64 + lane] = kn; ko[((size_t)(s * w + (w - 1)) * 2 + 1) * 256 + h * 64 + lane] = v;
    const float s0 = wave_sum(qv * kn);
    LDS_WAIT();
    float sc[2];
#pragma unroll
    for (int half = 0; half < 2; ++half) {
        const int j = 1 + lane + 64 * half; const int rr = w - (j << dl);
        const float* kp = cp + ((size_t)(s * w + rr) * 2 + 0) * 256 + h * 64; float a = 0.f;
#pragma unroll
        for (int d4 = 0; d4 < 16; ++d4) { const f32x4 kk = *(const f32x4*)(kp + 4 * d4); const f32x4 qq = *(const LAS f32x4*)(sl + 4 * d4); a += (kk[0] * qq[0] + kk[1] * qq[1]) + (kk[2] * qq[2] + kk[3] * qq[3]); }
        sc[half] = a;
    }
    const float mx = wave_max(fmaxf(s0, fmaxf(sc[0], sc[1])));
    const float e0 = __builtin_amdgcn_exp2f(s0 - mx), p0 = __builtin_amdgcn_exp2f(sc[0] - mx), p1 = __builtin_amdgcn_exp2f(sc[1] - mx);
    const float den = wave_sum(p0 + p1) + e0;
    sl[64 + lane] = p0; sl[128 + lane] = p1;
    LDS_WAIT();
    const int d4 = lane & 15, kq = lane >> 4;
    f32x4 o = {0.f, 0.f, 0.f, 0.f};
#pragma unroll 8
    for (int i = 0; i < 32; ++i) { const int j = 1 + kq + 4 * i; const int rr = w - (j << dl);
        const f32x4 vv = *(const f32x4*)(cp + ((size_t)(s * w + rr) * 2 + 1) * 256 + h * 64 + 4 * d4); o += vv * sl[64 + j - 1]; }
#pragma unroll
    for (int e = 0; e < 4; ++e) { o[e] += __shfl_xor(o[e], 16); o[e] += __shfl_xor(o[e], 32); }
    if (lane < 16) {
        const f32x4 vn = *(const LAS f32x4*)(sl + 192 + 4 * d4); const float inv = 1.0f / den;
        o = (o + vn * e0) * inv;
        u32x2 wv; wv.x = pk2(o[0], o[1]); wv.y = pk2(o[2], o[3]);
        *(u32x2*)(OG + ((size_t)g * MT + NPR + s) * 256 + h * 64 + 4 * d4) = wv;
    }
    if (lane == 0) { f32x2 ml = {mx, den}; *(f32x2*)(ML + (((size_t)g * MT + NPR + s) * 4 + h) * 2) = ml; }
    LDS_WAIT();
}
DI void sample_ssm_item(int s, int g, const SsmIn& W, const float* raw3, const float* st_re, const float* st_im, float* out_re, float* out_im, bf16_t* YG, int lane) {
    const SsmPar sp = ssm_par(W.a_re, W.a_im, W.log_dt, g, lane);
    const float* r3 = raw3 + (size_t)s * INW;
    float xr = 0.f, xi = 0.f;
    const float* br = W.b_re + (size_t)(g * 64 + lane) * 16; const float* bi = W.b_im + (size_t)(g * 64 + lane) * 16;
#pragma unroll
    for (int c = 0; c < 16; ++c) { const float u = r3[l2p(16 * g + c)]; const float bbr = sp.fr * br[c] - sp.fi * bi[c], bbi = sp.fr * bi[c] + sp.fi * br[c]; xr += bbr * u; xi += bbi * u; }
    const size_t so = (size_t)(s * 32 + g) * 64 + lane;
    const float s0r = st_re[so], s0i = st_im[so];
    const float nr = sp.abr * s0r - sp.abi * s0i + xr, ni = sp.abr * s0i + sp.abi * s0r + xi;
    out_re[so] = nr; out_im[so] = ni;
    float ysel = 0.f;
#pragma unroll
    for (int c = 0; c < 16; ++c) { const float y = wave_sum(W.c_re[(size_t)(g * 16 + c) * 64 + lane] * nr - W.c_im[(size_t)(g * 16 + c) * 64 + lane] * ni); if (lane == c) ysel = y; }
    if (lane < 16) { const float u = r3[l2p(16 * g + lane)]; YG[(size_t)(NPR + s) * 512 + 16 * g + lane] = f2bf(gelu_tanh(ysel + W.dsk[16 * g + lane] * u)); }
}

struct Args { const float* in[32]; float* out; unsigned char* ws; };

__global__ void __launch_bounds__(512, 2) mega_fwd(Args a) {
    extern __shared__ __attribute__((aligned(16))) unsigned char lds_raw[];
    LAS unsigned char* lds = (LAS unsigned char*)lds_raw;
    cg::grid_group grid = cg::this_grid();
    const int tid = threadIdx.x, lane = tid & 63, wave = __builtin_amdgcn_readfirstlane(tid >> 6);
    const int G = gridDim.x, blk = blockIdx.x, gw = blk * 8 + wave, NGW = G * 8;
    unsigned char* const ws = a.ws;
    if (tid < 16) ((LAS unsigned*)(lds + 131072))[tid] = 0u;
    __syncthreads();
    unsigned* const barw = (unsigned*)(ws + 512 * 1024);
    const XcdBarrier xb = xcd_barrier_post(barw, (volatile LAS unsigned*)(lds + 131072 + 32), (unsigned)G);
    const int HG = G / 2;
    const XcdBarrier xbh = xcd_barrier_post(barw + (blk < HG ? 4096 : 8192), (volatile LAS unsigned*)(lds + 131072 + 48), (unsigned)(blk < HG ? HG : G - HG));
#define W1GU ((bf16_t*)(ws + WS_W1GU))
#define W1D ((bf16_t*)(ws + WS_W1D))
#define WIN ((bf16_t*)(ws + WS_WIN))
#define WGLU ((bf16_t*)(ws + WS_WGLU))
#define WSP ((bf16_t*)(ws + WS_WMIX))
#define WAP ((bf16_t*)(ws + WS_WMIX + MiB))
#define TBUF ((bf16_t*)(ws + WS_X1 + 33 * MiB))
#define WO ((bf16_t*)(ws + WS_WO))
#define W2GU ((bf16_t*)(ws + WS_W2GU))
#define W2D ((bf16_t*)(ws + WS_W2D))
#define SEND ((float*)(ws + WS_SEND))
#define SIN ((float*)(ws + WS_SIN))
#define ML ((float*)(ws + WS_ML))
#define SQ1 ((float*)(ws + WS_SQ1))
#define SQ2 ((float*)(ws + WS_SQ2))
#define SR ((float*)(ws + WS_SRAW))
#define XN ((bf16_t*)(ws + WS_XN))
#define X1B ((bf16_t*)(ws + WS_X1B))
#define ACT ((bf16_t*)(ws + WS_ACT))
#define GT ((bf16_t*)(ws + WS_G))
#define OG ((bf16_t*)(ws + WS_OG))
#define YG ((bf16_t*)(ws + WS_YG))
#define YY ((bf16_t*)(ws + WS_YY))
#define X1 ((float*)(ws + WS_X1))
#define GQK ((float*)ws)
#define X2B XN
#define MIXED ((bf16_t*)(ws + WS_X1))
#define Ub ACT
#define Qb (ACT + (size_t)MT * 512)
#define Kb (ACT + (size_t)MT * 512 + (size_t)MT * 768)
#define Vb (ACT + (size_t)MT * 512 + (size_t)MT * 1536)
#define acts1 ((bf16_t*)(SR + SR_RAW1))
#define rawd (SR + SR_RAWD)
#define raw3 (SR + SR_RAW3)
#define yssms ((bf16_t*)(SR + SR_RAWGLU))
#define mixeds ((bf16_t*)(SR + SR_RAWMIX))
#define rawma (SR + SR_RAWMIX + 32 * 1024)
#define rawo (SR + SR_RAWO)
#define acts2 ((bf16_t*)(SR + SR_RAW10))
#define xp (a.in[0])
#define xs (a.in[1])
    float* const out = a.out;
#define SSM_IN(SW) SsmIn SW; SW.a_re = a.in[15]; SW.a_im = a.in[16]; SW.log_dt = a.in[17]; SW.b_re = a.in[18]; SW.b_im = a.in[19]; SW.c_re = a.in[20]; SW.c_im = a.in[21]; SW.dsk = a.in[22];

    constexpr int I_GU = 16 * 88, I_DN = 44 * 32, I_IN = 16 * 152, I_GL = 8 * 16, I_SP = 8 * 32, I_AP = 4 * 32, I_WO = 16 * 32;
#ifndef REP_P0
#define REP_P0 1
#endif
    for (int rep0 = 0; rep0 < REP_P0; ++rep0) {
        LAS float* scr = (LAS float*)(lds + wave * 16384);
        constexpr int NIT = 3 * I_GU + I_IN + I_GL + I_SP + I_AP + I_WO + 3 * I_GU;
        static_assert(I_DN == I_GU, "item counts");
        (void)NIT;
#define TR_JOB(CNT, ...) for (int r = gw; r < (CNT); r += NGW) tr_item(__VA_ARGS__, r, scr, lane);
        TR_JOB(I_GU, a.in[8], FF, nullptr, W1GU, 1024, 0, 1)
        TR_JOB(I_GU, a.in[9], FF, nullptr, W1GU, 1024, 0, 2)
        TR_JOB(I_IN, a.in[12], INW, a.in[11], WIN, 1024, 0, 3)
#undef TR_JOB
        for (int i = blk * 512 + tid; i < NPR; i += G * 512) { SQ1[i] = 0.f; SQ2[i] = 0.f; }
        for (int i = blk * 512 + tid; i < 384; i += G * 512) GQK[i] = i < 192 ? a.in[13][i] : a.in[14][i - 192];
        for (int m = gw; m < MT; m += 2 * NGW) { const int m1 = (m + NGW < MT) ? m + NGW : m;
            norm_rows2_bf16(m < NPR ? xp + (size_t)m * DM : xs + (size_t)(m - NPR) * DM, m1 < NPR ? xp + (size_t)m1 * DM : xs + (size_t)(m1 - NPR) * DM, a.in[7], XN + (size_t)m * DM, XN + (size_t)m1 * DM, lane); }
    }
    if (a.ws == nullptr) grid.sync();
    xcd_barrier(xb);
    {
        pg8::Gemm g{XN, W1GU, NPR, 2 * FF, DM}; pg8::StaticOrder S; S.init(NPR, 2 * FF, G, blk);
        EpiAct<false> E{ACT, nullptr};
        pg8::gemm_phase<EpiAct<false>, pg8::StaticOrder, true, true>(lds, g, S, E);
        ProvBf16 P{XN + (size_t)NPR * DM, DM};
        skinny_gu_phase<DM>(lds, W1GU, P, acts1);
        { const int first = (64 * 22) % G; const int wk = blk - first;
          if (wk >= 0) { LAS float* scr = (LAS float*)(lds + wave * 16384); const int gw2 = wk * 8 + wave, NGW2 = (G - first) * 8;
            if (gw2 >= NGW2 - 32) { SSM_IN(SWT) ssm_build_tables(SWT, ws + WS_SSMT, gw2 - (NGW2 - 32), lane); }
#define TR_JOB2(CNT, ...) for (int r = gw2; r < (CNT); r += NGW2) tr_item(__VA_ARGS__, r, scr, lane);
            TR_JOB2(I_DN, a.in[10], DM, nullptr, W1D, FF, 0, 0)
            TR_JOB2(I_GL, a.in[23], 512, nullptr, WGLU, 512, 0, 0)
            TR_JOB2(I_SP, a.in[25], DM, nullptr, WSP, 512, 0, 0)
            TR_JOB2(I_AP, a.in[26], DM, nullptr, WAP, 256, 0, 0)
            TR_JOB2(I_WO, a.in[27], DM, nullptr, WO, 1024, 0, 0)
            TR_JOB2(I_GU, a.in[29], FF, a.in[28], W2GU, 1024, 0, 1)
            TR_JOB2(I_GU, a.in[30], FF, a.in[28], W2GU, 1024, 0, 2)
            TR_JOB2(I_DN, a.in[31], DM, nullptr, W2D, FF, 0, 0)
#undef TR_JOB2
          } }
    }
    xcd_barrier(xb);
    {
        pg8::Gemm g{ACT, W1D, NPR, DM, FF}; pg8::StaticOrder S; S.init(NPR, DM, G, blk);
        EpiRes<false> E{xp, nullptr, X1B, SQ1, 0.5f};
        pg8::gemm_phase<EpiRes<false>, pg8::StaticOrder, true, true, -1>(lds, g, S, E);
        ProvBf16 P{acts1, FF}; SEpiRaw SE{rawd, DM};
        skinny_phase<DM, FF>(lds, W1D, P, SE);
    }
    xcd_barrier(xb);
    {
        pg8::Gemm g{X1B, WIN, NPR, INW, DM}; pg8::StaticOrder S; S.init(NPR, INW, G, blk);
        EpiWin E{SQ1, ACT, GT, GQK, out};
        pg8::gemm_phase<EpiWin, pg8::StaticOrder, true, true>(lds, g, S, E);
        ProvX<false> P{xs, rawd, nullptr}; SEpiRawScaled SE{raw3, INW};
        skinny_phase<INW, DM>(lds, WIN, P, SE);
        kvshift_tail(a.in[2], a.in[3], a.in[4], out, 64 * 19, KV_TAIL_P10, KV_TAIL_ROWS, wave, lane);
    }
    xcd_barrier(xb);
    if (blk < HG) {
        SSM_IN(SW)
        { const KvSrc KS{a.in[2], a.in[3], a.in[4], out, KV_TAIL_ROWS}; ssm_pass<false>(lds, SW, ws + WS_SSMT, Ub, SEND, nullptr, nullptr, KS, blk, HG); }
        xcd_barrier(xbh);
        ssm_carry(ws + WS_SSMT, SEND, SIN, out + O_SREP, out + O_SIMP, blk, HG);
        xcd_barrier(xbh);
        { const KvSrc KS{a.in[2], a.in[3], a.in[4], out, KV_TAIL_ROWS + 40960}; ssm_pass<true>(lds, SW, ws + WS_SSMT, Ub, nullptr, SIN, YG, KS, blk, HG); }
    } else {
        const int vblk = blk - HG, vG = G - HG, vgw = vblk * 8 + wave, vNGW = vG * 8;
        { const KvSrc KS{a.in[2], a.in[3], a.in[4], out, KV_TAIL_ROWS + 16384}; attn_prompt_phase(lds, Qb, Kb, Vb, OG, ML, KS, vblk, vG); }
        LAS float* sl = (LAS float*)(lds + 110592 + wave * 2560);
        for (int it = vgw; it < 384; it += vNGW) { const int g = it % 3, sh = it / 3;
            sample_attn_item(sh >> 2, sh & 3, g, raw3, GQK, g == 0 ? a.in[2] : (g == 1 ? a.in[3] : a.in[4]), out + (g == 0 ? O_KVS0 : (g == 1 ? O_KVS1 : O_KVS2)), OG, ML, sl, lane); }
        { SSM_IN(SW)
          for (int it = vNGW - 1 - vgw; it < 1024; it += vNGW) sample_ssm_item(it >> 5, it & 31, SW, raw3, a.in[5], a.in[6], out + O_SRES, out + O_SIMS, YG, lane); }
        xcd_barrier(xbh);
        attn_combine(OG, ML, YY, vblk, vG);
    }
    xcd_barrier(xb);
    {
        { pg8::Gemm g{YG, WGLU, NPR, 512, 512}; pg8::StaticOrder S; S.init(NPR, 512, G, blk);
          EpiGlu E{YG, a.in[24], YY};
          pg8::gemm_phase<EpiGlu, pg8::StaticOrder, true, true>(lds, g, S, E); }
        { pg8::Gemm g{YY + 512, WAP, NPR, DM, 256}; pg8::StaticOrder S; S.init(NPR, DM, G, blk);
          EpiGateScale E{GT, TBUF};
          pg8::gemm_phase<EpiGateScale, pg8::StaticOrder, true, true, 768>(lds, g, S, E); }
        { ProvBf16 P{YG + (size_t)NPR * 512, 512}; SEpiGluS SE{YG, a.in[24], yssms};
          skinny_phase<512, 512>(lds, WGLU, P, SE); }
        { ProvBf16 P{YY + (size_t)NPR * 768 + 512, 768}; SEpiRaw SE{rawma, DM};
          skinny_phase<DM, 256>(lds, WAP, P, SE); }
    }
    xcd_barrier(xb);
    {
        pg8::Gemm g{YY, WSP, NPR, DM, 512}; pg8::StaticOrder S; S.init(NPR, DM, G, blk);
        EpiMix2 E{GT, TBUF, MIXED};
        pg8::gemm_phase<EpiMix2, pg8::StaticOrder, true, true, 768>(lds, g, S, E);
        ProvBf16 P{yssms, 512}; SEpiMixS SE{raw3, rawma, mixeds};
        skinny_phase<DM, 512>(lds, WSP, P, SE);
    }
    xcd_barrier(xb);
    {
        pg8::Gemm g{MIXED, WO, NPR, DM, DM}; pg8::StaticOrder S; S.init(NPR, DM, G, blk);
        EpiRes<true> E{X1B, nullptr, X2B, SQ2, 1.0f};
        pg8::gemm_phase<EpiRes<true>, pg8::StaticOrder, true, true>(lds, g, S, E);
        ProvBf16 P{mixeds, DM}; SEpiRaw SE{rawo, DM};
        skinny_phase<DM, DM>(lds, WO, P, SE);
    }
    xcd_barrier(xb);
    {
        pg8::Gemm g{X2B, W2GU, NPR, 2 * FF, DM}; pg8::StaticOrder S; S.init(NPR, 2 * FF, G, blk);
        EpiAct<true> E{ACT, SQ2};
        pg8::gemm_phase<EpiAct<true>, pg8::StaticOrder, true, true>(lds, g, S, E);
        ProvX<true> P{xs, rawd, rawo};
        skinny_gu_phase<DM>(lds, W2GU, P, acts2);
        kvshift_tail(a.in[2], a.in[3], a.in[4], out, 64 * 22, 0, KV_TAIL_P10, wave, lane);
    }
    xcd_barrier(xb);
    {
        pg8::Gemm g{ACT, W2D, NPR, DM, FF}; pg8::StaticOrder S; S.init(NPR, DM, G, blk);
        EpiRes<true> E{X2B, out + O_YP, nullptr, nullptr, 0.5f};
        pg8::gemm_phase<EpiRes<true>, pg8::StaticOrder, true, true, -1>(lds, g, S, E);
        ProvBf16 P{acts2, FF}; SEpiFinal SE{xs, rawd, rawo, out + O_YS};
        skinny_phase<DM, FF>(lds, W2D, P, SE);
    }
}

extern "C" void kernel_launch(void* const* d_in, const int* in_sizes, int n_in, void* d_out, int out_size, void* d_ws, size_t ws_size, hipStream_t stream) {
    static int grid = 0;
    if (grid == 0) {
        if (n_in != 32 || ws_size < WS_END) { fprintf(stderr, "kernel_launch: unexpected inputs (n_in %d, ws %zu)\n", n_in, ws_size); grid = -1; return; }
        int dev = 0, cus = 0, per_cu = 0;
        hipGetDevice(&dev); hipDeviceGetAttribute(&cus, hipDeviceAttributeMultiprocessorCount, dev);
        hipFuncSetAttribute((const void*)mega_fwd, hipFuncAttributeMaxDynamicSharedMemorySize, LDS_BYTES);
        hipOccupancyMaxActiveBlocksPerMultiprocessor(&per_cu, (const void*)mega_fwd, 512, LDS_BYTES);
        if (per_cu < 1) { fprintf(stderr, "kernel_launch: occupancy query says %d blocks/CU\n", per_cu); per_cu = 1; }
        if (per_cu > 1) per_cu = 1;
        grid = cus * per_cu;
        (void)hipGetLastError();
    }
    if (grid < 0) return;
    if (hipMemsetAsync((char*)d_ws + 512 * 1024, 0, 3 * 4096 * 4, stream) != hipSuccess) { fprintf(stderr, "kernel_launch: memset of barrier words failed\n"); return; }
    Args a{};
    for (int i = 0; i < 32; ++i) a.in[i] = (const float*)d_in[i];
    a.out = (float*)d_out; a.ws = (unsigned char*)d_ws;
    void* args[] = {&a};
    hipError_t e = hipLaunchCooperativeKernel((const void*)mega_fwd, dim3(grid), dim3(512), args, LDS_BYTES, stream);
    if (e != hipSuccess) fprintf(stderr, "cooperative launch failed: %s (grid %d)\n", hipGetErrorString(e), grid);
}
```
